# Optimizing an MI355X kernel written in HIP

```python
import math
import jax, jax.numpy as jnp
from jax import lax
import numpy as np


D_MODEL = 1024
BATCH = 8
SEQ = 8192
DEPTH = 1

SSM_WIDTH = D_MODEL // 2
SSM_GROUP = 16
SSM_GROUPS = SSM_WIDTH // SSM_GROUP
SSM_STATE = 64
N_HEADS = 16
HEAD_DIM = 64
N_KV = 4
GQA = N_HEADS // N_KV
ATTN_WIDTH = N_HEADS * HEAD_DIM
KV_WIDTH = N_KV * HEAD_DIM
CMP_LEN = 32
CMP_STRIDE = 16
CMP_HIDDEN = 256
SEL_LEN = 64
SEL_TOP = 16
WINDOW = 512
Q_BLOCK = 64
FORCE_BONUS = 1.0e4
REL_BUCKETS = 32
REL_MAX_DIST = 128
N_EXPERTS = 256
TOP_K = 8
D_EXPERT = 256
ROUTED_SCALE = 2.5
EXPERT_BLOCK = 128
DN_ALPHA = (2 * DEPTH) ** 0.25
DN_BETA = (8 * DEPTH) ** -0.25
LN_EPS = 1e-5

SPLIT_SIZES = (SSM_WIDTH, ATTN_WIDTH, KV_WIDTH, KV_WIDTH, KV_WIDTH, KV_WIDTH, KV_WIDTH, KV_WIDTH, 3 * N_HEADS, 2 * D_MODEL)
IN_WIDTH = sum(SPLIT_SIZES)
VALUE_PIECES = (3, 5, 7)

kernel_name = 'hybrid_s5_nsa_moe_block'


def _split_points():
    return [int(v) for v in np.cumsum(SPLIT_SIZES)[:-1]]


def _norm(x):
    xf = x.astype(jnp.float32)
    xc = xf - jnp.mean(xf, axis=-1, keepdims=True)
    var = jnp.mean(xc * xc, axis=-1, keepdims=True)
    return xc * lax.rsqrt(var + LN_EPS)


def _layer_norm(x, g, b):
    return (_norm(x) * g.astype(jnp.float32) + b.astype(jnp.float32)).astype(x.dtype)


def _ada_modulate(x, shift, scale):
    return (_norm(x) * (1.0 + scale.astype(jnp.float32)) + shift.astype(jnp.float32)).astype(x.dtype)


def _rel_bucket(dist):
    dist = jnp.maximum(dist, 0)
    exact = REL_BUCKETS // 2
    log_ratio = jnp.log(jnp.maximum(dist, 1).astype(jnp.float32) / exact) / math.log(REL_MAX_DIST / exact)
    large = jnp.minimum(exact + (log_ratio * (REL_BUCKETS - exact)).astype(jnp.int32), REL_BUCKETS - 1)
    return jnp.where(dist < exact, dist, large)


def _masked_softmax(s, mask):
    s = jnp.where(mask, s.astype(jnp.float32), -jnp.inf)
    m = jnp.max(s, axis=-1, keepdims=True)
    m = jnp.where(jnp.isfinite(m), m, 0.0)
    e = jnp.exp(s - m)
    return e / jnp.maximum(jnp.sum(e, axis=-1, keepdims=True), 1e-30)


def _cplx_combine(e1, e2):
    ar1, ai1, br1, bi1 = e1
    ar2, ai2, br2, bi2 = e2
    return (ar1 * ar2 - ai1 * ai2, ar1 * ai2 + ai1 * ar2,
            ar2 * br1 - ai2 * bi1 + br2, ar2 * bi1 + ai2 * br1 + bi2)


def _s5_branch(u, lam_re, lam_im, log_step, b_re, b_im, c_re, c_im, d_skip, glu_w):
    bsz, seq, _ = u.shape
    f32 = jnp.float32
    lr, li = lam_re.astype(f32), lam_im.astype(f32)
    dt = jnp.exp(log_step.astype(f32))[:, None]
    mag = jnp.exp(lr * dt)
    ar, ai = mag * jnp.cos(li * dt), mag * jnp.sin(li * dt)
    den = lr * lr + li * li
    kr = ((ar - 1.0) * lr + ai * li) / den
    ki = (ai * lr - (ar - 1.0) * li) / den
    br, bi = b_re.astype(f32), b_im.astype(f32)
    bbr = kr[..., None] * br - ki[..., None] * bi
    bbi = kr[..., None] * bi + ki[..., None] * br
    cr, ci = c_re.astype(f32), c_im.astype(f32)
    dsk = d_skip.astype(f32)

    def one_sequence(us):
        uf = us.astype(f32)
        ug = uf.reshape(seq, SSM_GROUPS, SSM_GROUP)
        bur = jnp.einsum('lgc,gpc->lgp', ug, bbr)
        bui = jnp.einsum('lgc,gpc->lgp', ug, bbi)
        a_r = jnp.broadcast_to(ar, bur.shape)
        a_i = jnp.broadcast_to(ai, bur.shape)
        _, _, xr, xi = lax.associative_scan(_cplx_combine, (a_r, a_i, bur, bui), axis=0)
        y = jnp.einsum('lgp,gcp->lgc', xr, cr) - jnp.einsum('lgp,gcp->lgc', xi, ci)
        return y.reshape(seq, SSM_WIDTH) + dsk * uf

    y = lax.map(one_sequence, u)
    z = jax.nn.gelu(y).astype(u.dtype)
    val, gate = jnp.split(jnp.einsum('blc,cn->bln', z, glu_w), 2, axis=-1)
    return val * jax.nn.sigmoid(gate)


def _compress(kv, pos, w1, w2):
    bsz, seq = kv.shape[:2]
    n_cmp = (seq - CMP_LEN) // CMP_STRIDE + 1
    idx = jnp.arange(n_cmp)[:, None] * CMP_STRIDE + jnp.arange(CMP_LEN)[None, :]
    blocks = kv[:, idx] + pos[None, None, :, None, :]
    flat = jnp.transpose(blocks, (0, 1, 3, 2, 4)).reshape(bsz, n_cmp, N_KV, CMP_LEN * HEAD_DIM)
    return jax.nn.gelu(flat @ w1) @ w2


def _nsa_branch(q, kc, vc, k_slc, v_slc, k_win, v_win, gates, rel_bias):
    bsz, seq = q.shape[:2]
    n_cmp = kc.shape[1]
    n_blk = seq // SEL_LEN
    n_sel = min(SEL_TOP, n_blk)
    table = rel_bias.T.reshape(N_KV, GQA, REL_BUCKETS)
    c_start = jnp.arange(n_cmp) * CMP_STRIDE
    c_end = c_start + CMP_LEN - 1
    blk = jnp.arange(n_blk)
    overlap = ((c_start[:, None] < (blk[None, :] + 1) * SEL_LEN) &
               (c_end[:, None] >= blk[None, :] * SEL_LEN)).astype(jnp.float32)
    ks_b = k_slc.reshape(bsz, n_blk, SEL_LEN, N_KV, HEAD_DIM).transpose(0, 3, 1, 2, 4)
    vs_b = v_slc.reshape(bsz, n_blk, SEL_LEN, N_KV, HEAD_DIM).transpose(0, 3, 1, 2, 4)
    kw_p = jnp.pad(k_win, ((0, 0), (WINDOW, 0), (0, 0), (0, 0)))
    vw_p = jnp.pad(v_win, ((0, 0), (WINDOW, 0), (0, 0), (0, 0)))
    qg = q.reshape(bsz, seq, N_KV, GQA, HEAD_DIM)
    gg = gates.reshape(bsz, seq, N_KV, GQA, 3)
    b_ix = jnp.arange(bsz)[:, None, None, None]
    g_ix = jnp.arange(N_KV)[None, None, :, None]
    g5 = jnp.arange(N_KV)[None, None, :, None, None]
    r5 = jnp.arange(GQA)[None, None, None, :, None]

    def query_block(qi):
        s0 = qi * Q_BLOCK
        t = s0 + jnp.arange(Q_BLOCK)
        qb = lax.dynamic_slice_in_dim(qg, s0, Q_BLOCK, axis=1)
        gb = lax.dynamic_slice_in_dim(gg, s0, Q_BLOCK, axis=1)
        d_cmp = t[:, None] - c_end[None, :]
        bias = table[:, :, _rel_bucket(d_cmp)].transpose(2, 0, 1, 3)
        s = jnp.einsum('bqgrd,bngd->bqgrn', qb, kc) + bias
        p_cmp = _masked_softmax(s, (d_cmp >= 0)[:, None, None, :])
        o_cmp = jnp.einsum('bqgrn,bngd->bqgrd', p_cmp.astype(vc.dtype), vc)
        imp = jnp.einsum('bqgrn,nj->bqgj', p_cmp, overlap)
        cur = (t // SEL_LEN)[:, None]
        forced = (blk[None, :] == 0) | (blk[None, :] == cur) | (blk[None, :] == cur - 1)
        score = jnp.where((blk[None, :] <= cur)[None, :, None, :],
                          imp + jnp.where(forced, FORCE_BONUS, 0.0)[None, :, None, :], -jnp.inf)
        _, sel = lax.top_k(score, n_sel)
        kg = ks_b[b_ix, g_ix, sel].reshape(bsz, Q_BLOCK, N_KV, n_sel * SEL_LEN, HEAD_DIM)
        vg = vs_b[b_ix, g_ix, sel].reshape(bsz, Q_BLOCK, N_KV, n_sel * SEL_LEN, HEAD_DIM)
        kpos = (sel[..., None] * SEL_LEN + jnp.arange(SEL_LEN)).reshape(bsz, Q_BLOCK, N_KV, n_sel * SEL_LEN)
        d_sel = t[None, :, None, None] - kpos
        bias = table[g5, r5, _rel_bucket(d_sel)[:, :, :, None, :]]
        s = jnp.einsum('bqgrd,bqgkd->bqgrk', qb, kg) + bias
        p = _masked_softmax(s, (d_sel >= 0)[:, :, :, None, :])
        o_slc = jnp.einsum('bqgrk,bqgkd->bqgrd', p.astype(vg.dtype), vg)
        kw = lax.dynamic_slice_in_dim(kw_p, s0, WINDOW + Q_BLOCK, axis=1)
        vw = lax.dynamic_slice_in_dim(vw_p, s0, WINDOW + Q_BLOCK, axis=1)
        wpos = s0 - WINDOW + jnp.arange(WINDOW + Q_BLOCK)
        d_win = t[:, None] - wpos[None, :]
        bias = table[:, :, _rel_bucket(d_win)].transpose(2, 0, 1, 3)
        s = jnp.einsum('bqgrd,bkgd->bqgrk', qb, kw) + bias
        win_mask = (d_win >= 0) & (d_win < WINDOW) & (wpos[None, :] >= 0)
        p = _masked_softmax(s, win_mask[:, None, None, :])
        o_win = jnp.einsum('bqgrk,bkgd->bqgrd', p.astype(vw.dtype), vw)
        return gb[..., 0:1] * o_cmp + gb[..., 1:2] * o_slc + gb[..., 2:3] * o_win

    out = lax.map(query_block, jnp.arange(seq // Q_BLOCK))
    return jnp.moveaxis(out, 0, 1).reshape(bsz, seq, ATTN_WIDTH)


def _token_mixer(h, w_in, lam_re, lam_im, log_step, b_re, b_im, c_re, c_im, d_skip, glu_w,
                 cmp_pos, cmp_w1, cmp_w2, rel_bias, w_out):
    bsz, seq, _ = h.shape
    proj = jnp.einsum('bld,de->ble', h, w_in)
    u, q, kcr, vcr, ksr, vsr, kwr, vwr, nsa_g, merge_g = jnp.split(proj, _split_points(), axis=-1)

    def heads(a, n):
        return a.reshape(bsz, seq, n, HEAD_DIM)

    q = heads(q, N_HEADS) * (HEAD_DIM ** -0.5)
    kc = _compress(heads(kcr, N_KV), cmp_pos[0], cmp_w1[0], cmp_w2[0])
    vc = _compress(heads(vcr, N_KV), cmp_pos[1], cmp_w1[1], cmp_w2[1])
    y_nsa = _nsa_branch(q, kc, vc, heads(ksr, N_KV), heads(vsr, N_KV), heads(kwr, N_KV), heads(vwr, N_KV),
                        jax.nn.sigmoid(nsa_g.reshape(bsz, seq, N_HEADS, 3)), rel_bias)
    y_ssm = _s5_branch(u, lam_re, lam_im, log_step, b_re, b_im, c_re, c_im, d_skip, glu_w)
    mg = jax.nn.sigmoid(merge_g.reshape(bsz, seq, 2, D_MODEL))
    merged = mg[:, :, 0] * y_ssm + mg[:, :, 1] * y_nsa
    return jnp.einsum('bld,de->ble', merged, w_out)


def _moe(h, router_w, router_bias, w_gate, w_up, w_down, sh_gate, sh_up, sh_down):
    bsz, seq, dm = h.shape
    n_tok = bsz * seq
    hf = h.reshape(n_tok, dm)
    scores = jax.nn.sigmoid(jnp.einsum('td,de->te', hf, router_w).astype(jnp.float32))
    _, top_e = lax.top_k(scores + router_bias.astype(jnp.float32), TOP_K)
    top_s = jnp.take_along_axis(scores, top_e, axis=-1)
    top_w = top_s / jnp.sum(top_s, axis=-1, keepdims=True) * ROUTED_SCALE
    n_asg = n_tok * TOP_K
    e_flat = top_e.reshape(n_asg)
    tok_flat = jnp.repeat(jnp.arange(n_tok, dtype=jnp.int32), TOP_K)
    order = jnp.argsort(e_flat)
    e_sorted = e_flat[order]
    counts = jnp.bincount(e_flat, length=N_EXPERTS)
    starts = jnp.cumsum(counts) - counts
    padded = (counts + EXPERT_BLOCK - 1) // EXPERT_BLOCK * EXPERT_BLOCK
    pad_end = jnp.cumsum(padded)
    pad_start = pad_end - padded
    dest = pad_start[e_sorted] + jnp.arange(n_asg) - starts[e_sorted]
    n_rows = n_asg + N_EXPERTS * EXPERT_BLOCK
    n_blocks = n_rows // EXPERT_BLOCK
    row_tok = jnp.full((n_rows,), n_tok, jnp.int32).at[dest].set(tok_flat[order])
    row_w = jnp.zeros((n_rows,), jnp.float32).at[dest].set(top_w.reshape(n_asg)[order])
    blk_exp = jnp.minimum(jnp.searchsorted(pad_end, jnp.arange(n_blocks) * EXPERT_BLOCK, side='right'), N_EXPERTS - 1)
    h_pad = jnp.concatenate([hf, jnp.zeros((1, dm), hf.dtype)], axis=0)

    def expert_block(acc, blk):
        tok, wt, e = blk
        xb = h_pad[tok]
        yb = (jax.nn.silu(xb @ w_gate[e]) * (xb @ w_up[e])) @ w_down[e]
        return acc.at[tok].add(yb * wt.astype(yb.dtype)[:, None]), None

    routed, _ = lax.scan(expert_block, jnp.zeros_like(h_pad),
                         (row_tok.reshape(n_blocks, EXPERT_BLOCK), row_w.reshape(n_blocks, EXPERT_BLOCK), blk_exp))
    shared = (jax.nn.silu(hf @ sh_gate) * (hf @ sh_up)) @ sh_down
    return (routed[:n_tok] + shared).reshape(bsz, seq, dm)


def setup_inputs(seed: int = 0) -> dict:
    key = jax.random.key(seed)
    ks = jax.random.split(key, 32)
    f32 = jnp.float32

    def nrm(k, shape, scale):
        return jax.random.normal(k, shape, f32) * scale

    nl, dm = DEPTH, D_MODEL
    offs = np.concatenate([[0], np.cumsum(SPLIT_SIZES)])
    col_scale = np.ones((IN_WIDTH,), np.float32)
    for i in VALUE_PIECES:
        col_scale[offs[i]:offs[i + 1]] = DN_BETA
    n_idx = jnp.arange(SSM_STATE, dtype=f32)
    return {
        'x': nrm(ks[0], (BATCH, SEQ, dm), 1.0),
        'c': nrm(ks[1], (BATCH, dm), 1.0),
        'ada_w': nrm(ks[2], (nl, dm, 6 * dm), dm ** -0.5),
        'ada_b': nrm(ks[3], (nl, 6 * dm), 0.02),
        'w_in': nrm(ks[4], (nl, dm, IN_WIDTH), dm ** -0.5) * jnp.asarray(col_scale),
        'ssm_lambda_re': -0.5 + nrm(ks[5], (nl, SSM_GROUPS, SSM_STATE), 0.01),
        'ssm_lambda_im': math.pi * n_idx + nrm(ks[6], (nl, SSM_GROUPS, SSM_STATE), 0.01),
        'ssm_log_step': jax.random.uniform(ks[7], (nl, SSM_GROUPS), f32, math.log(1e-3), math.log(1e-1)),
        'ssm_b_re': nrm(ks[8], (nl, SSM_GROUPS, SSM_STATE, SSM_GROUP), (2 * SSM_GROUP) ** -0.5),
        'ssm_b_im': nrm(ks[9], (nl, SSM_GROUPS, SSM_STATE, SSM_GROUP), (2 * SSM_GROUP) ** -0.5),
        'ssm_c_re': nrm(ks[10], (nl, SSM_GROUPS, SSM_GROUP, SSM_STATE), SSM_STATE ** -0.5),
        'ssm_c_im': nrm(ks[11], (nl, SSM_GROUPS, SSM_GROUP, SSM_STATE), SSM_STATE ** -0.5),
        'ssm_d': nrm(ks[12], (nl, SSM_WIDTH), 1.0),
        'ssm_glu_w': nrm(ks[13], (nl, SSM_WIDTH, 2 * dm), SSM_WIDTH ** -0.5),
        'cmp_pos': nrm(ks[14], (nl, 2, CMP_LEN, HEAD_DIM), 0.1),
        'cmp_w1': nrm(ks[15], (nl, 2, CMP_LEN * HEAD_DIM, CMP_HIDDEN), (CMP_LEN * HEAD_DIM) ** -0.5),
        'cmp_w2': nrm(ks[16], (nl, 2, CMP_HIDDEN, HEAD_DIM), CMP_HIDDEN ** -0.5),
        'rel_bias': nrm(ks[17], (REL_BUCKETS, N_HEADS), 0.5),
        'w_out': nrm(ks[18], (nl, dm, dm), dm ** -0.5 * DN_BETA),
        'ln1_g': 1.0 + nrm(ks[19], (nl, dm), 0.01),
        'ln1_b': nrm(ks[20], (nl, dm), 0.01),
        'router_w': nrm(ks[21], (nl, dm, N_EXPERTS), dm ** -0.5),
        'router_bias': nrm(ks[22], (nl, N_EXPERTS), 0.01),
        'exp_w_gate': nrm(ks[23], (nl, N_EXPERTS, dm, D_EXPERT), dm ** -0.5),
        'exp_w_up': nrm(ks[24], (nl, N_EXPERTS, dm, D_EXPERT), dm ** -0.5),
        'exp_w_down': nrm(ks[25], (nl, N_EXPERTS, D_EXPERT, dm), D_EXPERT ** -0.5 * DN_BETA),
        'sh_w_gate': nrm(ks[26], (nl, dm, D_EXPERT), dm ** -0.5),
        'sh_w_up': nrm(ks[27], (nl, dm, D_EXPERT), dm ** -0.5),
        'sh_w_down': nrm(ks[28], (nl, D_EXPERT, dm), D_EXPERT ** -0.5 * DN_BETA),
        'ln2_g': 1.0 + nrm(ks[29], (nl, dm), 0.01),
        'ln2_b': nrm(ks[30], (nl, dm), 0.01),
    }


def reference(x, c, ada_w, ada_b, w_in, ssm_lambda_re, ssm_lambda_im, ssm_log_step, ssm_b_re, ssm_b_im,
              ssm_c_re, ssm_c_im, ssm_d, ssm_glu_w, cmp_pos, cmp_w1, cmp_w2, rel_bias, w_out, ln1_g, ln1_b,
              router_w, router_bias, exp_w_gate, exp_w_up, exp_w_down, sh_w_gate, sh_w_up, sh_w_down,
              ln2_g, ln2_b):
    cond = jax.nn.silu(c)
    for l in range(DEPTH):
        mod = jnp.einsum('bd,de->be', cond, ada_w[l]) + ada_b[l]
        sh1, sc1, g1, sh2, sc2, g2 = jnp.split(mod[:, None, :], 6, axis=-1)
        h = _ada_modulate(x, sh1, sc1)
        y = _token_mixer(h, w_in[l], ssm_lambda_re[l], ssm_lambda_im[l], ssm_log_step[l], ssm_b_re[l],
                         ssm_b_im[l], ssm_c_re[l], ssm_c_im[l], ssm_d[l], ssm_glu_w[l], cmp_pos[l],
                         cmp_w1[l], cmp_w2[l], rel_bias, w_out[l])
        x = _layer_norm(DN_ALPHA * x + g1 * y, ln1_g[l], ln1_b[l])
        h = _ada_modulate(x, sh2, sc2)
        y = _moe(h, router_w[l], router_bias[l], exp_w_gate[l], exp_w_up[l], exp_w_down[l],
                 sh_w_gate[l], sh_w_up[l], sh_w_down[l])
        x = _layer_norm(DN_ALPHA * x + g2 * y, ln2_g[l], ln2_b[l])
    return x
```

```cpp
#include <hip/hip_runtime.h>
#include <cstdio>
#include <cstdint>

#define LAS __attribute__((address_space(3)))
#define GAS __attribute__((address_space(1)))
typedef unsigned short bf16_t;
typedef short bf16x8 __attribute__((ext_vector_type(8)));
typedef short bf16x4 __attribute__((ext_vector_type(4)));
typedef float f32x4 __attribute__((ext_vector_type(4)));
typedef float f32x2 __attribute__((ext_vector_type(2)));
typedef unsigned u32x4 __attribute__((ext_vector_type(4)));
typedef unsigned u32x2 __attribute__((ext_vector_type(2)));

constexpr int DM = 1024, NB = 8, SEQ = 8192, MTOK = NB * SEQ;
constexpr int SSM_W = 512, SSM_G = 32, SSM_P = 64;
constexpr int NH = 16, HD = 64, NKV = 4, KVW = 256;
constexpr int NCMP = 511, NCMP_PAD = 512;
constexpr int NEXP = 256, TOPK = 8, DEXP = 256;
constexpr int NPROJ = 5376;
constexpr float DN_ALPHA = 1.189207115002721f;
constexpr float LN_EPS = 1e-5f;
constexpr int NWAVES = 8, NTHREADS = 512;

constexpr size_t MiB = 1u << 20;
constexpr size_t WS_CTL = 0, CTL_ZERO_BYTES = 1 * MiB;
constexpr size_t WS_MOD = 1 * MiB;
constexpr size_t WS_TAB = 1 * MiB + 512 * 1024;
constexpr size_t WS_WIN = 2 * MiB;
constexpr size_t WS_GLU = 13 * MiB;
constexpr size_t WS_WOUT = 15 * MiB;
constexpr size_t WS_ROUT = 17 * MiB;
constexpr size_t WS_SHGU = 17 * MiB + 512 * 1024;
constexpr size_t WS_SHD = 18 * MiB + 512 * 1024;
constexpr size_t WS_CW1 = 19 * MiB;
constexpr size_t WS_CW2 = 21 * MiB;
constexpr size_t WS_S5T = 21 * MiB + 512 * 1024;
constexpr size_t WS_BASE = 24 * MiB;
constexpr size_t WS_H1 = WS_BASE;
constexpr size_t WS_YNSA = WS_H1;
constexpr size_t WS_U = WS_H1 + 128 * MiB;
constexpr size_t WS_Q = WS_U + 64 * MiB;
constexpr size_t WS_MERGED = WS_Q;
constexpr size_t WS_KCR = WS_Q + 128 * MiB;
constexpr size_t WS_VCR = WS_KCR + 32 * MiB;
constexpr size_t WS_KS = WS_VCR + 32 * MiB;
constexpr size_t WS_VST = WS_KS + 32 * MiB;
constexpr size_t WS_KW = WS_VST + 32 * MiB;
constexpr size_t WS_VWT = WS_KW + 32 * MiB;
constexpr size_t WS_MG = WS_VWT + 32 * MiB;
constexpr size_t WS_GATES = WS_MG + 256 * MiB;
constexpr size_t WS_Z = WS_GATES + 12 * MiB;
constexpr size_t WS_CMPH = WS_Z + 64 * MiB;
constexpr size_t WS_KC = WS_CMPH + 16 * MiB;
constexpr size_t WS_VCT = WS_KC + 2 * MiB;
constexpr size_t WS_S5ST = WS_VCT + 2 * MiB;
constexpr size_t WS_MIX_END = WS_S5ST + 1 * MiB;
constexpr int NCHUNK = 2, CHUNK_TOK = 32768, CHUNK_ASG = CHUNK_TOK * 8, CHUNK_ROWS = 327680, CHUNK_TILES = CHUNK_ROWS / 256;
constexpr float OUTS_SCALE = 64.0f;
__host__ __device__ __forceinline__ int chunk_of_tok(int tok) { return tok >> 15; }
__host__ __device__ __forceinline__ int chunk_ntok(int ch) { return CHUNK_TOK; }
constexpr size_t WS_H2 = WS_BASE;
constexpr size_t WS_WGU = WS_H2 + 129 * MiB;
constexpr size_t WS_WD = WS_WGU + 256 * MiB;
constexpr size_t WS_OUTS = WS_WD + 128 * MiB;
constexpr size_t WS_LOGIT = WS_OUTS;
constexpr size_t WS_HID = WS_OUTS + 256 * MiB;
constexpr size_t WS_HSH = WS_HID;
constexpr size_t WS_ASGE = WS_HID + 160 * MiB;
constexpr size_t WS_ASGS = WS_ASGE + 2 * MiB;
constexpr size_t WS_ASGW = WS_ASGS + 2 * MiB;
constexpr size_t WS_ROWASG = WS_ASGW + 2 * MiB;
constexpr size_t WS_ROWW = WS_ROWASG + 3 * MiB;
constexpr size_t WS_LNST = WS_ROWW + 3 * MiB;
constexpr size_t WS_SHOUT = WS_LNST + 1 * MiB;
constexpr size_t WS_END = WS_SHOUT + 64 * MiB;
static_assert(WS_MIX_END <= WS_END, "map");
constexpr int CW_BAR = 4096;
constexpr int CW_CNT = 8192;
constexpr int CW_FCTR = 9216;
constexpr size_t TAB_CMPB = 0;
constexpr size_t TAB_LUT = 4096;
constexpr size_t S5_AFR = 0;
constexpr size_t S5_CFR = 256 * 1024;
constexpr size_t S5_A = 384 * 1024;
constexpr size_t S5_A16 = S5_A + 16384;
constexpr size_t S5_AC = S5_A16 + 16384;

constexpr int RING_BYTES = 131072;
constexpr int MISC_OFF = 133120;
constexpr int LUT_OFF = MISC_OFF + 1024;
constexpr int TILES_OFF = LUT_OFF + 8448;
constexpr int NB_OFF = TILES_OFF + 4160;
constexpr int LDS_BYTES = 163840;
static_assert(NB_OFF % 16 == 0 && NB_OFF + 16 * 264 * 4 <= LDS_BYTES, "near-bias table");
static_assert(RING_BYTES <= MISC_OFF, "GEMM stage ring below the control words");
static_assert(TILES_OFF + 4 * 260 * 4 <= LDS_BYTES, "lds map");

#define RLX_AGENT __ATOMIC_RELAXED, __HIP_MEMORY_SCOPE_AGENT
#define LDS_WAIT() asm volatile("s_waitcnt lgkmcnt(0)" ::: "memory")
#define VM_WAIT() asm volatile("s_waitcnt vmcnt(0)" ::: "memory")
__device__ __forceinline__ unsigned f2bf(float f) { unsigned u = __builtin_bit_cast(unsigned, f); return (u + 0x7fffu + ((u >> 16) & 1u)) >> 16; }
typedef __bf16 nbf16x2 __attribute__((ext_vector_type(2)));
__device__ __forceinline__ unsigned pk2(float lo, float hi) { const f32x2 v = {lo, hi}; return __builtin_bit_cast(unsigned, __builtin_convertvector(v, nbf16x2)); }
__device__ __forceinline__ float bf2f(unsigned short b) { return __builtin_bit_cast(float, ((unsigned)b) << 16); }
__device__ __forceinline__ float bflo(unsigned w) { return __builtin_bit_cast(float, w << 16); }
__device__ __forceinline__ float bfhi(unsigned w) { return __builtin_bit_cast(float, w & 0xffff0000u); }
__device__ __forceinline__ float sigmoidf_(float x) { return 1.0f / (1.0f + __expf(-x)); }
__device__ __forceinline__ float siluf_(float x) { return x / (1.0f + __expf(-x)); }
__device__ __forceinline__ float gelu_tanh(float x) { const float u = 0.7978845608028654f * (x + 0.044715f * x * x * x); const float e = __expf(2.0f * u); return x * (1.0f - 1.0f / (e + 1.0f)); }
__device__ __forceinline__ float wave_sum(float v) {
#pragma unroll
    for (int o = 1; o < 64; o <<= 1) v += __shfl_xor(v, o);
    return v;
}

#define XB_TMO      128
#define XB_XCNT(j)  (256  + 64 * (j))
#define XB_XSUB(j)  (1280 + 64 * (j))
#define XB_XGEN(j)  (2304 + 64 * (j))
#define XB_TOP      3328
#define XB_TOPGEN   3392
#define XCD_BAR_WORDS 3456
#define XB_SPIN_CAP (1u << 18)
__device__ __forceinline__ unsigned xb_ld(unsigned* p)              { return __hip_atomic_load(p, __ATOMIC_RELAXED, __HIP_MEMORY_SCOPE_AGENT); }
__device__ __forceinline__ unsigned xb_add(unsigned* p, unsigned v) { return __hip_atomic_fetch_add(p, v, __ATOMIC_RELAXED, __HIP_MEMORY_SCOPE_AGENT); }
__device__ __forceinline__ unsigned xb_xcc_id() { return (unsigned)__builtin_amdgcn_s_getreg((3 << 11) | 20) & 0xFu; }
#define XB_SPIN(cond, bar) do { unsigned _sp = 0; while (cond) { __builtin_amdgcn_s_sleep(1); \
    if ((++_sp & 255u) == 0u) { if (xb_ld(&(bar)[XB_TMO])) break; if (_sp > XB_SPIN_CAP) { atomicAdd(&(bar)[XB_TMO], 1u); break; } } } } while (0)
struct XcdBarrier { unsigned* bar; unsigned x; volatile LAS unsigned* st; };
__device__ __forceinline__ XcdBarrier xcd_barrier_post(unsigned* bar, volatile LAS unsigned* st) {
    XcdBarrier b; b.bar = bar; b.x = xb_xcc_id(); b.st = st;
    if (threadIdx.x == 0) (void)xb_add(&bar[XB_XCNT(b.x)], 1u);
    return b;
}
__device__ __forceinline__ void xcd_barrier_complete(unsigned* bar, unsigned x, unsigned& nloc, unsigned& nx) {
    const unsigned G = gridDim.x * gridDim.y * gridDim.z;
    unsigned sum, cnt, mine, sp = 0u;
    for (;;) {
        sum = 0u; cnt = 0u; mine = 0u;
#pragma unroll
        for (unsigned j = 0; j < 16; ++j) { const unsigned c = xb_ld(&bar[XB_XCNT(j)]); sum += c; cnt += (c > 0u) ? 1u : 0u; mine = (j == x) ? c : mine; }
        if (sum == G) break;
        __builtin_amdgcn_s_sleep(1);
        if ((++sp & 255u) == 0u) { if (xb_ld(&bar[XB_TMO])) break; if (sp > XB_SPIN_CAP) { atomicAdd(&bar[XB_TMO], 1u); break; } }
    }
    nloc = mine > 0u ? mine : 1u; nx = cnt > 0u ? cnt : 1u;
}
__device__ __forceinline__ void xcd_barrier(const XcdBarrier& b) {
    asm volatile("s_waitcnt vmcnt(0)" ::: "memory");
    __syncthreads();
    if (threadIdx.x == 0) {
        unsigned* bar = b.bar;
        __builtin_amdgcn_s_waitcnt(0);
        unsigned nloc = b.st[0], nx = b.st[1];
        if (nloc == 0u) { xcd_barrier_complete(bar, b.x, nloc, nx); b.st[0] = nloc; b.st[1] = nx; }
        const unsigned old = xb_add(&bar[XB_XSUB(b.x)], 1u);
        const unsigned gen = old / nloc;
        if (old + 1u == (gen + 1u) * nloc) {
            __builtin_amdgcn_fence(__ATOMIC_RELEASE, "agent");
            asm volatile("s_waitcnt vmcnt(0)" ::: "memory");
            const unsigned og = xb_add(&bar[XB_TOP], 1u);
            const unsigned tg = og / nx;
            if (og + 1u == (tg + 1u) * nx) xb_add(&bar[XB_TOPGEN], 1u);
            else XB_SPIN(xb_ld(&bar[XB_TOPGEN]) == tg, bar);
            __builtin_amdgcn_fence(__ATOMIC_ACQUIRE, "agent");
            xb_add(&bar[XB_XGEN(b.x)], 1u);
            asm volatile("s_waitcnt vmcnt(0)" ::: "memory");
        } else {
            XB_SPIN(xb_ld(&bar[XB_XGEN(b.x)]) == gen, bar);
            __builtin_amdgcn_fence(__ATOMIC_ACQUIRE, "agent");
            asm volatile("s_waitcnt vmcnt(0)" ::: "memory");
        }
    }
    __syncthreads();
}

namespace pg8 {
constexpr int BM = 256, BK = 64, HALF = 128, HTB = HALF * BK * 2, STAGE_BYTES = 8 * HTB, NXCD = 8, WGM = 8;
__host__ __device__ __forceinline__ int lds_byte(int r, int c) { const int st = (r >> 4) * 2 + (c >> 5), rr = r & 15, cc = c & 31, ob = rr * 64 + cc * 2; return st * 1024 + (ob ^ (((ob >> 9) & 1) << 5)); }
__host__ __device__ __forceinline__ void stage_rc(int b, int& R, int& C) { const int st = b / 1024, sb = b % 1024, swz = sb ^ (((sb >> 9) & 1) << 5); R = (st >> 1) * 16 + swz / 64; C = (st & 1) * 32 + (swz % 64) / 2; }
__host__ __device__ __forceinline__ int perm32(int rho) { const int n = rho >> 4, i = rho & 15; return 8 * (i >> 2) + 4 * n + (i & 3); }
struct Unit { int pm, pn; };
struct DenseOrder {
    int nM, nN, nwg, G, c;
    __device__ void init(int nM_, int nN_, int G_, int c_) { nM = nM_; nN = nN_; nwg = nM * nN; G = G_; c = c_; }
    __device__ bool next(int i, Unit& u) const {
        const long L = (long)i * G + c; if (L >= nwg) return false;
        int wgid = (int)L; { const int q = nwg / NXCD, r = nwg % NXCD, xcd = wgid % NXCD, off = wgid / NXCD; wgid = (xcd < r ? xcd * (q + 1) : r * (q + 1) + (xcd - r) * q) + off; }
        const int nig = WGM * nN, gid = wgid / nig, fm = gid * WGM, gsz = (nM - fm) < WGM ? (nM - fm) : WGM;
        u.pm = fm + ((wgid % nig) % gsz); u.pn = (wgid % nig) / gsz; return true;
    }
};
template <class Epi, class Sched>
__device__ __forceinline__ void gemm_phase(LAS unsigned char* lds, const Sched& S, const Epi& E) {
    int tid_ = threadIdx.x; asm volatile("" : "+v"(tid_));
    const int tid = tid_, wid = __builtin_amdgcn_readfirstlane(tid >> 6), lane = tid & 63, wr = wid >> 2, wc = wid & 3, fr = lane & 15, fq = lane >> 4;
    const int K = S.K, nt = K / BK;
    int RA[2], CA[2]; unsigned voffB[2];
#pragma unroll
    for (int i = 0; i < 2; ++i) { int R, C; stage_rc(tid * 16 + i * 8192, R, C); const int Rb = Epi::PERM ? ((R & ~31) + perm32(R & 31)) : R;
        RA[i] = R; CA[i] = C * 2; voffB[i] = (unsigned)(Rb * K + C) * 2u; }
    const size_t kstep = (size_t)(BK * 2);
    const size_t hstep = (size_t)HALF * K * 2;
    const size_t ka = (size_t)S.a_kstep;
    const unsigned ldsw = (unsigned)wid * 1024u;
    const int aoff = lds_byte(wr * 64 + fr, fq * 8), boff = lds_byte(wc * 32 + fr, fq * 8);
#define PG8_SA(b, h) (((b) * 2 + (h)) * HTB)
#define PG8_SB(b, h) ((4 + (b) * 2 + (h)) * HTB)
#define PG8_STAGE(bufoff, gbase, v0, v1) do { \
        __builtin_amdgcn_global_load_lds((const unsigned*)((const char*)(gbase) + (v0)), (LAS unsigned*)(lds + (bufoff) + ldsw), 16, 0, 0); \
        __builtin_amdgcn_global_load_lds((const unsigned*)((const char*)(gbase) + (v1)), (LAS unsigned*)(lds + (bufoff) + ldsw + 8192), 16, 0, 0); } while (0)
#define PG8_LDA(dst, b, h) do { _Pragma("unroll") for (int m = 0; m < 4; ++m) _Pragma("unroll") for (int k = 0; k < 2; ++k) dst[m][k] = *(const LAS bf16x8*)(lds + PG8_SA(b, h) + aoff + m * 2048 + k * 1024); } while (0)
#define PG8_LDB(dst, b, h) do { _Pragma("unroll") for (int n = 0; n < 2; ++n) _Pragma("unroll") for (int k = 0; k < 2; ++k) dst[n][k] = *(const LAS bf16x8*)(lds + PG8_SB(b, h) + boff + n * 2048 + k * 1024); } while (0)
#define PG8_MMA(ai, bj, At, Bt) do { _Pragma("unroll") for (int m = 0; m < 4; ++m) _Pragma("unroll") for (int n = 0; n < 2; ++n) _Pragma("unroll") for (int k = 0; k < 2; ++k) \
        acc[ai][bj][m][n] = __builtin_amdgcn_mfma_f32_16x16x32_bf16(Bt[n][k], At[m][k], acc[ai][bj][m][n], 0, 0, 0); } while (0)
#define PG8_WAIT_V(n) asm volatile("s_waitcnt vmcnt(" #n ")" ::: "memory")
#define PG8_WAIT_L(n) asm volatile("s_waitcnt lgkmcnt(" #n ")" ::: "memory")
#define PG8_BAR __builtin_amdgcn_s_barrier()
#define PG8_SCHED __builtin_amdgcn_sched_barrier(0)
    Unit cur, nxt; int ui = 0;
    if (!S.next(0, cur)) return;
    if (wr) __builtin_amdgcn_s_setprio(1);
    f32x4 acc[2][2][4][2];
#pragma unroll
    for (int a = 0; a < 2; ++a)
#pragma unroll
        for (int b = 0; b < 2; ++b)
#pragma unroll
            for (int m = 0; m < 4; ++m)
#pragma unroll
                for (int n = 0; n < 2; ++n) acc[a][b][m][n] = (f32x4){0.f, 0.f, 0.f, 0.f};
    bf16x8 At[4][2], B0[2][2], B1[2][2];
    const char* const abase = S.abase;
    unsigned va00 = S.a_off(cur, RA[0]) + CA[0], va01 = S.a_off(cur, RA[1]) + CA[1], va10 = S.a_off(cur, RA[0] + HALF) + CA[0], va11 = S.a_off(cur, RA[1] + HALF) + CA[1];
    const char* cB = S.b_ptr(cur);
    PG8_STAGE(PG8_SB(0, 0), cB, voffB[0], voffB[1]); PG8_STAGE(PG8_SB(0, 1), cB + hstep, voffB[0], voffB[1]); PG8_STAGE(PG8_SA(0, 0), abase, va00, va01); PG8_STAGE(PG8_SA(0, 1), abase, va10, va11);
    if (wr == 1) PG8_BAR;
    PG8_WAIT_V(2); PG8_BAR;
    PG8_STAGE(PG8_SB(1, 0), cB + kstep, voffB[0], voffB[1]); PG8_STAGE(PG8_SA(1, 0), abase + ka, va00, va01); PG8_STAGE(PG8_SB(1, 1), cB + hstep + kstep, voffB[0], voffB[1]);
    PG8_WAIT_V(6); PG8_BAR;
    for (;;) {
        const bool has_next = S.next(ui + 1, nxt);
        unsigned na00 = va00, na01 = va01, na10 = va10, na11 = va11; const char* nB = cB;
        if (has_next) { na00 = S.a_off(nxt, RA[0]) + CA[0]; na01 = S.a_off(nxt, RA[1]) + CA[1]; na10 = S.a_off(nxt, RA[0] + HALF) + CA[0]; na11 = S.a_off(nxt, RA[1] + HALF) + CA[1]; nB = S.b_ptr(nxt); }
        for (int t = 0; t < nt; t += 2) {
            const bool last = (t == nt - 2);
            const char* a1 = abase + (size_t)(t + 1) * ka;
            const char* a2 = last ? abase : abase + (size_t)(t + 2) * ka; const char* b2 = last ? nB : cB + (size_t)(t + 2) * kstep;
            const char* a3 = a2 + ka; const char* b3 = b2 + kstep;
            const unsigned x00 = last ? na00 : va00, x01 = last ? na01 : va01, x10 = last ? na10 : va10, x11 = last ? na11 : va11;
            PG8_LDB(B0, 0, 0); PG8_LDB(B1, 0, 1); PG8_SCHED; PG8_LDA(At, 0, 0); PG8_STAGE(PG8_SA(1, 1), a1, va10, va11);
            PG8_WAIT_V(8); PG8_WAIT_L(0); PG8_BAR; PG8_MMA(0, 0, At, B0); PG8_MMA(0, 1, At, B1); PG8_BAR; PG8_SCHED;
            PG8_LDA(At, 0, 1); PG8_STAGE(PG8_SB(0, 0), b2, voffB[0], voffB[1]); PG8_STAGE(PG8_SB(0, 1), b2 + hstep, voffB[0], voffB[1]); PG8_STAGE(PG8_SA(0, 0), a2, x00, x01);
            PG8_WAIT_V(8); PG8_WAIT_L(0); PG8_BAR; PG8_MMA(1, 0, At, B0); PG8_MMA(1, 1, At, B1); PG8_BAR; PG8_SCHED;
            PG8_LDB(B0, 1, 0); PG8_LDB(B1, 1, 1); PG8_SCHED; PG8_LDA(At, 1, 0); PG8_STAGE(PG8_SA(0, 1), a2, x10, x11);
            PG8_WAIT_V(8); PG8_WAIT_L(0); PG8_BAR; PG8_MMA(0, 0, At, B0); PG8_MMA(0, 1, At, B1); PG8_BAR; PG8_SCHED;
            PG8_LDA(At, 1, 1); PG8_STAGE(PG8_SB(1, 0), b3, voffB[0], voffB[1]); PG8_STAGE(PG8_SB(1, 1), b3 + hstep, voffB[0], voffB[1]); PG8_STAGE(PG8_SA(1, 0), a3, x00, x01);
            PG8_WAIT_V(8); PG8_WAIT_L(0); PG8_BAR; PG8_MMA(1, 0, At, B0); PG8_MMA(1, 1, At, B1); PG8_BAR; PG8_SCHED;
        }
        if (wr == 0) PG8_BAR;
        E(acc, cur, wr, wc, fr, fq);
        if (!has_next) break;
#pragma unroll
        for (int a = 0; a < 2; ++a)
#pragma unroll
            for (int b = 0; b < 2; ++b)
#pragma unroll
                for (int m = 0; m < 4; ++m)
#pragma unroll
                    for (int n = 0; n < 2; ++n) acc[a][b][m][n] = (f32x4){0.f, 0.f, 0.f, 0.f};
        cur = nxt; cB = nB; va00 = na00; va01 = na01; va10 = na10; va11 = na11; ++ui;
        if (wr == 1) PG8_BAR;
    }
    PG8_WAIT_V(0);
    PG8_BAR;
    __builtin_amdgcn_s_setprio(0);
#undef PG8_SA
#undef PG8_SB
#undef PG8_STAGE
#undef PG8_LDA
#undef PG8_LDB
#undef PG8_MMA
#undef PG8_WAIT_V
#undef PG8_WAIT_L
#undef PG8_BAR
#undef PG8_SCHED
}
}

__host__ __device__ __forceinline__ int vperm(int key) { const int x = key & 31; return (key & ~31) | (8 * ((x >> 2) & 3) + 4 * ((x >> 4) & 1) + (x & 3)); }
using pg8::Unit;
struct SchedDense {
    const char* abase; unsigned a_kstep; int K;
    unsigned a_base; unsigned lda; const char* Bt; pg8::DenseOrder ord;
    __device__ __forceinline__ bool next(int i, Unit& u) const { return ord.next(i, u); }
    __device__ __forceinline__ unsigned a_off(const Unit& u, int R) const { return a_base + (unsigned)(u.pm * 256 + R) * lda; }
    __device__ __forceinline__ const char* b_ptr(const Unit& u) const { return Bt + (size_t)u.pn * 256 * K * 2; }
};
__device__ __forceinline__ SchedDense make_dense(const char* ws, size_t a_off, int lda_bytes, const char* Bt, int M, int N, int K) {
    SchedDense S; S.abase = ws; S.a_kstep = 128; S.K = K; S.a_base = (unsigned)a_off; S.lda = (unsigned)lda_bytes; S.Bt = Bt; S.ord.init(M / 256, N / 256, (int)gridDim.x, (int)blockIdx.x); return S;
}
struct SchedCmp1 {
    const char* abase; unsigned a_kstep; int K; const char* Bt; pg8::DenseOrder ord;
    __device__ __forceinline__ bool next(int i, Unit& u) const { return ord.next(i, u); }
    __device__ __forceinline__ unsigned a_off(const Unit& u, int R) const {
        const int row = u.pm * 256 + R, g = row & 3, bn = row >> 2, b = bn >> 9; int n = bn & 511; n = n > 510 ? 510 : n;
        return (unsigned)(u.pn ? WS_VCR : WS_KCR) + (unsigned)(((b * SEQ + 16 * n) * KVW + g * HD) * 2);
    }
    __device__ __forceinline__ const char* b_ptr(const Unit& u) const { return Bt + (size_t)u.pn * 256 * 2048 * 2; }
};
struct SchedCmp2 {
    const char* abase; unsigned a_kstep; int K; const char* Bt; pg8::DenseOrder ord;
    __device__ __forceinline__ bool next(int i, Unit& u) const { return ord.next(i, u); }
    __device__ __forceinline__ unsigned a_off(const Unit& u, int R) const { return (unsigned)WS_CMPH + (unsigned)(((u.pn * 16384) + u.pm * 256 + R) * 512); }
    __device__ __forceinline__ const char* b_ptr(const Unit& u) const { return Bt + (size_t)u.pn * 256 * 256 * 2; }
};

struct EpiProj {
    static constexpr bool PERM = true;
    unsigned char* ws;
    __device__ __forceinline__ void operator()(const f32x4 (&acc)[2][2][4][2], const Unit& u, int wr, int wc, int fr, int fq) const {
        const int pn = u.pn;
#pragma unroll
        for (int ai = 0; ai < 2; ++ai)
#pragma unroll
            for (int m = 0; m < 4; ++m) {
                const int row = u.pm * 256 + 128 * ai + 64 * wr + 16 * m + fr;
#pragma unroll
                for (int bj = 0; bj < 2; ++bj) {
                    const int c8 = 128 * bj + 32 * wc + 8 * fq;
                    float v[8];
#pragma unroll
                    for (int j = 0; j < 4; ++j) { v[j] = acc[ai][bj][m][0][j]; v[4 + j] = acc[ai][bj][m][1][j]; }
                    if (pn < 12 && pn != 9 && pn != 11) {
                        bf16_t* dst; float sc = 1.0f;
                        if (pn < 2) dst = (bf16_t*)(ws + WS_U) + (size_t)row * 512 + pn * 256 + c8;
                        else if (pn < 6) { dst = (bf16_t*)(ws + WS_Q) + (size_t)row * 1024 + (pn - 2) * 256 + c8; sc = 0.125f * 1.4426950408889634f; }
                        else { const size_t off = pn == 6 ? WS_KCR : pn == 7 ? WS_VCR : pn == 8 ? WS_KS : WS_KW; dst = (bf16_t*)(ws + off) + (size_t)row * 256 + c8; }
                        u32x4 w; w.x = pk2(v[0] * sc, v[1] * sc); w.y = pk2(v[2] * sc, v[3] * sc); w.z = pk2(v[4] * sc, v[5] * sc); w.w = pk2(v[6] * sc, v[7] * sc);
                        *(u32x4*)dst = w;
                    } else if (pn == 9 || pn == 11) {
                        bf16_t* base = (bf16_t*)(ws + (pn == 9 ? WS_VST : WS_VWT));
                        const int b = row >> 13, t = row & (SEQ - 1);
#pragma unroll
                        for (int e = 0; e < 8; ++e) { const int c = c8 + e, g = c >> 6, d = c & 63; base[((size_t)((b * 4 + g) * 64 + d)) * SEQ + vperm(t)] = (bf16_t)f2bf(v[e]); }
                    } else if (pn < 20) {
                        bf16_t* dst = (bf16_t*)(ws + WS_MG) + (size_t)row * 2048 + (pn - 12) * 256 + c8;
                        u32x4 w; w.x = pk2(sigmoidf_(v[0]), sigmoidf_(v[1])); w.y = pk2(sigmoidf_(v[2]), sigmoidf_(v[3])); w.z = pk2(sigmoidf_(v[4]), sigmoidf_(v[5])); w.w = pk2(sigmoidf_(v[6]), sigmoidf_(v[7]));
                        *(u32x4*)dst = w;
                    } else {
                        if (c8 < 48) { float* dst = (float*)(ws + WS_GATES) + (size_t)row * 48 + c8;
                            *(f32x4*)dst = (f32x4){sigmoidf_(v[0]), sigmoidf_(v[1]), sigmoidf_(v[2]), sigmoidf_(v[3])}; *(f32x4*)(dst + 4) = (f32x4){sigmoidf_(v[4]), sigmoidf_(v[5]), sigmoidf_(v[6]), sigmoidf_(v[7])}; }
                    }
                }
            }
    }
};
struct EpiCmp1 {
    static constexpr bool PERM = true;
    unsigned char* ws;
    __device__ __forceinline__ void operator()(const f32x4 (&acc)[2][2][4][2], const Unit& u, int wr, int wc, int fr, int fq) const {
        const float* bias = (const float*)(ws + WS_CTL + 65536) + u.pn * 256;
#pragma unroll
        for (int bj = 0; bj < 2; ++bj) {
            const int c8 = 128 * bj + 32 * wc + 8 * fq;
            const f32x4 b0 = *(const f32x4*)(bias + c8), b1 = *(const f32x4*)(bias + c8 + 4);
#pragma unroll
            for (int ai = 0; ai < 2; ++ai)
#pragma unroll
                for (int m = 0; m < 4; ++m) {
                    const int row = u.pm * 256 + 128 * ai + 64 * wr + 16 * m + fr;
                    const f32x4 x0 = acc[ai][bj][m][0] + b0, x1 = acc[ai][bj][m][1] + b1;
                    u32x4 w; w.x = pk2(gelu_tanh(x0[0]), gelu_tanh(x0[1])); w.y = pk2(gelu_tanh(x0[2]), gelu_tanh(x0[3])); w.z = pk2(gelu_tanh(x1[0]), gelu_tanh(x1[1])); w.w = pk2(gelu_tanh(x1[2]), gelu_tanh(x1[3]));
                    *(u32x4*)((bf16_t*)(ws + WS_CMPH) + ((size_t)u.pn * 16384 + row) * 256 + c8) = w;
                }
        }
    }
};
struct EpiCmp2 {
    static constexpr bool PERM = false;
    unsigned char* ws;
    __device__ __forceinline__ void operator()(const f32x4 (&acc)[2][2][4][2], const Unit& u, int wr, int wc, int fr, int fq) const {
        if (wc >= 2) return;
#pragma unroll
        for (int ai = 0; ai < 2; ++ai)
#pragma unroll
            for (int m = 0; m < 4; ++m) {
                const int row = u.pm * 256 + 128 * ai + 64 * wr + 16 * m + fr;
#pragma unroll
                for (int n = 0; n < 2; ++n) {
                    const int c = 32 * wc + 16 * n + 4 * fq; const f32x4 x = acc[ai][0][m][n];
                    if (u.pn == 0) { u32x2 w; w.x = pk2(x[0], x[1]); w.y = pk2(x[2], x[3]); *(u32x2*)((bf16_t*)(ws + WS_KC) + (size_t)row * 64 + c) = w; }
                    else { const int g = row & 3, bn = row >> 2, b = bn >> 9, nn = bn & 511; bf16_t* base = (bf16_t*)(ws + WS_VCT) + ((size_t)((b * 4 + g) * 64 + c)) * NCMP_PAD + vperm(nn);
#pragma unroll
                        for (int j = 0; j < 4; ++j) base[(size_t)j * NCMP_PAD] = (bf16_t)f2bf(x[j]); }
                }
            }
    }
};
struct EpiGlu {
    static constexpr bool PERM = true;
    unsigned char* ws;
    __device__ __forceinline__ void operator()(const f32x4 (&acc)[2][2][4][2], const Unit& u, int wr, int wc, int fr, int fq) const {
        const int col = u.pn * 128 + 32 * wc + 8 * fq;
#pragma unroll
        for (int ai = 0; ai < 2; ++ai) {
            u32x4 g0[4], g1[4], yn[4];
#pragma unroll
            for (int m = 0; m < 4; ++m) { const int row = u.pm * 256 + 128 * ai + 64 * wr + 16 * m + fr;
                g0[m] = *(const u32x4*)((const bf16_t*)(ws + WS_MG) + (size_t)row * 2048 + col);
                g1[m] = *(const u32x4*)((const bf16_t*)(ws + WS_MG) + (size_t)row * 2048 + 1024 + col);
                yn[m] = *(const u32x4*)((const bf16_t*)(ws + WS_YNSA) + (size_t)row * 1024 + col); }
#pragma unroll
            for (int m = 0; m < 4; ++m) { const int row = u.pm * 256 + 128 * ai + 64 * wr + 16 * m + fr;
                float o[8];
#pragma unroll
                for (int e = 0; e < 8; ++e) { const float val = acc[ai][0][m][e >> 2][e & 3], gate = acc[ai][1][m][e >> 2][e & 3]; const float ys = val * sigmoidf_(gate);
                    const unsigned w0 = g0[m][e >> 1], w1 = g1[m][e >> 1], wy = yn[m][e >> 1];
                    const float a0 = (e & 1) ? bfhi(w0) : bflo(w0), a1 = (e & 1) ? bfhi(w1) : bflo(w1), yy = (e & 1) ? bfhi(wy) : bflo(wy);
                    o[e] = a0 * ys + a1 * yy; }
                u32x4 w; w.x = pk2(o[0], o[1]); w.y = pk2(o[2], o[3]); w.z = pk2(o[4], o[5]); w.w = pk2(o[6], o[7]);
                *(u32x4*)((bf16_t*)(ws + WS_MERGED) + (size_t)row * 1024 + col) = w; }
        }
    }
};
struct EpiWout {
    static constexpr bool PERM = false;
    const float* x; float* out; const float* gmod;
    __device__ __forceinline__ void operator()(const f32x4 (&acc)[2][2][4][2], const Unit& u, int wr, int wc, int fr, int fq) const {
        const int b = u.pm >> 5;
#pragma unroll
        for (int bj = 0; bj < 2; ++bj)
#pragma unroll
            for (int n = 0; n < 2; ++n) {
                const int col = u.pn * 256 + 128 * bj + 32 * wc + 16 * n + 4 * fq; const f32x4 gv = *(const f32x4*)(gmod + (size_t)b * 6144 + col);
                f32x4 xv[2][4];
#pragma unroll
                for (int ai = 0; ai < 2; ++ai)
#pragma unroll
                    for (int m = 0; m < 4; ++m) xv[ai][m] = *(const f32x4*)(x + (size_t)(u.pm * 256 + 128 * ai + 64 * wr + 16 * m + fr) * 1024 + col);
#pragma unroll
                for (int ai = 0; ai < 2; ++ai)
#pragma unroll
                    for (int m = 0; m < 4; ++m) *(f32x4*)(out + (size_t)(u.pm * 256 + 128 * ai + 64 * wr + 16 * m + fr) * 1024 + col) = xv[ai][m] * DN_ALPHA + gv * acc[ai][bj][m][n];
            }
    }
};
struct EpiF32 {
    static constexpr bool PERM = false;
    float* C; int ldc;
    __device__ __forceinline__ void operator()(const f32x4 (&acc)[2][2][4][2], const Unit& u, int wr, int wc, int fr, int fq) const {
#pragma unroll
        for (int ai = 0; ai < 2; ++ai)
#pragma unroll
            for (int m = 0; m < 4; ++m) { float* rowp = C + (size_t)(u.pm * 256 + 128 * ai + 64 * wr + 16 * m + fr) * ldc + u.pn * 256 + 32 * wc + 4 * fq;
#pragma unroll
                for (int bj = 0; bj < 2; ++bj)
#pragma unroll
                    for (int n = 0; n < 2; ++n) *(f32x4*)(rowp + bj * 128 + n * 16) = acc[ai][bj][m][n]; }
    }
};
struct EpiSwiglu {
    static constexpr bool PERM = true;
    bf16_t* H;
    __device__ __forceinline__ void operator()(const f32x4 (&acc)[2][2][4][2], const Unit& u, int wr, int wc, int fr, int fq) const {
#pragma unroll
        for (int ai = 0; ai < 2; ++ai)
#pragma unroll
            for (int m = 0; m < 4; ++m) {
                const size_t row = (size_t)u.pm * 256 + 128 * ai + 64 * wr + 16 * m + fr; const int col = u.pn * 128 + 32 * wc + 8 * fq;
                float o[8];
#pragma unroll
                for (int e = 0; e < 8; ++e) o[e] = siluf_(acc[ai][0][m][e >> 2][e & 3]) * acc[ai][1][m][e >> 2][e & 3];
                u32x4 w; w.x = pk2(o[0], o[1]); w.y = pk2(o[2], o[3]); w.z = pk2(o[4], o[5]); w.w = pk2(o[6], o[7]);
                *(u32x4*)(H + row * 256 + col) = w;
            }
    }
};

__device__ __forceinline__ int find_expert(const LAS int* tstart, int tau) {
    int lo = 0, hi = 256;
    while (hi - lo > 1) { const int mid = (lo + hi) >> 1; if (tstart[mid] <= tau) lo = mid; else hi = mid; }
    return lo;
}
struct SchedMoeGU {
    const char* abase; unsigned a_kstep; int K; const LAS int* tstart; const int* rowasg; const char* W; int G, c;
    __device__ __forceinline__ bool next(int i, Unit& u) const { const int x = c & 7, slot = c >> 3, per = (G >> 3) >> 1; const int tau = (i * 8 + x) * per + (slot >> 1); if ((G & 15) != 0 || tau >= tstart[256]) { if ((G & 15) != 0) { const int L = i * G + c; if (L >= 2 * tstart[256]) return false; u.pm = L >> 1; u.pn = L & 1; return true; } return false; } u.pm = tau; u.pn = slot & 1; return true; }
    __device__ __forceinline__ unsigned a_off(const Unit& u, int R) const { const int a = rowasg[u.pm * 256 + R]; const unsigned tok = a < 0 ? (unsigned)MTOK : (unsigned)a >> 3; return (unsigned)WS_H2 + tok * 2048u; }
    __device__ __forceinline__ const char* b_ptr(const Unit& u) const { const int e = find_expert(tstart, u.pm); return W + ((size_t)e * 512 + u.pn * 256) * 1024 * 2; }
};
struct SchedMoeD {
    const char* abase; unsigned a_kstep; int K; const LAS int* tstart; const char* W; int G, c;
    __device__ __forceinline__ bool next(int i, Unit& u) const { const int x = c & 7, slot = c >> 3, per = (G >> 3) >> 2; const int tau = (i * 8 + x) * per + (slot >> 2); if ((G & 31) != 0 || tau >= tstart[256]) { if ((G & 31) != 0) { const int L = i * G + c; if (L >= 4 * tstart[256]) return false; u.pm = L >> 2; u.pn = L & 3; return true; } return false; } u.pm = tau; u.pn = slot & 3; return true; }
    __device__ __forceinline__ unsigned a_off(const Unit& u, int R) const { return (unsigned)WS_HID + (unsigned)(u.pm * 256 + R) * 512u; }
    __device__ __forceinline__ const char* b_ptr(const Unit& u) const { const int e = find_expert(tstart, u.pm); return W + ((size_t)e * 1024 + u.pn * 256) * 256 * 2; }
};
struct EpiMoeDown {
    static constexpr bool PERM = true;
    unsigned char* O; const int* rowasg; const float* roww; int asg0;
    __device__ __forceinline__ void operator()(const f32x4 (&acc)[2][2][4][2], const Unit& u, int wr, int wc, int fr, int fq) const {
        int av[2][4]; float wv[2][4];
#pragma unroll
        for (int ai = 0; ai < 2; ++ai)
#pragma unroll
            for (int m = 0; m < 4; ++m) { const int row = u.pm * 256 + 128 * ai + 64 * wr + 16 * m + fr; av[ai][m] = rowasg[row]; wv[ai][m] = roww[row] * OUTS_SCALE; }
#pragma unroll
        for (int ai = 0; ai < 2; ++ai)
#pragma unroll
            for (int m = 0; m < 4; ++m) {
                const int a = av[ai][m]; const float w = wv[ai][m];
                if (a >= 0) { unsigned char* rowp = O + (size_t)(a - asg0) * 1024 + u.pn * 256 + 32 * wc + 8 * fq;
#pragma unroll
                    for (int bj = 0; bj < 2; ++bj) { f32x4 x0 = acc[ai][bj][m][0] * w, x1 = acc[ai][bj][m][1] * w;
#pragma unroll
                        for (int e = 0; e < 4; ++e) { x0[e] = fminf(fmaxf(x0[e], -440.f), 440.f); x1[e] = fminf(fmaxf(x1[e], -440.f), 440.f); }
                        int w0 = __builtin_amdgcn_cvt_pk_fp8_f32(x0[0], x0[1], 0, false); w0 = __builtin_amdgcn_cvt_pk_fp8_f32(x0[2], x0[3], w0, true);
                        int w1 = __builtin_amdgcn_cvt_pk_fp8_f32(x1[0], x1[1], 0, false); w1 = __builtin_amdgcn_cvt_pk_fp8_f32(x1[2], x1[3], w1, true);
                        u32x2 o; o.x = (unsigned)w0; o.y = (unsigned)w1; *(u32x2*)(rowp + bj * 128) = o; } }
            }
    }
};
struct EpiShDown {
    static constexpr bool PERM = true;
    unsigned char* O;
    __device__ __forceinline__ void operator()(const f32x4 (&acc)[2][2][4][2], const Unit& u, int wr, int wc, int fr, int fq) const {
#pragma unroll
        for (int ai = 0; ai < 2; ++ai)
#pragma unroll
            for (int m = 0; m < 4; ++m) { unsigned char* rowp = O + (size_t)(u.pm * 256 + 128 * ai + 64 * wr + 16 * m + fr) * 1024 + u.pn * 256 + 32 * wc + 8 * fq;
#pragma unroll
                for (int bj = 0; bj < 2; ++bj) { f32x4 x0 = acc[ai][bj][m][0] * OUTS_SCALE, x1 = acc[ai][bj][m][1] * OUTS_SCALE;
#pragma unroll
                    for (int e = 0; e < 4; ++e) { x0[e] = fminf(fmaxf(x0[e], -440.f), 440.f); x1[e] = fminf(fmaxf(x1[e], -440.f), 440.f); }
                    int w0 = __builtin_amdgcn_cvt_pk_fp8_f32(x0[0], x0[1], 0, false); w0 = __builtin_amdgcn_cvt_pk_fp8_f32(x0[2], x0[3], w0, true);
                    int w1 = __builtin_amdgcn_cvt_pk_fp8_f32(x1[0], x1[1], 0, false); w1 = __builtin_amdgcn_cvt_pk_fp8_f32(x1[2], x1[3], w1, true);
                    u32x2 o; o.x = (unsigned)w0; o.y = (unsigned)w1; *(u32x2*)(rowp + bj * 128) = o; } }
    }
};

__device__ __forceinline__ void transpose_item(const float* src, size_t ld, int nvalid, bf16_t* dst, size_t dld, LAS float* scr, int lane) {
    { const int j4 = lane & 7, k8 = lane >> 3;
        f32x4 v[8];
#pragma unroll
        for (int i = 0; i < 8; ++i) v[i] = 4 * j4 < nvalid ? *(const f32x4*)(src + (size_t)(8 * i + k8) * ld + 4 * j4) : (f32x4){0.f, 0.f, 0.f, 0.f};
#pragma unroll
        for (int i = 0; i < 8; ++i) { LAS float* d = scr + (8 * i + k8) * 33 + 4 * j4; d[0] = v[i][0]; d[1] = v[i][1]; d[2] = v[i][2]; d[3] = v[i][3]; } }
    LDS_WAIT(); asm volatile("" ::: "memory");
    const int c = lane & 7;
#pragma unroll
    for (int j = 0; j < 4; ++j) { const int n = (lane >> 3) + 8 * j; const LAS float* s = scr + (8 * c) * 33 + n;
        u32x4 o; o.x = pk2(s[0 * 33], s[1 * 33]); o.y = pk2(s[2 * 33], s[3 * 33]); o.z = pk2(s[4 * 33], s[5 * 33]); o.w = pk2(s[6 * 33], s[7 * 33]);
        *(u32x4*)(dst + (size_t)n * dld + 8 * c) = o; }
    LDS_WAIT(); asm volatile("" ::: "memory");
}
__device__ __forceinline__ void transpose_item2(const float* srcA, size_t ldA, bf16_t* dstA, size_t dldA, const float* srcB, size_t ldB, bf16_t* dstB, size_t dldB, LAS float* scr, int lane) {
    const int j4 = lane & 7, k8 = lane >> 3, c = lane & 7;
    f32x4 va[8], vb[8];
#pragma unroll
    for (int i = 0; i < 8; ++i) va[i] = *(const f32x4*)(srcA + (size_t)(8 * i + k8) * ldA + 4 * j4);
#pragma unroll
    for (int i = 0; i < 8; ++i) vb[i] = *(const f32x4*)(srcB + (size_t)(8 * i + k8) * ldB + 4 * j4);
#pragma unroll
    for (int i = 0; i < 8; ++i) { LAS float* d = scr + (8 * i + k8) * 33 + 4 * j4; d[0] = va[i][0]; d[1] = va[i][1]; d[2] = va[i][2]; d[3] = va[i][3]; }
    LDS_WAIT(); asm volatile("" ::: "memory");
#pragma unroll
    for (int j = 0; j < 4; ++j) { const int n = (lane >> 3) + 8 * j; const LAS float* sp = scr + (8 * c) * 33 + n;
        u32x4 o; o.x = pk2(sp[0 * 33], sp[1 * 33]); o.y = pk2(sp[2 * 33], sp[3 * 33]); o.z = pk2(sp[4 * 33], sp[5 * 33]); o.w = pk2(sp[6 * 33], sp[7 * 33]);
        *(u32x4*)(dstA + (size_t)n * dldA + 8 * c) = o; }
    LDS_WAIT(); asm volatile("" ::: "memory");
#pragma unroll
    for (int i = 0; i < 8; ++i) { LAS float* d = scr + (8 * i + k8) * 33 + 4 * j4; d[0] = vb[i][0]; d[1] = vb[i][1]; d[2] = vb[i][2]; d[3] = vb[i][3]; }
    LDS_WAIT(); asm volatile("" ::: "memory");
#pragma unroll
    for (int j = 0; j < 4; ++j) { const int n = (lane >> 3) + 8 * j; const LAS float* sp = scr + (8 * c) * 33 + n;
        u32x4 o; o.x = pk2(sp[0 * 33], sp[1 * 33]); o.y = pk2(sp[2 * 33], sp[3 * 33]); o.z = pk2(sp[4 * 33], sp[5 * 33]); o.w = pk2(sp[6 * 33], sp[7 * 33]);
        *(u32x4*)(dstB + (size_t)n * dldB + 8 * c) = o; }
    LDS_WAIT(); asm volatile("" ::: "memory");
}
struct In {
    const float *x, *c, *ada_w, *ada_b, *w_in, *lam_re, *lam_im, *log_step, *b_re, *b_im, *c_re, *c_im, *ssm_d, *glu_w, *cmp_pos, *cmp_w1, *cmp_w2, *rel_bias, *w_out,
        *ln1_g, *ln1_b, *router_w, *router_bias, *w_gate, *w_up, *w_down, *sh_gate, *sh_up, *sh_down, *ln2_g, *ln2_b;
};
static_assert(sizeof(In) == 31 * sizeof(void*), "In");

__device__ __forceinline__ void p0_small_weights(const In& in, unsigned char* ws, LAS float* scr, int gw, int NGW, int lane) {
    constexpr int I_WIN = 168 * 16, I_GLU = 64 * 8, I_WOUT = 32 * 16, I_ROUT = 8 * 16, I_SHGU = 16 * 16, I_SHD = 32 * 4, I_CW1 = 2 * 8 * 32, I_CW2 = 2 * 2 * 4;
    constexpr int NITEMS = I_WIN + I_GLU + I_WOUT + I_ROUT + I_SHGU + I_SHD + I_CW1 + I_CW2;
    for (int it = gw; it < NITEMS; it += NGW) {
        int r = it;
        if (r < I_WIN) { const int db = r / 16, kb = r % 16, n0 = 32 * db; int src, nv = 32;
            if (n0 < 3072) src = n0; else if (n0 < 5120) src = n0 + 48; else if (n0 < 5152) src = n0 - 2048; else if (n0 == 5152) { src = 3104; nv = 16; } else { src = 0; nv = 0; }
            transpose_item(in.w_in + (size_t)(64 * kb) * 5168 + src, 5168, nv, (bf16_t*)(ws + WS_WIN) + (size_t)n0 * 1024 + 64 * kb, 1024, scr, lane); continue; } r -= I_WIN;
        if (r < I_GLU) { const int db = r / 8, kb = r % 8, n0 = 32 * db, pn = n0 >> 8, half = (n0 >> 7) & 1, j = n0 & 127;
            transpose_item(in.glu_w + (size_t)(64 * kb) * 2048 + half * 1024 + pn * 128 + j, 2048, 32, (bf16_t*)(ws + WS_GLU) + (size_t)n0 * 512 + 64 * kb, 512, scr, lane); continue; } r -= I_GLU;
        if (r < I_WOUT) { const int db = r / 16, kb = r % 16;
            transpose_item(in.w_out + (size_t)(64 * kb) * 1024 + 32 * db, 1024, 32, (bf16_t*)(ws + WS_WOUT) + (size_t)(32 * db) * 1024 + 64 * kb, 1024, scr, lane); continue; } r -= I_WOUT;
        if (r < I_ROUT) { const int db = r / 16, kb = r % 16;
            transpose_item(in.router_w + (size_t)(64 * kb) * 256 + 32 * db, 256, 32, (bf16_t*)(ws + WS_ROUT) + (size_t)(32 * db) * 1024 + 64 * kb, 1024, scr, lane); continue; } r -= I_ROUT;
        if (r < I_SHGU) { const int db = r / 16, kb = r % 16, n0 = 32 * db, pn = n0 >> 8, half = (n0 >> 7) & 1, j = n0 & 127;
            transpose_item((half ? in.sh_up : in.sh_gate) + (size_t)(64 * kb) * 256 + pn * 128 + j, 256, 32, (bf16_t*)(ws + WS_SHGU) + (size_t)n0 * 1024 + 64 * kb, 1024, scr, lane); continue; } r -= I_SHGU;
        if (r < I_SHD) { const int db = r / 4, kb = r % 4;
            transpose_item(in.sh_down + (size_t)(64 * kb) * 1024 + 32 * db, 1024, 32, (bf16_t*)(ws + WS_SHD) + (size_t)(32 * db) * 256 + 64 * kb, 256, scr, lane); continue; } r -= I_SHD;
        if (r < I_CW1) { const int ts = r / 256, rr = r % 256, db = rr / 32, kb = rr % 32;
            transpose_item(in.cmp_w1 + (size_t)ts * 2048 * 256 + (size_t)(64 * kb) * 256 + 32 * db, 256, 32, (bf16_t*)(ws + WS_CW1) + (size_t)ts * 256 * 2048 + (size_t)(32 * db) * 2048 + 64 * kb, 2048, scr, lane); continue; } r -= I_CW1;
        { const int ts = r / 8, rr = r % 8, db = rr / 4, kb = rr % 4;
            transpose_item(in.cmp_w2 + (size_t)ts * 256 * 64 + (size_t)(64 * kb) * 64 + 32 * db, 64, 32, (bf16_t*)(ws + WS_CW2) + (size_t)ts * 256 * 256 + (size_t)(32 * db) * 256 + 64 * kb, 256, scr, lane); }
    }
    for (int i = gw * 64 + lane; i < 2 * 192 * 32; i += NGW * 64) { const int ts = i / (192 * 32), rr = i % (192 * 32); *(u32x4*)(ws + WS_CW2 + (size_t)ts * 256 * 512 + (size_t)64 * 512 + (size_t)rr * 16) = (u32x4){0u, 0u, 0u, 0u}; }
}
struct ConvItem { const float* src; size_t ld; bf16_t* dst; size_t dld; };
__device__ __forceinline__ void convert_expert_weights(const In& in, unsigned char* ws, LAS float* scr, int gw, int NGW, int lane, int part) {
    constexpr int I_GU = 256, I_D = 128;
    bool have = false; ConvItem pa{nullptr, 0, nullptr, 0};
    for (int it = gw; it < NEXP * (I_GU + I_D); it += NGW) {
        const int e = it / (I_GU + I_D), r = it % (I_GU + I_D);
        { const bool mid = e >= 63 && e <= 190; const bool early = r >= I_GU || !mid; if (early != (part == 0)) continue; }
        ConvItem d;
        if (r < I_GU) { const int db = r / 16, kb = r % 16, n0 = 32 * db, pn = n0 >> 8, half = (n0 >> 7) & 1, j = n0 & 127;
            d.src = (half ? in.w_up : in.w_gate) + (size_t)e * 1024 * 256 + (size_t)(64 * kb) * 256 + pn * 128 + j; d.ld = 256; d.dst = (bf16_t*)(ws + WS_WGU) + ((size_t)e * 512 + n0) * 1024 + 64 * kb; d.dld = 1024; }
        else { const int rr = r - I_GU, db = rr / 4, kb = rr % 4;
            d.src = in.w_down + (size_t)e * 256 * 1024 + (size_t)(64 * kb) * 1024 + 32 * db; d.ld = 1024; d.dst = (bf16_t*)(ws + WS_WD) + ((size_t)e * 1024 + 32 * db) * 256 + 64 * kb; d.dld = 256; }
        if (!have) { pa = d; have = true; }
        else { transpose_item2(pa.src, pa.ld, pa.dst, pa.dld, d.src, d.ld, d.dst, d.dld, scr, lane); have = false; }
    }
    if (have) transpose_item(pa.src, pa.ld, 32, pa.dst, pa.dld, scr, lane);
}

__device__ __forceinline__ void p0_mod(const In& in, unsigned char* ws, LAS unsigned char* lds, int tid) {
    LAS float* cond = (LAS float*)lds;
    LAS float* part = (LAS float*)(lds + 32768);
    for (int i = tid; i < 8192; i += NTHREADS) cond[i] = siluf_(in.c[i]);
    __syncthreads();
    const int col = tid % 24, ks = tid / 24, e = (int)blockIdx.x * 24 + col;
    if (tid < 504) {
        float a[8];
#pragma unroll
        for (int b = 0; b < 8; ++b) a[b] = 0.f;
        for (int k = ks; k < 1024; k += 21) { const float w = in.ada_w[(size_t)k * 6144 + e];
#pragma unroll
            for (int b = 0; b < 8; ++b) a[b] += cond[b * 1024 + k] * w; }
#pragma unroll
        for (int b = 0; b < 8; ++b) part[(ks * 24 + col) * 8 + b] = a[b];
    }
    __syncthreads();
    if (tid < 192) { const int c2 = tid % 24, b = tid / 24; float s = 0.f; for (int k = 0; k < 21; ++k) s += part[(k * 24 + c2) * 8 + b];
        const int e2 = (int)blockIdx.x * 24 + c2; ((float*)(ws + WS_MOD))[b * 6144 + e2] = s + in.ada_b[e2]; }
    __syncthreads();
}
__device__ __forceinline__ void p0_tables(const In& in, unsigned char* ws, LAS unsigned char* lds, int tid) {
    const int w = (int)blockIdx.x;
    if (w < 16) {
        const int ts = w >> 3, kq = w & 7, c = tid & 255, kh = tid >> 8; float s = 0.f;
        const float* pos = in.cmp_pos + ts * 2048; const float* w1 = in.cmp_w1 + (size_t)ts * 2048 * 256;
        for (int k = kq * 256 + kh * 128; k < kq * 256 + kh * 128 + 128; ++k) s += pos[k] * w1[(size_t)k * 256 + c];
        ((float*)(ws + WS_CTL + 131072))[((ts * 8 + kq) * 2 + kh) * 256 + c] = s;
    } else if (w == 16) {
        for (int i = tid; i < 16 * 132; i += NTHREADS) { const int h = i / 132, dd = i % 132; int bk;
            if (dd < 16) bk = dd; else { const int v = 16 + (int)(__logf((float)dd * (1.0f / 16.0f)) / 2.0794415416798357f * 16.0f); bk = v < 31 ? v : 31; }
            if (dd >= 128) bk = 31;
            ((float*)(ws + WS_TAB + TAB_LUT))[i] = in.rel_bias[bk * 16 + h] * 1.4426950408889634f; }
    } else if (w >= 32 && w < 64) {
        const int g = w - 32;
        LAS float* bbr = (LAS float*)lds; LAS float* bbi = bbr + 1024;
        if (tid < 64) { const int p = tid; const float lr = in.lam_re[g * 64 + p], li = in.lam_im[g * 64 + p], dt = expf(in.log_step[g]);
            const float mag = expf(lr * dt), ar = mag * cosf(li * dt), ai = mag * sinf(li * dt), den = lr * lr + li * li;
            const float kr = ((ar - 1.0f) * lr + ai * li) / den, ki = (ai * lr - (ar - 1.0f) * li) / den;
            for (int c = 0; c < 16; ++c) { const float br = in.b_re[(g * 64 + p) * 16 + c], bi = in.b_im[(g * 64 + p) * 16 + c]; bbr[p * 16 + c] = kr * br - ki * bi; bbi[p * 16 + c] = kr * bi + ki * br; }
            float* A = (float*)(ws + WS_S5T + S5_A) + (g * 64 + p) * 2; A[0] = ar; A[1] = ai;
            float xr = ar, xi = ai; for (int s = 0; s < 10; ++s) { const float nr = xr * xr - xi * xi, ni = 2.0f * xr * xi; xr = nr; xi = ni; }
            float* AC = (float*)(ws + WS_S5T + S5_AC) + (g * 64 + p) * 2; AC[0] = xr; AC[1] = xi; }
        __syncthreads();
        { const int f = tid >> 6, lane = tid & 63, pt = f >> 1, ri = f & 1, p = 16 * pt + (lane & 15), q = lane >> 4;
            bf16_t* dst = (bf16_t*)(ws + WS_S5T + S5_AFR) + ((size_t)(g * 8 + f) * 64 + lane) * 8;
            for (int j = 0; j < 8; ++j) { const float v = q < 2 ? (ri ? bbi : bbr)[p * 16 + 8 * q + j] : 0.f; dst[j] = (bf16_t)f2bf(v); } }
        if (tid < 256) { const int s = tid >> 6, lane = tid & 63, c = lane & 15, q = lane >> 4;
            bf16_t* dst = (bf16_t*)(ws + WS_S5T + S5_CFR) + ((size_t)(g * 4 + s) * 64 + lane) * 8;
            for (int j = 0; j < 8; ++j) { const int k = 32 * s + 8 * q + j, p = k >> 1; const float v = (k & 1) ? -in.c_im[(g * 16 + c) * 64 + p] : in.c_re[(g * 16 + c) * 64 + p]; dst[j] = (bf16_t)f2bf(v); } }
        __syncthreads();
    }
}

struct RowV { f32x4 v[4]; };
__device__ __forceinline__ RowV row_load(const float* p, int lane) { RowV r; const f32x4* q = (const f32x4*)p + lane;
#pragma unroll
    for (int j = 0; j < 4; ++j) r.v[j] = q[64 * j]; return r; }
__device__ __forceinline__ void row_norm(RowV& r) {
    float s = 0.f;
#pragma unroll
    for (int j = 0; j < 4; ++j) s += (r.v[j].x + r.v[j].y) + (r.v[j].z + r.v[j].w);
    const float mean = wave_sum(s) * (1.f / DM); float s2 = 0.f;
#pragma unroll
    for (int j = 0; j < 4; ++j) { r.v[j] = r.v[j] - mean; s2 += (r.v[j].x * r.v[j].x + r.v[j].y * r.v[j].y) + (r.v[j].z * r.v[j].z + r.v[j].w * r.v[j].w); }
    const float rstd = 1.f / sqrtf(wave_sum(s2) * (1.f / DM) + LN_EPS);
#pragma unroll
    for (int j = 0; j < 4; ++j) r.v[j] = r.v[j] * rstd;
}
__device__ __forceinline__ void row_norm_stats(RowV& r, float& mean_o, float& rstd_o) {
    float s = 0.f;
#pragma unroll
    for (int j = 0; j < 4; ++j) s += (r.v[j].x + r.v[j].y) + (r.v[j].z + r.v[j].w);
    const float mean = wave_sum(s) * (1.f / DM); float s2 = 0.f;
#pragma unroll
    for (int j = 0; j < 4; ++j) { r.v[j] = r.v[j] - mean; s2 += (r.v[j].x * r.v[j].x + r.v[j].y * r.v[j].y) + (r.v[j].z * r.v[j].z + r.v[j].w * r.v[j].w); }
    const float rstd = 1.f / sqrtf(wave_sum(s2) * (1.f / DM) + LN_EPS);
#pragma unroll
    for (int j = 0; j < 4; ++j) r.v[j] = r.v[j] * rstd;
    mean_o = mean; rstd_o = rstd;
}
__device__ __forceinline__ void row_store_bf16(bf16_t* p, const RowV& r, int lane) { u32x2* o = (u32x2*)p + lane;
#pragma unroll
    for (int j = 0; j < 4; ++j) { u32x2 w; w.x = pk2(r.v[j].x, r.v[j].y); w.y = pk2(r.v[j].z, r.v[j].w); o[64 * j] = w; } }
__device__ __forceinline__ void ph_h1(const In& in, unsigned char* ws, int gw, int NGW, int lane) {
    const float* mod = (const float*)(ws + WS_MOD);
    for (int row = gw; row < MTOK; row += NGW) { const int b = row >> 13;
        RowV r = row_load(in.x + (size_t)row * DM, lane); row_norm(r);
        const RowV sh = row_load(mod + b * 6144, lane), sc = row_load(mod + b * 6144 + 1024, lane);
#pragma unroll
        for (int j = 0; j < 4; ++j) r.v[j] = r.v[j] * (sc.v[j] + 1.0f) + sh.v[j];
        row_store_bf16((bf16_t*)(ws + WS_H1) + (size_t)row * DM, r, lane); }
}
__device__ __forceinline__ void ph_ln1(const In& in, unsigned char* ws, float* r1, int gw, int NGW, int lane) {
    const float* mod = (const float*)(ws + WS_MOD);
    const RowV g = row_load(in.ln1_g, lane), bb = row_load(in.ln1_b, lane);
    for (int row = gw; row < MTOK; row += NGW) { const int b = row >> 13;
        RowV r = row_load(r1 + (size_t)row * DM, lane); float mean, rstd; row_norm_stats(r, mean, rstd);
        if (lane == 0) *(f32x2*)((float*)(ws + WS_LNST) + (size_t)row * 2) = (f32x2){mean, rstd};
#pragma unroll
        for (int j = 0; j < 4; ++j) r.v[j] = r.v[j] * g.v[j] + bb.v[j];
        row_norm(r);
        const RowV sh = row_load(mod + b * 6144 + 3072, lane), sc = row_load(mod + b * 6144 + 4096, lane);
#pragma unroll
        for (int j = 0; j < 4; ++j) r.v[j] = r.v[j] * (sc.v[j] + 1.0f) + sh.v[j];
        row_store_bf16((bf16_t*)(ws + WS_H2) + (size_t)row * DM, r, lane); }
}
__device__ __forceinline__ void final_row(const In& in, unsigned char* ws, float* out, int tok, int chunk, const RowV& g, const RowV& bb, const RowV& g1, const RowV& b1, int lane) {
    const float* mod = (const float*)(ws + WS_MOD); const int b = tok >> 13;
    RowV v = row_load(out + (size_t)tok * DM, lane); const RowV g2 = row_load(mod + b * 6144 + 5120, lane);
    const f32x2 stt = *(const f32x2*)((const float*)(ws + WS_LNST) + (size_t)tok * 2);
    const unsigned* sp = (const unsigned*)(ws + WS_OUTS + (size_t)(tok - chunk * CHUNK_TOK) * 8 * DM) + lane;
    const unsigned* shp = (const unsigned*)(ws + WS_SHOUT + (size_t)tok * DM) + lane;
    f32x4 acc[4];
#pragma unroll
    for (int j = 0; j < 4; ++j) { const int w = (int)shp[64 * j]; const f32x2 lo = __builtin_amdgcn_cvt_pk_f32_fp8(w, false), hi = __builtin_amdgcn_cvt_pk_f32_fp8(w, true); acc[j] = (f32x4){lo.x, lo.y, hi.x, hi.y}; }
#pragma unroll
    for (int k = 0; k < 8; ++k)
#pragma unroll
        for (int j = 0; j < 4; ++j) { const int w = (int)sp[k * 256 + 64 * j]; const f32x2 lo = __builtin_amdgcn_cvt_pk_f32_fp8(w, false), hi = __builtin_amdgcn_cvt_pk_f32_fp8(w, true);
            acc[j] = acc[j] + (f32x4){lo.x, lo.y, hi.x, hi.y}; }
#pragma unroll
    for (int j = 0; j < 4; ++j) { const f32x4 x1 = (v.v[j] - stt.x) * stt.y * g1.v[j] + b1.v[j]; v.v[j] = x1 * DN_ALPHA + g2.v[j] * (acc[j] * (1.0f / OUTS_SCALE)); }
    row_norm(v);
    f32x4* o = (f32x4*)(out + (size_t)tok * DM) + lane;
#pragma unroll
    for (int j = 0; j < 4; ++j) o[64 * j] = v.v[j] * g.v[j] + bb.v[j];
}
__device__ __forceinline__ void final_chunk(const In& in, unsigned char* ws, float* out, unsigned* ticket, int chunk, volatile LAS unsigned* bcast, int tid, int wave, int lane) {
    int ll = lane; asm volatile("" : "+v"(ll));
    const RowV g = row_load(in.ln2_g, ll), bb = row_load(in.ln2_b, ll), g1 = row_load(in.ln1_g, ll), b1 = row_load(in.ln1_b, ll);
    for (;;) {
        __syncthreads();
        if (tid == 0) bcast[0] = __hip_atomic_fetch_add(ticket, 64u, RLX_AGENT);
        __syncthreads();
        const unsigned base = bcast[0];
        if (base >= (unsigned)chunk_ntok(chunk)) break;
        for (int i = 0; i < 8; ++i) final_row(in, ws, out, chunk * CHUNK_TOK + (int)base + wave * 8 + i, chunk, g, bb, g1, b1, lane);
    }
}
constexpr int S5_LDS_PER_WAVE = 4352;
template <bool FULL>
__device__ __forceinline__ void s5_task(const In& in, unsigned char* ws, LAS unsigned char* wlds, int b, int g, int ch, int lane) {
    const int col = lane & 15, q = lane >> 4;
    LAS unsigned* BU = (LAS unsigned*)wlds;
    LAS unsigned char* XB = wlds;
    bf16x8 afr[8], cfr[4];
#pragma unroll
    for (int f = 0; f < 8; ++f) afr[f] = *(const bf16x8*)((const bf16_t*)(ws + WS_S5T + S5_AFR) + ((size_t)(g * 8 + f) * 64 + lane) * 8);
    if (FULL) {
#pragma unroll
        for (int s = 0; s < 4; ++s) cfr[s] = *(const bf16x8*)((const bf16_t*)(ws + WS_S5T + S5_CFR) + ((size_t)(g * 4 + s) * 64 + lane) * 8);
    }
    const float ar = ((const float*)(ws + WS_S5T + S5_A))[(g * 64 + lane) * 2], ai = ((const float*)(ws + WS_S5T + S5_A))[(g * 64 + lane) * 2 + 1];
    float xr = 0.f, xi = 0.f;
    float* st = (float*)(ws + WS_S5ST);
    if (FULL) {
        const float cr_ = ((const float*)(ws + WS_S5T + S5_AC))[(g * 64 + lane) * 2], ci_ = ((const float*)(ws + WS_S5T + S5_AC))[(g * 64 + lane) * 2 + 1];
        for (int c2 = 0; c2 < ch; ++c2) { const float sr = st[((size_t)((b * 32 + g) * 8 + c2) * 64 + lane) * 2], si = st[((size_t)((b * 32 + g) * 8 + c2) * 64 + lane) * 2 + 1];
            const float nr = cr_ * xr - ci_ * xi + sr, ni = cr_ * xi + ci_ * xr + si; xr = nr; xi = ni; }
    }
    const bf16_t* U = (const bf16_t*)(ws + WS_U);
    f32x4 dsk = (f32x4){0.f, 0.f, 0.f, 0.f};
    if (FULL) dsk = *(const f32x4*)(in.ssm_d + g * 16 + 4 * q);
    const size_t row00 = (size_t)b * SEQ + (size_t)ch * 1024;
    for (int sb = 0; sb < 64; ++sb) {
        const size_t row0 = row00 + 16 * sb;
        bf16x8 ufr = (bf16x8){0, 0, 0, 0, 0, 0, 0, 0};
        if (q < 2) ufr = *(const bf16x8*)(U + (row0 + col) * 512 + g * 16 + 8 * q);
#pragma unroll
        for (int pt = 0; pt < 4; ++pt) {
            const f32x4 dr = __builtin_amdgcn_mfma_f32_16x16x32_bf16(afr[2 * pt], ufr, (f32x4){0.f, 0.f, 0.f, 0.f}, 0, 0, 0);
            const f32x4 di = __builtin_amdgcn_mfma_f32_16x16x32_bf16(afr[2 * pt + 1], ufr, (f32x4){0.f, 0.f, 0.f, 0.f}, 0, 0, 0);
            u32x4 w; w.x = pk2(dr[0], di[0]); w.y = pk2(dr[1], di[1]); w.z = pk2(dr[2], di[2]); w.w = pk2(dr[3], di[3]);
            *(LAS u32x4*)(BU + col * 68 + 16 * pt + 4 * q) = w; }
        asm volatile("s_waitcnt lgkmcnt(0)" ::: "memory");
#pragma unroll
        for (int t = 0; t < 16; ++t) { const unsigned bw = BU[t * 68 + lane]; const float br = bflo(bw), bi = bfhi(bw);
            const float nr = ar * xr - ai * xi + br, ni = ar * xi + ai * xr + bi; xr = nr; xi = ni;
            if (FULL) *(LAS unsigned*)(XB + t * 272 + 4 * lane) = pk2(xr, xi); }
        asm volatile("s_waitcnt lgkmcnt(0)" ::: "memory");
        if (FULL) {
            f32x4 y = (f32x4){0.f, 0.f, 0.f, 0.f};
#pragma unroll
            for (int s = 0; s < 4; ++s) { const bf16x8 xf = *(const LAS bf16x8*)(XB + col * 272 + (32 * s + 8 * q) * 2); y = __builtin_amdgcn_mfma_f32_16x16x32_bf16(cfr[s], xf, y, 0, 0, 0); }
            const u32x2 uw = *(const u32x2*)(U + (row0 + col) * 512 + g * 16 + 4 * q);
            const f32x4 uv = (f32x4){bflo(uw.x), bfhi(uw.x), bflo(uw.y), bfhi(uw.y)};
            y = y + dsk * uv;
            u32x2 o; o.x = pk2(gelu_tanh(y[0]), gelu_tanh(y[1])); o.y = pk2(gelu_tanh(y[2]), gelu_tanh(y[3]));
            *(u32x2*)((bf16_t*)(ws + WS_Z) + (row0 + col) * 512 + g * 16 + 4 * q) = o;
            asm volatile("s_waitcnt lgkmcnt(0)" ::: "memory");
        }
    }
    if (!FULL) { st[((size_t)((b * 32 + g) * 8 + ch) * 64 + lane) * 2] = xr; st[((size_t)((b * 32 + g) * 8 + ch) * 64 + lane) * 2 + 1] = xi; }
}

constexpr int NSA_KB = 0, NSA_VB = 32768, NSA_IMP = 65536, NSA_RES = 65536;
static_assert(NSA_IMP + 67584 <= MISC_OFF && NSA_RES + 65536 <= MISC_OFF, "attention LDS map");
__device__ __forceinline__ bf16x8 pack8(const f32x4& a, const f32x4& b) {
    u32x4 w; w.x = pk2(a[0], a[1]); w.y = pk2(a[2], a[3]); w.z = pk2(b[0], b[1]); w.w = pk2(b[2], b[3]); return __builtin_bit_cast(bf16x8, w);
}
struct Softmax { float m; f32x4 l; };
typedef unsigned u32x2s __attribute__((ext_vector_type(2)));
__device__ __forceinline__ float fmax_x16(float x) { return fmaxf(x, __shfl_xor(x, 16)); }
__device__ __forceinline__ float fmax_x32(float x) { return fmaxf(x, __shfl_xor(x, 32)); }
__device__ __forceinline__ float fadd_x16(float x) { return x + __shfl_xor(x, 16); }
__device__ __forceinline__ float fadd_x32(float x) { return x + __shfl_xor(x, 32); }
__device__ __forceinline__ unsigned or_x16(unsigned u) { return u | __shfl_xor(u, 16); }
__device__ __forceinline__ unsigned or_x32(unsigned u) { return u | __shfl_xor(u, 32); }
__device__ __forceinline__ float dpp_x1(float x) { return __builtin_bit_cast(float, __builtin_amdgcn_update_dpp(0, __builtin_bit_cast(int, x), 0xB1, 0xF, 0xF, true)); }
__device__ __forceinline__ float dpp_x2(float x) { return __builtin_bit_cast(float, __builtin_amdgcn_update_dpp(0, __builtin_bit_cast(int, x), 0x4E, 0xF, 0xF, true)); }
__device__ __forceinline__ int dpp_x1i(int x) { return __builtin_amdgcn_update_dpp(0, x, 0xB1, 0xF, 0xF, true); }
__device__ __forceinline__ int dpp_x2i(int x) { return __builtin_amdgcn_update_dpp(0, x, 0x4E, 0xF, 0xF, true); }
__device__ __forceinline__ float ex2(float x) { return __builtin_amdgcn_exp2f(x); }
__device__ __forceinline__ float max16(const f32x4 (&S)[4]) {
    float a = fmaxf(fmaxf(S[0][0], S[0][1]), S[0][2]); a = fmaxf(fmaxf(a, S[0][3]), S[1][0]); a = fmaxf(fmaxf(a, S[1][1]), S[1][2]);
    float b = fmaxf(fmaxf(S[2][0], S[2][1]), S[2][2]); b = fmaxf(fmaxf(b, S[2][3]), S[3][0]); b = fmaxf(fmaxf(b, S[3][1]), S[3][2]);
    return fmaxf(fmaxf(a, S[1][3]), fmaxf(b, S[3][3]));
}
#define ONES8 ((bf16x8){(bf16_t)0x3F80, (bf16_t)0x3F80, (bf16_t)0x3F80, (bf16_t)0x3F80, (bf16_t)0x3F80, (bf16_t)0x3F80, (bf16_t)0x3F80, (bf16_t)0x3F80})
__device__ __forceinline__ void best_pair(float& bv, int& bj, float ov, int oj) { const bool take = ov > bv || (ov == bv && oj < bj); bv = take ? ov : bv; bj = take ? oj : bj; }
__device__ __forceinline__ void best_x16(float& bv, int& bj) { const float ov = __shfl_xor(bv, 16); const int oj = __shfl_xor(bj, 16); best_pair(bv, bj, ov, oj); }
__device__ __forceinline__ void best_x32(float& bv, int& bj) { const float ov = __shfl_xor(bv, 32); const int oj = __shfl_xor(bj, 32); best_pair(bv, bj, ov, oj); }
struct Stage { u32x4 k, v; };
__device__ __forceinline__ void stage_load(Stage& s, const unsigned char* kg, size_t kstride, const unsigned char* vg, size_t vstride, int tid, bool hasv) {
    const int row = tid >> 3, ch = tid & 7;
    s.k = *(const u32x4*)(kg + (size_t)row * kstride + ch * 16);
    if (hasv) s.v = *(const u32x4*)(vg + (size_t)row * vstride + ch * 16);
}
__device__ __forceinline__ void stage_store(const Stage& s, LAS unsigned char* lds, int buf, int tid, bool hasv) {
    const int row = tid >> 3, ch = tid & 7, off = row * 128 + ((ch ^ (row & 7)) << 4);
    *(LAS u32x4*)(lds + NSA_KB + buf * 8192 + off) = s.k;
    if (hasv) *(LAS u32x4*)(lds + NSA_VB + buf * 8192 + off) = s.v;
}
__device__ __forceinline__ bf16x8 lds_frag(const LAS unsigned char* base, int row, int ch) { return *(const LAS bf16x8*)(base + row * 128 + ((ch ^ (row & 7)) << 4)); }

__device__ __forceinline__ void select_blocks(const LAS float* impw, int tl, int r, int q, int cur, unsigned (&w)[4]) {
    w[0] = w[1] = w[2] = w[3] = 0u;
    if (cur < 16) { w[0] = (2u << cur) - 1u; return; }
    const int s16 = r * 4 + q;
    float cand[8];
#pragma unroll
    for (int k = 0; k < 8; ++k) { const int j = s16 + 16 * k; cand[k] = (j >= 1 && j <= cur - 2) ? impw[tl * 264 + j] + impw[tl * 264 + 132 + j] : -1.0f; }
    unsigned chosen = 0u;
    for (int it = 0; it < 13; ++it) {
        float bv = -2.0f; int bj = 1 << 20;
#pragma unroll
        for (int k = 0; k < 8; ++k) { const bool ok = !((chosen >> k) & 1u) && cand[k] > bv; bv = ok ? cand[k] : bv; bj = ok ? s16 + 16 * k : bj; }
        best_pair(bv, bj, dpp_x1(bv), dpp_x1i(bj)); best_pair(bv, bj, dpp_x2(bv), dpp_x2i(bj)); best_x16(bv, bj); best_x32(bv, bj);
        if ((bj & 15) == s16) chosen |= 1u << (bj >> 4);
    }
#pragma unroll
    for (int k = 0; k < 8; ++k) { const unsigned bit = ((chosen >> k) & 1u) << (s16 + 16 * (k & 1)); w[k >> 1] |= bit; }
#pragma unroll
    for (int x = 0; x < 4; ++x) { unsigned v = w[x]; v |= (unsigned)dpp_x1i((int)v); v |= (unsigned)dpp_x2i((int)v); v = or_x16(v); v = or_x32(v); w[x] = v; }
    w[0] |= 1u;
#pragma unroll
    for (int x = 0; x < 4; ++x) { if (((cur - 1) >> 5) == x) w[x] |= 1u << ((cur - 1) & 31); if ((cur >> 5) == x) w[x] |= 1u << (cur & 31); }
}

__device__ __forceinline__ float dpp_r4(float x) { return __builtin_bit_cast(float, __builtin_amdgcn_update_dpp(0, __builtin_bit_cast(int, x), 0x124, 0xF, 0xF, true)); }
__device__ __forceinline__ float dpp_r8(float x) { return __builtin_bit_cast(float, __builtin_amdgcn_update_dpp(0, __builtin_bit_cast(int, x), 0x128, 0xF, 0xF, true)); }
__device__ __forceinline__ int dpp_r4i(int x) { return __builtin_amdgcn_update_dpp(0, x, 0x124, 0xF, 0xF, true); }
__device__ __forceinline__ int dpp_r8i(int x) { return __builtin_amdgcn_update_dpp(0, x, 0x128, 0xF, 0xF, true); }
__device__ __forceinline__ void select_blocks8(const LAS float* impw, LAS unsigned* mk, int lane, int cur, unsigned (&u)[2][4]) {
    const int i = lane & 15, k = lane >> 4;
    unsigned m4[2][4];
    if (cur < 16) {
#pragma unroll
        for (int c = 0; c < 2; ++c) { m4[c][0] = (2u << cur) - 1u; m4[c][1] = 0u; m4[c][2] = 0u; m4[c][3] = 0u; }
    } else {
        float cand[2][8]; unsigned chosen[2] = {0u, 0u};
#pragma unroll
        for (int c = 0; c < 2; ++c)
#pragma unroll
            for (int m = 0; m < 8; ++m) { const int j = i + 16 * m; const LAS float* p = impw + (4 * c + k) * 264; cand[c][m] = (j >= 1 && j <= cur - 2) ? p[j] + p[132 + j] : -1.0f; }
        for (int it = 0; it < 13; ++it) {
#pragma unroll
            for (int c = 0; c < 2; ++c) {
                float bv = -2.0f; int bj = 1 << 20;
#pragma unroll
                for (int m = 0; m < 8; ++m) { const bool ok = !((chosen[c] >> m) & 1u) && cand[c][m] > bv; bv = ok ? cand[c][m] : bv; bj = ok ? i + 16 * m : bj; }
                best_pair(bv, bj, dpp_r8(bv), dpp_r8i(bj)); best_pair(bv, bj, dpp_r4(bv), dpp_r4i(bj)); best_pair(bv, bj, dpp_x2(bv), dpp_x2i(bj)); best_pair(bv, bj, dpp_x1(bv), dpp_x1i(bj));
                if ((bj & 15) == i) chosen[c] |= 1u << (bj >> 4);
            }
        }
        const int c1 = cur - 1;
        const unsigned long long flo = 1ull | (c1 < 64 ? 1ull << c1 : 0ull) | (cur < 64 ? 1ull << cur : 0ull), fhi = (c1 >= 64 ? 1ull << (c1 - 64) : 0ull) | (cur >= 64 ? 1ull << (cur - 64) : 0ull);
#pragma unroll
        for (int c = 0; c < 2; ++c) {
#pragma unroll
            for (int x = 0; x < 4; ++x) m4[c][x] = 0u;
#pragma unroll
            for (int m = 0; m < 8; ++m) m4[c][m >> 1] |= ((chosen[c] >> m) & 1u) << (i + 16 * (m & 1));
#pragma unroll
            for (int x = 0; x < 4; ++x) { unsigned v = m4[c][x]; v |= (unsigned)dpp_r8i((int)v); v |= (unsigned)dpp_r4i((int)v); v |= (unsigned)dpp_x2i((int)v); v |= (unsigned)dpp_x1i((int)v); m4[c][x] = v; }
            m4[c][0] |= (unsigned)flo; m4[c][1] |= (unsigned)(flo >> 32); m4[c][2] |= (unsigned)fhi; m4[c][3] |= (unsigned)(fhi >> 32);
        }
    }
#pragma unroll
    for (int c = 0; c < 2; ++c) {
        if (i == 0) *(LAS u32x4*)(mk + (4 * c + k) * 4) = (u32x4){m4[c][0], m4[c][1], m4[c][2], m4[c][3]};
#pragma unroll
        for (int x = 0; x < 4; ++x) { unsigned v = m4[c][x]; v = or_x16(v); v = or_x32(v); u[c][x] = __builtin_amdgcn_readfirstlane(v); }
    }
}

template <int MODE, bool SELMASK>
__device__ __forceinline__ void attn_block(const LAS unsigned char* kb, const LAS unsigned char* vb, const bf16x8 (&qf)[2][2], int col, int q, const int (&tq)[2], int key0, const LAS float* nbq, float bias_far,
                                           bool sel0, bool sel1, Softmax (&st)[2], f32x4 (&O)[2][4]) {
    const f32x4 z4 = (f32x4){0.f, 0.f, 0.f, 0.f};
    const float NEG = -__builtin_inff();
    f32x4 S[2][4];
#pragma unroll
    for (int kt = 0; kt < 4; ++kt) { const bf16x8 k0 = lds_frag(kb, 16 * kt + col, q), k1 = lds_frag(kb, 16 * kt + col, 4 + q);
#pragma unroll
        for (int c = 0; c < 2; ++c) { S[c][kt] = __builtin_amdgcn_mfma_f32_16x16x32_bf16(k0, qf[c][0], z4, 0, 0, 0); S[c][kt] = __builtin_amdgcn_mfma_f32_16x16x32_bf16(k1, qf[c][1], S[c][kt], 0, 0, 0); } }
    float rowb[2] = {bias_far, bias_far}, cm[2];
#pragma unroll
    for (int c = 0; c < 2; ++c) {
        const bool sel = c == 0 ? sel0 : sel1;
        if (MODE == 0) { if (SELMASK) rowb[c] = sel ? bias_far : NEG; }
        else if (MODE == 1) { rowb[c] = (SELMASK && !sel) ? NEG : 0.f;
            const LAS float* bp = nbq - (tq[c] - key0);
#pragma unroll
            for (int kt = 0; kt < 4; ++kt) S[c][kt] = S[c][kt] + *(const LAS f32x4*)(bp + 16 * kt); }
        else {
#pragma unroll
            for (int kt = 0; kt < 4; ++kt)
#pragma unroll
                for (int e = 0; e < 4; ++e) { const int d = tq[c] - (key0 + 16 * kt + 4 * q + e); S[c][kt][e] = d < 512 ? S[c][kt][e] : NEG; } }
        cm[c] = max16(S[c]) + rowb[c];
    }
    if (__any(cm[0] > st[0].m || cm[1] > st[1].m)) {
#pragma unroll
        for (int c = 0; c < 2; ++c) { float x = fmax_x16(cm[c]); x = fmax_x32(x);
            const float mn = fmaxf(st[c].m, x), alpha = ex2(st[c].m - mn);
            st[c].m = mn; st[c].l = st[c].l * alpha;
#pragma unroll
            for (int dt = 0; dt < 4; ++dt) O[c][dt] = O[c][dt] * alpha; }
    }
    bf16x8 pf[2][2];
#pragma unroll
    for (int c = 0; c < 2; ++c) {
        const float off = rowb[c] - st[c].m;
#pragma unroll
        for (int kt = 0; kt < 4; ++kt) { f32x4 p = S[c][kt] + off;
#pragma unroll
            for (int e = 0; e < 4; ++e) p[e] = ex2(p[e]);
            S[c][kt] = p; }
        pf[c][0] = pack8(S[c][0], S[c][1]); pf[c][1] = pack8(S[c][2], S[c][3]);
        st[c].l = __builtin_amdgcn_mfma_f32_16x16x32_bf16(ONES8, pf[c][0], st[c].l, 0, 0, 0); st[c].l = __builtin_amdgcn_mfma_f32_16x16x32_bf16(ONES8, pf[c][1], st[c].l, 0, 0, 0);
    }
#pragma unroll
    for (int c32 = 0; c32 < 2; ++c32)
#pragma unroll
        for (int dt = 0; dt < 4; ++dt) { const bf16x8 vf = lds_frag(vb, 16 * dt + col, 4 * c32 + q);
            O[0][dt] = __builtin_amdgcn_mfma_f32_16x16x32_bf16(vf, pf[0][c32], O[0][dt], 0, 0, 0);
            O[1][dt] = __builtin_amdgcn_mfma_f32_16x16x32_bf16(vf, pf[1][c32], O[1][dt], 0, 0, 0); }
}

template <int C>
__device__ __forceinline__ void attn_block_far1(const LAS unsigned char* kb, const LAS unsigned char* vb, const bf16x8 (&qf)[2][2], int col, int q, float bias_far, bool sel, Softmax (&st)[2], f32x4 (&O)[2][4]) {
    const f32x4 z4 = (f32x4){0.f, 0.f, 0.f, 0.f};
    const float NEG = -__builtin_inff();
    f32x4 S[4];
#pragma unroll
    for (int kt = 0; kt < 4; ++kt) { const bf16x8 k0 = lds_frag(kb, 16 * kt + col, q), k1 = lds_frag(kb, 16 * kt + col, 4 + q);
        S[kt] = __builtin_amdgcn_mfma_f32_16x16x32_bf16(k0, qf[C][0], z4, 0, 0, 0); S[kt] = __builtin_amdgcn_mfma_f32_16x16x32_bf16(k1, qf[C][1], S[kt], 0, 0, 0); }
    const float rowb = sel ? bias_far : NEG;
    float cm = max16(S) + rowb;
    if (__any(cm > st[C].m)) { float x = fmax_x16(cm); x = fmax_x32(x);
        const float mn = fmaxf(st[C].m, x), alpha = ex2(st[C].m - mn);
        st[C].m = mn; st[C].l = st[C].l * alpha;
#pragma unroll
        for (int dt = 0; dt < 4; ++dt) O[C][dt] = O[C][dt] * alpha; }
    const float off = rowb - st[C].m;
#pragma unroll
    for (int kt = 0; kt < 4; ++kt) { f32x4 p = S[kt] + off;
#pragma unroll
        for (int e = 0; e < 4; ++e) p[e] = ex2(p[e]);
        S[kt] = p; }
    const bf16x8 pf0 = pack8(S[0], S[1]), pf1 = pack8(S[2], S[3]);
    st[C].l = __builtin_amdgcn_mfma_f32_16x16x32_bf16(ONES8, pf0, st[C].l, 0, 0, 0); st[C].l = __builtin_amdgcn_mfma_f32_16x16x32_bf16(ONES8, pf1, st[C].l, 0, 0, 0);
#pragma unroll
    for (int dt = 0; dt < 4; ++dt) { const bf16x8 vf0 = lds_frag(vb, 16 * dt + col, q), vf1 = lds_frag(vb, 16 * dt + col, 4 + q);
        O[C][dt] = __builtin_amdgcn_mfma_f32_16x16x32_bf16(vf0, pf0, O[C][dt], 0, 0, 0); O[C][dt] = __builtin_amdgcn_mfma_f32_16x16x32_bf16(vf1, pf1, O[C][dt], 0, 0, 0); }
}

template <bool SELMASK>
__device__ __forceinline__ void attn_far_fast(const LAS unsigned char* kb, const LAS unsigned char* vb, const bf16x8 (&qf)[2][2], int col, int q, float bias_far, bool sel0, bool sel1, Softmax (&st)[2], f32x4 (&O)[2][4]) {
    const f32x4 z4 = (f32x4){0.f, 0.f, 0.f, 0.f};
    const float NEG = -__builtin_inff();
    f32x4 S[2][4];
#pragma unroll
    for (int kt = 0; kt < 4; ++kt) { const bf16x8 k0 = lds_frag(kb, 16 * kt + col, q), k1 = lds_frag(kb, 16 * kt + col, 4 + q);
#pragma unroll
        for (int c = 0; c < 2; ++c) { S[c][kt] = __builtin_amdgcn_mfma_f32_16x16x32_bf16(k0, qf[c][0], z4, 0, 0, 0); S[c][kt] = __builtin_amdgcn_mfma_f32_16x16x32_bf16(k1, qf[c][1], S[c][kt], 0, 0, 0); } }
    bf16x8 pf[2][2];
#pragma unroll
    for (int c = 0; c < 2; ++c) {
        const bool sel = c == 0 ? sel0 : sel1;
        const float off = ((SELMASK && !sel) ? NEG : bias_far) - st[c].m;
#pragma unroll
        for (int kt = 0; kt < 4; ++kt) { f32x4 p = S[c][kt] + off;
#pragma unroll
            for (int e = 0; e < 4; ++e) p[e] = ex2(p[e]);
            S[c][kt] = p; }
        pf[c][0] = pack8(S[c][0], S[c][1]); pf[c][1] = pack8(S[c][2], S[c][3]);
        st[c].l = __builtin_amdgcn_mfma_f32_16x16x32_bf16(ONES8, pf[c][0], st[c].l, 0, 0, 0); st[c].l = __builtin_amdgcn_mfma_f32_16x16x32_bf16(ONES8, pf[c][1], st[c].l, 0, 0, 0);
    }
#pragma unroll
    for (int c32 = 0; c32 < 2; ++c32)
#pragma unroll
        for (int dt = 0; dt < 4; ++dt) { const bf16x8 vf = lds_frag(vb, 16 * dt + col, 4 * c32 + q);
            O[0][dt] = __builtin_amdgcn_mfma_f32_16x16x32_bf16(vf, pf[0][c32], O[0][dt], 0, 0, 0);
            O[1][dt] = __builtin_amdgcn_mfma_f32_16x16x32_bf16(vf, pf[1][c32], O[1][dt], 0, 0, 0); }
}
template <int C>
__device__ __forceinline__ void attn_far1_fast(const LAS unsigned char* kb, const LAS unsigned char* vb, const bf16x8 (&qf)[2][2], int col, int q, float bias_far, bool sel, Softmax (&st)[2], f32x4 (&O)[2][4]) {
    const f32x4 z4 = (f32x4){0.f, 0.f, 0.f, 0.f};
    const float NEG = -__builtin_inff();
    f32x4 S[4];
#pragma unroll
    for (int kt = 0; kt < 4; ++kt) { const bf16x8 k0 = lds_frag(kb, 16 * kt + col, q), k1 = lds_frag(kb, 16 * kt + col, 4 + q);
        S[kt] = __builtin_amdgcn_mfma_f32_16x16x32_bf16(k0, qf[C][0], z4, 0, 0, 0); S[kt] = __builtin_amdgcn_mfma_f32_16x16x32_bf16(k1, qf[C][1], S[kt], 0, 0, 0); }
    const float off = (sel ? bias_far : NEG) - st[C].m;
#pragma unroll
    for (int kt = 0; kt < 4; ++kt) { f32x4 p = S[kt] + off;
#pragma unroll
        for (int e = 0; e < 4; ++e) p[e] = ex2(p[e]);
        S[kt] = p; }
    const bf16x8 pf0 = pack8(S[0], S[1]), pf1 = pack8(S[2], S[3]);
    st[C].l = __builtin_amdgcn_mfma_f32_16x16x32_bf16(ONES8, pf0, st[C].l, 0, 0, 0); st[C].l = __builtin_amdgcn_mfma_f32_16x16x32_bf16(ONES8, pf1, st[C].l, 0, 0, 0);
#pragma unroll
    for (int dt = 0; dt < 4; ++dt) { const bf16x8 vf0 = lds_frag(vb, 16 * dt + col, q), vf1 = lds_frag(vb, 16 * dt + col, 4 + q);
        O[C][dt] = __builtin_amdgcn_mfma_f32_16x16x32_bf16(vf0, pf0, O[C][dt], 0, 0, 0); O[C][dt] = __builtin_amdgcn_mfma_f32_16x16x32_bf16(vf1, pf1, O[C][dt], 0, 0, 0); }
}
__device__ __forceinline__ bool attn_overflowed(const Softmax (&st)[2], const f32x4 (&O)[2][4]) {
    float a = 0.f;
#pragma unroll
    for (int c = 0; c < 2; ++c) { a += fabsf(st[c].l[0]);
#pragma unroll
        for (int dt = 0; dt < 4; ++dt) a += (fabsf(O[c][dt][0]) + fabsf(O[c][dt][1])) + (fabsf(O[c][dt][2]) + fabsf(O[c][dt][3])); }
    return !(a < 1e37f);
}

__device__ __forceinline__ void nsa_unit(unsigned char* ws, LAS unsigned char* lds, const LAS float* lut, int b, int g, int tau, int tid_in) {
    int tid = tid_in; asm volatile("" : "+v"(tid));
    const int lane = tid & 63, wave = __builtin_amdgcn_readfirstlane(tid >> 6);
    const int col = lane & 15, q = lane >> 4, tl = col >> 2, r = col & 3, h = g * 4 + r, t0 = 64 * tau, cur = tau;
    const f32x4 z4 = (f32x4){0.f, 0.f, 0.f, 0.f};
    const float NEG = -__builtin_inff();
    int tq[2]; bf16x8 qf[2][2];
#pragma unroll
    for (int c = 0; c < 2; ++c) { tq[c] = t0 + 8 * wave + 4 * c + tl; const size_t qrow = (size_t)b * SEQ + tq[c];
        const bf16_t* Qp = (const bf16_t*)(ws + WS_Q) + qrow * 1024 + h * 64 + 8 * q; qf[c][0] = *(const bf16x8*)Qp; qf[c][1] = *(const bf16x8*)(Qp + 32); }
#define NSA_GATE(c, k) (((const float*)(ws + WS_GATES))[((size_t)b * SEQ + tq[c]) * 48 + h * 3 + (k)])
    const LAS float* lrow = lut + h * 132;
    const float bias_far = lrow[128];
    const int dl = (4 - tl) & 3;
    const LAS float* nbq = (const LAS float*)(lds + NB_OFF) + (r * 4 + dl) * 264 + 196 - dl + 4 * q;
    LAS f32x4* resw = (LAS f32x4*)(lds + NSA_RES + wave * 8192) + lane;
    f32x4 Oc[2][4];
#pragma unroll
    for (int c = 0; c < 2; ++c)
#pragma unroll
        for (int dt = 0; dt < 4; ++dt) Oc[c][dt] = z4;
    LAS float* impw = (LAS float*)(lds + NSA_IMP) + wave * 2112;
    volatile LAS unsigned* ovf = (volatile LAS unsigned*)(lds + MISC_OFF) + 20;
    if (tid == 0) { ovf[0] = 0u; ovf[1] = 0u; }
    Stage stg;
    const int nvmax = (t0 + 63 >= 31) ? ((t0 + 63 - 31) >> 4) + 1 : 0;
    const int ncb = (nvmax + 63) >> 6;
    int nv[2];
#pragma unroll
    for (int c = 0; c < 2; ++c) nv[c] = tq[c] >= 31 ? ((tq[c] - 31) >> 4) + 1 : 0;
    const unsigned char* kcg = ws + WS_KC + ((size_t)(b * 512) * 4 + g) * 128;
    const unsigned char* vcg = ws + WS_VCT + ((size_t)((b * 4 + g) * 64)) * NCMP_PAD * 2;
    float M[2] = {-1e30f, -1e30f}, L[2] = {0.f, 0.f};
    if (ncb > 0) {
        const int nfar = (t0 - 159 >= 0) ? (((t0 - 159) >> 4) + 1) >> 6 : 0;
        stage_load(stg, kcg, 512, nullptr, 0, tid, false); stage_store(stg, lds, 0, tid, false); __syncthreads();
        for (int i = 0; i < ncb; ++i) {
            if (i + 1 < ncb) stage_load(stg, kcg + (size_t)(i + 1) * 64 * 512, 512, nullptr, 0, tid, false);
            else stage_load(stg, kcg, 512, vcg, NCMP_PAD * 2, tid, true);
            const LAS unsigned char* kb = lds + NSA_KB + (i & 1) * 8192;
            f32x4 S[2][4];
#pragma unroll
            for (int kt = 0; kt < 4; ++kt) { const bf16x8 kf0 = lds_frag(kb, 16 * kt + col, q), kf1 = lds_frag(kb, 16 * kt + col, 4 + q);
#pragma unroll
                for (int c = 0; c < 2; ++c) { S[c][kt] = __builtin_amdgcn_mfma_f32_16x16x32_bf16(kf0, qf[c][0], z4, 0, 0, 0); S[c][kt] = __builtin_amdgcn_mfma_f32_16x16x32_bf16(kf1, qf[c][1], S[c][kt], 0, 0, 0); } }
#pragma unroll
            for (int c = 0; c < 2; ++c) {
                float rowb = bias_far;
                if (i >= nfar) { rowb = 0.f;
                    const int tqlo = t0 + 8 * wave + 4 * c, tqhi = tqlo + 3;
#pragma unroll
                    for (int kt = 0; kt < 4; ++kt) { const int nlo = 64 * i + 16 * kt;
                        if (16 * (nlo + 15) + 31 + 128 <= tqlo) S[c][kt] = S[c][kt] + bias_far;
                        else if (16 * nlo + 31 > tqhi) S[c][kt] = (f32x4){NEG, NEG, NEG, NEG};
                        else {
#pragma unroll
                            for (int e = 0; e < 4; ++e) { const int n = nlo + 4 * q + e; int dist = tq[c] - (16 * n + 31); dist = dist < 0 ? 0 : (dist > 128 ? 128 : dist);
                                const float bv = lrow[dist]; const float sv = S[c][kt][e] + bv; S[c][kt][e] = n < nv[c] ? sv : NEG; } } } }
                const float tm = fmaxf(fmaxf(fmaxf(fmaxf(S[c][0][0], S[c][0][1]), fmaxf(S[c][0][2], S[c][0][3])), fmaxf(fmaxf(S[c][1][0], S[c][1][1]), fmaxf(S[c][1][2], S[c][1][3]))),
                                       fmaxf(fmaxf(fmaxf(S[c][2][0], S[c][2][1]), fmaxf(S[c][2][2], S[c][2][3])), fmaxf(fmaxf(S[c][3][0], S[c][3][1]), fmaxf(S[c][3][2], S[c][3][3])))) + rowb;
                const float mn = fmaxf(M[c], tm); L[c] *= ex2(M[c] - mn); M[c] = mn;
                const float off = rowb - mn; float sum = 0.f;
#pragma unroll
                for (int kt = 0; kt < 4; ++kt)
#pragma unroll
                    for (int e = 0; e < 4; ++e) sum += ex2(S[c][kt][e] + off);
                L[c] += sum;
            }
            if (i + 1 < ncb) stage_store(stg, lds, (i + 1) & 1, tid, false);
            __syncthreads();
        }
#pragma unroll
        for (int c = 0; c < 2; ++c) { float mo = fmax_x16(M[c]); mo = fmax_x32(mo); L[c] *= ex2(M[c] - mo); M[c] = mo; L[c] = fadd_x16(L[c]); L[c] = fadd_x32(L[c]); }
        float offN[2];
#pragma unroll
        for (int c = 0; c < 2; ++c) offN[c] = -M[c] - __builtin_amdgcn_logf(fmaxf(L[c], 1e-30f));
        f32x4 (&O)[2][4] = Oc;
        stage_store(stg, lds, 0, tid, true); __syncthreads();
        for (int i = 0; i < ncb; ++i) {
            if (i + 1 < ncb) stage_load(stg, kcg + (size_t)(i + 1) * 64 * 512, 512, vcg + (size_t)(i + 1) * 128, NCMP_PAD * 2, tid, true);
            const LAS unsigned char* kb = lds + NSA_KB + (i & 1) * 8192; const LAS unsigned char* vb = lds + NSA_VB + (i & 1) * 8192;
            f32x4 S[2][4];
#pragma unroll
            for (int kt = 0; kt < 4; ++kt) { const bf16x8 kf0 = lds_frag(kb, 16 * kt + col, q), kf1 = lds_frag(kb, 16 * kt + col, 4 + q);
#pragma unroll
                for (int c = 0; c < 2; ++c) { S[c][kt] = __builtin_amdgcn_mfma_f32_16x16x32_bf16(kf0, qf[c][0], z4, 0, 0, 0); S[c][kt] = __builtin_amdgcn_mfma_f32_16x16x32_bf16(kf1, qf[c][1], S[c][kt], 0, 0, 0); } }
#pragma unroll
            for (int c = 0; c < 2; ++c) {
                if (i >= nfar) {
                    const int tqlo = t0 + 8 * wave + 4 * c, tqhi = tqlo + 3; const float offF = bias_far + offN[c];
#pragma unroll
                    for (int kt = 0; kt < 4; ++kt) { const int nlo = 64 * i + 16 * kt;
                        if (16 * (nlo + 15) + 31 + 128 <= tqlo) {
#pragma unroll
                            for (int e = 0; e < 4; ++e) S[c][kt][e] = ex2(S[c][kt][e] + offF); }
                        else if (16 * nlo + 31 > tqhi) S[c][kt] = (f32x4){0.f, 0.f, 0.f, 0.f};
                        else {
#pragma unroll
                            for (int e = 0; e < 4; ++e) { const int n = nlo + 4 * q + e; int dist = tq[c] - (16 * n + 31); dist = dist < 0 ? 0 : (dist > 128 ? 128 : dist);
                                const float bv = lrow[dist]; const float pv = ex2(S[c][kt][e] + bv + offN[c]); S[c][kt][e] = n < nv[c] ? pv : 0.f; } } }
                } else { const float off = bias_far + offN[c];
#pragma unroll
                    for (int kt = 0; kt < 4; ++kt)
#pragma unroll
                        for (int e = 0; e < 4; ++e) S[c][kt][e] = ex2(S[c][kt][e] + off); }
#pragma unroll
                for (int kt = 0; kt < 4; ++kt) { float sA = (S[c][kt][0] + S[c][kt][1]) + (S[c][kt][2] + S[c][kt][3]), c3 = S[c][kt][3];
                    sA += dpp_x1(sA); sA += dpp_x2(sA); c3 += dpp_x1(c3); c3 += dpp_x2(c3);
                    if (r == 0) { const int jb = 4 * (4 * i + kt) + q; impw[(4 * c + tl) * 264 + jb] = sA; impw[(4 * c + tl) * 264 + 132 + jb + 1] = c3; } }
            }
            const bf16x8 pf00 = pack8(S[0][0], S[0][1]), pf01 = pack8(S[0][2], S[0][3]), pf10 = pack8(S[1][0], S[1][1]), pf11 = pack8(S[1][2], S[1][3]);
#pragma unroll
            for (int dt = 0; dt < 4; ++dt) { const bf16x8 vf0 = lds_frag(vb, 16 * dt + col, q), vf1 = lds_frag(vb, 16 * dt + col, 4 + q);
                O[0][dt] = __builtin_amdgcn_mfma_f32_16x16x32_bf16(vf0, pf00, O[0][dt], 0, 0, 0); O[1][dt] = __builtin_amdgcn_mfma_f32_16x16x32_bf16(vf0, pf10, O[1][dt], 0, 0, 0);
                O[0][dt] = __builtin_amdgcn_mfma_f32_16x16x32_bf16(vf1, pf01, O[0][dt], 0, 0, 0); O[1][dt] = __builtin_amdgcn_mfma_f32_16x16x32_bf16(vf1, pf11, O[1][dt], 0, 0, 0); }
            if (i + 1 < ncb) stage_store(stg, lds, (i + 1) & 1, tid, true);
            __syncthreads();
        }
    }
    unsigned u[2][4];
    Stage stg2;
    const unsigned char* kg_s = ws + WS_KS + ((size_t)b * SEQ * 256 + g * 64) * 2;
    const unsigned char* vg_s = ws + WS_VST + ((size_t)((b * 4 + g) * 64)) * SEQ * 2;
    stage_load(stg, kg_s, 512, vg_s, SEQ * 2, tid, true);
    if (1 <= cur) stage_load(stg2, kg_s + (size_t)64 * 512, 512, vg_s + 128, SEQ * 2, tid, true);
    asm volatile("s_waitcnt lgkmcnt(0)" ::: "memory");
    LAS unsigned* selw = (LAS unsigned*)(lds + TILES_OFF) + wave * 32;
    select_blocks8(impw, selw, lane, cur, u);
    __syncthreads();
#pragma unroll
    for (int c = 0; c < 2; ++c) { const float gc = NSA_GATE(c, 0);
#pragma unroll
        for (int dt = 0; dt < 4; ++dt) resw[(c * 4 + dt) * 64] = Oc[c][dt] * gc; }
    {
        f32x4 O[2][4]; Softmax st[2];
#pragma unroll
        for (int c = 0; c < 2; ++c) { st[c].m = -1e30f; st[c].l = z4;
#pragma unroll
            for (int dt = 0; dt < 4; ++dt) O[c][dt] = z4; }
        const unsigned char* kg = kg_s; const unsigned char* vg = vg_s;
        const unsigned char* kgw = ws + WS_KW + ((size_t)b * SEQ * 256 + g * 64) * 2;
        const unsigned char* vgw = ws + WS_VWT + ((size_t)((b * 4 + g) * 64)) * SEQ * 2;
        const int jlo_w = cur >= 8 ? cur - 8 : 0;
#define SLC_LOAD(ST, J) stage_load(ST, kg + (size_t)(J) * 64 * 512, 512, vg + (size_t)(J) * 128, SEQ * 2, tid, true)
#define SLC_STEP(SAFE, J, BUF) do { const int j_ = (J); \
            const unsigned uw0 = (j_ >> 5) == 0 ? u[0][0] : (j_ >> 5) == 1 ? u[0][1] : (j_ >> 5) == 2 ? u[0][2] : u[0][3]; \
            const unsigned uw1 = (j_ >> 5) == 0 ? u[1][0] : (j_ >> 5) == 1 ? u[1][1] : (j_ >> 5) == 2 ? u[1][2] : u[1][3]; \
            if (((uw0 | uw1) >> (j_ & 31)) & 1u) { \
                const bool sel0 = (cw0 >> (j_ & 31)) & 1u, sel1 = (cw1 >> (j_ & 31)) & 1u; \
                const LAS unsigned char* kb = lds + NSA_KB + (BUF) * 8192; const LAS unsigned char* vb = lds + NSA_VB + (BUF) * 8192; \
                if (j_ + 3 > cur) attn_block<1, true>(kb, vb, qf, col, q, tq, 64 * j_, nbq, bias_far, sel0, sel1, st, O); \
                else { const bool d0_ = (uw0 >> (j_ & 31)) & 1u, d1_ = (uw1 >> (j_ & 31)) & 1u; \
                    if (SAFE) { \
                        if (d0_ && d1_) attn_block<0, true>(kb, vb, qf, col, q, tq, 64 * j_, nbq, bias_far, sel0, sel1, st, O); \
                        else if (d0_) attn_block_far1<0>(kb, vb, qf, col, q, bias_far, sel0, st, O); \
                        else attn_block_far1<1>(kb, vb, qf, col, q, bias_far, sel1, st, O); \
                    } else if (j_ == 0) attn_block<0, true>(kb, vb, qf, col, q, tq, 0, nbq, bias_far, sel0, sel1, st, O); \
                    else if (d0_ && d1_) attn_far_fast<true>(kb, vb, qf, col, q, bias_far, sel0, sel1, st, O); \
                    else if (d0_) attn_far1_fast<0>(kb, vb, qf, col, q, bias_far, sel0, st, O); \
                    else attn_far1_fast<1>(kb, vb, qf, col, q, bias_far, sel1, st, O); } } } while (0)
#define SLC_LOOP(SAFE) do { \
        if (SAFE) { SLC_LOAD(stg, 0); if (1 <= cur) SLC_LOAD(stg2, 1); } \
        stage_store(stg, lds, 0, tid, true); if (1 <= cur) stage_store(stg2, lds, 1, tid, true); __syncthreads(); \
        unsigned cw0 = 0u, cw1 = 0u; \
        for (int j = 0; j <= cur; j += 2) { \
            if ((j & 31) == 0) { cw0 = selw[tl * 4 + (j >> 5)]; cw1 = selw[16 + tl * 4 + (j >> 5)]; } \
            if (j + 2 <= cur) SLC_LOAD(stg, j + 2); \
            else stage_load(stg, kgw + (size_t)jlo_w * 64 * 512, 512, vgw + (size_t)jlo_w * 128, SEQ * 2, tid, true);     \
            if (j + 3 <= cur) SLC_LOAD(stg2, j + 3); \
            SLC_STEP(SAFE, j, j & 3); \
            if (j + 1 <= cur) SLC_STEP(SAFE, j + 1, (j + 1) & 3); \
            if (j + 2 <= cur) stage_store(stg, lds, (j + 2) & 3, tid, true); \
            if (j + 3 <= cur) stage_store(stg2, lds, (j + 3) & 3, tid, true); \
            __syncthreads(); \
        } } while (0)
        SLC_LOOP(false);
        if (__any(attn_overflowed(st, O))) ovf[0] = 1u;
        __syncthreads();
        if (ovf[0] != 0u) {
#pragma unroll
            for (int c = 0; c < 2; ++c) { st[c].m = -1e30f; st[c].l = z4;
#pragma unroll
                for (int dt = 0; dt < 4; ++dt) O[c][dt] = z4; }
            SLC_LOOP(true);
        }
#undef SLC_LOOP
#undef SLC_LOAD
#undef SLC_STEP
#pragma unroll
        for (int c = 0; c < 2; ++c) { const float sc = NSA_GATE(c, 1) / fmaxf(st[c].l[0], 1e-30f);
#pragma unroll
            for (int dt = 0; dt < 4; ++dt) resw[(c * 4 + dt) * 64] = resw[(c * 4 + dt) * 64] + O[c][dt] * sc; }
    }
    {
        f32x4 O[2][4]; Softmax st[2];
#pragma unroll
        for (int c = 0; c < 2; ++c) { st[c].m = -1e30f; st[c].l = z4;
#pragma unroll
            for (int dt = 0; dt < 4; ++dt) O[c][dt] = z4; }
        const unsigned char* kg = ws + WS_KW + ((size_t)b * SEQ * 256 + g * 64) * 2;
        const unsigned char* vg = ws + WS_VWT + ((size_t)((b * 4 + g) * 64)) * SEQ * 2;
        const int jlo = cur >= 8 ? cur - 8 : 0;
#define WIN_LOOP(SAFE) do { \
        if (SAFE) stage_load(stg, kg + (size_t)jlo * 64 * 512, 512, vg + (size_t)jlo * 128, SEQ * 2, tid, true); \
        stage_store(stg, lds, 0, tid, true); __syncthreads(); \
        for (int j = jlo; j <= cur; ++j) { \
            const int bi = (j - jlo) & 1; \
            if (j + 1 <= cur) stage_load(stg, kg + (size_t)(j + 1) * 64 * 512, 512, vg + (size_t)(j + 1) * 128, SEQ * 2, tid, true); \
            const LAS unsigned char* kb = lds + NSA_KB + bi * 8192; const LAS unsigned char* vb = lds + NSA_VB + bi * 8192; \
            if (j + 3 > cur) attn_block<1, false>(kb, vb, qf, col, q, tq, 64 * j, nbq, bias_far, true, true, st, O); \
            else if (j + 8 == cur) attn_block<2, false>(kb, vb, qf, col, q, tq, 64 * j, nbq, bias_far, true, true, st, O); \
            else if ((SAFE) || j < jlo + 2) attn_block<0, false>(kb, vb, qf, col, q, tq, 64 * j, nbq, bias_far, true, true, st, O); \
            else attn_far_fast<false>(kb, vb, qf, col, q, bias_far, true, true, st, O); \
            if (j + 1 <= cur) stage_store(stg, lds, bi ^ 1, tid, true); \
            __syncthreads(); \
        } } while (0)
        WIN_LOOP(false);
        if (__any(attn_overflowed(st, O))) ovf[1] = 1u;
        __syncthreads();
        if (ovf[1] != 0u) {
#pragma unroll
            for (int c = 0; c < 2; ++c) { st[c].m = -1e30f; st[c].l = z4;
#pragma unroll
                for (int dt = 0; dt < 4; ++dt) O[c][dt] = z4; }
            WIN_LOOP(true);
        }
#undef WIN_LOOP
#pragma unroll
        for (int c = 0; c < 2; ++c) { const float sc = NSA_GATE(c, 2) / fmaxf(st[c].l[0], 1e-30f);
            bf16_t* yo = (bf16_t*)(ws + WS_YNSA) + ((size_t)b * SEQ + tq[c]) * 1024 + h * 64 + 4 * q;
#pragma unroll
            for (int dt = 0; dt < 4; ++dt) { const f32x4 rv = resw[(c * 4 + dt) * 64] + O[c][dt] * sc; u32x2 o; o.x = pk2(rv[0], rv[1]); o.y = pk2(rv[2], rv[3]); *(u32x2*)(yo + 16 * dt) = o; } }
    }
}

__device__ __forceinline__ float dpp_ror4(float x) { return __builtin_bit_cast(float, __builtin_amdgcn_update_dpp(0, __builtin_bit_cast(int, x), 0x124, 0xF, 0xF, true)); }
__device__ __forceinline__ float dpp_ror8(float x) { return __builtin_bit_cast(float, __builtin_amdgcn_update_dpp(0, __builtin_bit_cast(int, x), 0x128, 0xF, 0xF, true)); }
__device__ __forceinline__ int dpp_ror4i(int x) { return __builtin_amdgcn_update_dpp(0, x, 0x124, 0xF, 0xF, true); }
__device__ __forceinline__ int dpp_ror8i(int x) { return __builtin_amdgcn_update_dpp(0, x, 0x128, 0xF, 0xF, true); }
__device__ __forceinline__ void route_token(const In& in, unsigned char* ws, LAS unsigned* hist, LAS unsigned* eloc, LAS unsigned* sloc, int tok, int tloc, int lane) {
    const f32x4 lg = *((const f32x4*)((const float*)(ws + WS_LOGIT) + (size_t)tok * 256) + lane);
    const f32x4 rb = *((const f32x4*)in.router_bias + lane);
    float s[4], v[4];
#pragma unroll
    for (int i = 0; i < 4; ++i) { s[i] = sigmoidf_(lg[i]); v[i] = s[i] + rb[i]; }
    unsigned taken = 0u; float my_s = 0.f; int my_e = 0;
    for (int k = 0; k < TOPK; ++k) {
        float bv = -__builtin_inff(); int bi = 1 << 20;
#pragma unroll
        for (int i = 0; i < 4; ++i) { const bool ok = !((taken >> i) & 1u) && v[i] > bv; bv = ok ? v[i] : bv; bi = ok ? 4 * lane + i : bi; }
        best_pair(bv, bi, dpp_ror8(bv), dpp_ror8i(bi)); best_pair(bv, bi, dpp_ror4(bv), dpp_ror4i(bi)); best_pair(bv, bi, dpp_x2(bv), dpp_x2i(bi)); best_pair(bv, bi, dpp_x1(bv), dpp_x1i(bi));
        { const float ov = __shfl_xor(bv, 16); const int oi = __shfl_xor(bi, 16); best_pair(bv, bi, ov, oi); }
        { const float ov = __shfl_xor(bv, 32); const int oi = __shfl_xor(bi, 32); best_pair(bv, bi, ov, oi); }
        const bool mine = (bi >> 2) == lane;
        if (mine) taken |= 1u << (bi & 3);
        const float sw = (bi & 3) == 0 ? s[0] : (bi & 3) == 1 ? s[1] : (bi & 3) == 2 ? s[2] : s[3];
        const float bs = __shfl(sw, bi >> 2);
        if (lane == k) { my_s = bs; my_e = bi; }
    }
    float sum = lane < TOPK ? my_s : 0.f;
    sum += dpp_x1(sum); sum += dpp_x2(sum); sum += dpp_ror4(sum); sum += dpp_ror8(sum);
    if (lane < TOPK) {
        const unsigned slot = __hip_atomic_fetch_add(hist + my_e, 1u, __ATOMIC_RELAXED, __HIP_MEMORY_SCOPE_WORKGROUP);
        eloc[tloc * 8 + lane] = (unsigned)my_e; sloc[tloc * 8 + lane] = slot;
        ((int*)(ws + WS_ASGE))[tok * 8 + lane] = my_e; ((float*)(ws + WS_ASGW))[tok * 8 + lane] = my_s / sum * 2.5f;
    }
}

#ifndef DBG_MODE
#define DBG_MODE 0
#endif
struct Args { In in; float* out; unsigned char* ws; int ph_lo, ph_hi; };
static_assert(sizeof(Args) == 31 * 8 + 8 + 8 + 8, "Args has no padding");

#define CAS __attribute__((address_space(4)))
struct PhaseArgs { In in; float* out; unsigned char* ws; };
__device__ __forceinline__ PhaseArgs load_args() {
    const CAS unsigned char* kp = (const CAS unsigned char*)__builtin_amdgcn_kernarg_segment_ptr(); asm volatile("" : "+s"(kp));
    const float* const CAS* pp = (const float* const CAS*)kp; PhaseArgs r; const float** rp = (const float**)&r.in;
#pragma unroll
    for (int i = 0; i < 31; ++i) rp[i] = pp[i];
    r.out = (float*)pp[31]; r.ws = (unsigned char*)pp[32]; return r;
}
#define PHASE_ARGS() const PhaseArgs pa_ = load_args(); const In& in = pa_.in; float* const out = pa_.out; unsigned char* const ws = pa_.ws; (void)in; (void)out; (void)ws
__global__ void __launch_bounds__(NTHREADS, 2) fwd_kernel(Args args) {
    extern __shared__ __attribute__((aligned(16))) unsigned char lds_raw[];
    LAS unsigned char* lds = (LAS unsigned char*)lds_raw;
    volatile LAS unsigned* MISC = (volatile LAS unsigned*)(lds + MISC_OFF);
    const int tid = threadIdx.x, lane = tid & 63, wave = __builtin_amdgcn_readfirstlane(tid >> 6);
    const int G = gridDim.x, gw = (int)blockIdx.x * NWAVES + wave, NGW = G * NWAVES;
    unsigned* ctl = (unsigned*)(args.ws + WS_CTL);
    for (int u = tid; u < 256; u += NTHREADS) ((LAS unsigned*)(lds + MISC_OFF))[u] = 0u;
    __syncthreads();
    XcdBarrier bar = xcd_barrier_post(ctl + CW_BAR, MISC + 8);
    const int lo = args.ph_lo, hi = args.ph_hi;
#define IN(k) (lo <= (k) && (k) < hi)
#define SEAM(k) do { if (IN(k) && IN((k) + 1)) xcd_barrier(bar); } while (0)
    LAS float* lut = (LAS float*)(lds + LUT_OFF);
    LAS int* tstart = (LAS int*)(lds + TILES_OFF);

    if (IN(0)) {
        PHASE_ARGS();
        p0_mod(in, ws, lds, tid);
        p0_tables(in, ws, lds, tid);
        if (blockIdx.x >= 64) p0_small_weights(in, ws, (LAS float*)(lds + wave * 8448), gw - 64 * NWAVES, NGW - 64 * NWAVES, lane);
    }
    SEAM(0);
    if (IN(1)) { PHASE_ARGS();
        if (blockIdx.x == 0) {
            const float* part = (const float*)(ws + WS_CTL + 131072);
            const int ts = tid >> 8, c = tid & 255; float sb = 0.f;
            for (int pz = 0; pz < 16; ++pz) sb += part[(ts * 16 + pz) * 256 + c];
            ((float*)(ws + WS_CTL + 65536))[ts * 256 + c] = sb; }
        ph_h1(in, ws, gw, NGW, lane); }
    SEAM(1);
    if (IN(2)) {
        PHASE_ARGS();
        SchedDense S = make_dense((const char*)ws, WS_H1, 2048, (const char*)(ws + WS_WIN), MTOK, NPROJ, 1024);
        EpiProj E{ws};
        pg8::gemm_phase<EpiProj, SchedDense>(lds, S, E);
    }
    SEAM(2);
    if (IN(3)) {
        PHASE_ARGS();
        { SchedCmp1 S; S.abase = (const char*)ws; S.a_kstep = 512; S.K = 2048; S.Bt = (const char*)(ws + WS_CW1); S.ord.init(64, 2, G, (int)blockIdx.x);
          EpiCmp1 E{ws}; pg8::gemm_phase<EpiCmp1, SchedCmp1>(lds, S, E); }
        __syncthreads();
        s5_task<false>(in, ws, lds + wave * S5_LDS_PER_WAVE, gw >> 8, (gw >> 3) & 31, gw & 7, lane);
    }
    SEAM(3);
    if (IN(4)) {
        PHASE_ARGS();
        { SchedCmp2 S; S.abase = (const char*)ws; S.a_kstep = 128; S.K = 256; S.Bt = (const char*)(ws + WS_CW2); S.ord.init(64, 2, G, (int)blockIdx.x);
          EpiCmp2 E{ws}; pg8::gemm_phase<EpiCmp2, SchedCmp2>(lds, S, E); }
        __syncthreads();
        s5_task<true>(in, ws, lds + wave * S5_LDS_PER_WAVE, gw >> 8, (gw >> 3) & 31, gw & 7, lane);
    }
    SEAM(4);
    if (IN(5)) {
        PHASE_ARGS();
        for (int i = tid; i < 16 * 132; i += NTHREADS) lut[i] = ((const float*)(ws + WS_TAB + TAB_LUT))[i];
        __syncthreads();
        if ((tid >> 6) >= 4) __builtin_amdgcn_s_setprio(2);
        for (int i = 0; i < 16; ++i) { const int bg = 8 * (i >> 2) + ((int)blockIdx.x & 7), wi = (int)blockIdx.x >> 3, k = i & 3;
            const int tau = k == 0 ? wi : k == 1 ? 63 - wi : k == 2 ? 64 + wi : 127 - wi;
            if (k == 0) {
                __syncthreads();
                LAS float* nbt = (LAS float*)(lds + NB_OFF);
                for (int x = tid; x < 16 * 264; x += NTHREADS) { const int rr = x / 1056, sh = (x / 264) & 3, z = x % 264, d = 196 - z - sh;
                    nbt[x] = d < 0 ? -__builtin_inff() : lut[((bg & 3) * 4 + rr) * 132 + (d > 128 ? 128 : d)]; }
                __syncthreads();
            }
            nsa_unit(ws, lds, lut, bg >> 2, bg & 3, tau, tid); }
        __builtin_amdgcn_s_setprio(0);
    }
    SEAM(5);
    if (IN(6)) {
        PHASE_ARGS();
        SchedDense S = make_dense((const char*)ws, WS_Z, 1024, (const char*)(ws + WS_GLU), MTOK, 2048, 512);
        EpiGlu E{ws}; pg8::gemm_phase<EpiGlu, SchedDense>(lds, S, E);
    }
    SEAM(6);
    if (IN(7)) {
        PHASE_ARGS();
        SchedDense S = make_dense((const char*)ws, WS_MERGED, 2048, (const char*)(ws + WS_WOUT), MTOK, 1024, 1024);
        EpiWout E{in.x, out, (const float*)(ws + WS_MOD) + 2048};
        static_assert(WS_WD >= WS_KS && WS_WD + 128 * MiB <= WS_MG + 256 * MiB && WS_WGU + 63 * MiB <= WS_Q && WS_WGU + 191 * MiB >= WS_Q + 128 * MiB, "early conversion targets must not overlap MERGED (live in this phase)");
        if (blockIdx.x & 1) { convert_expert_weights(in, ws, (LAS float*)(lds + wave * 8448), gw, NGW, lane, 0); __syncthreads(); }
        pg8::gemm_phase<EpiWout, SchedDense>(lds, S, E);
        if (!(blockIdx.x & 1)) { __syncthreads(); convert_expert_weights(in, ws, (LAS float*)(lds + wave * 8448), gw, NGW, lane, 0); }
    }
    SEAM(7);
    if (IN(8)) {
        PHASE_ARGS();
        ph_ln1(in, ws, out, gw, NGW, lane);
        for (int i = gw * 64 + lane; i < 128; i += NGW * 64) ((u32x4*)((bf16_t*)(ws + WS_H2) + (size_t)MTOK * DM))[i] = (u32x4){0u, 0u, 0u, 0u};
        for (int i = gw * 64 + lane; i < NCHUNK * CHUNK_ROWS; i += NGW * 64) { ((int*)(ws + WS_ROWASG))[i] = -1; ((float*)(ws + WS_ROWW))[i] = 0.f; }
        convert_expert_weights(in, ws, (LAS float*)(lds + wave * 8448), gw, NGW, lane, 1);
    }
    SEAM(8);
    if (IN(9)) {
        PHASE_ARGS();
        { SchedDense S = make_dense((const char*)ws, WS_H2, 2048, (const char*)(ws + WS_ROUT), MTOK, 256, 1024);
          EpiF32 E{(float*)(ws + WS_LOGIT), 256}; pg8::gemm_phase<EpiF32, SchedDense>(lds, S, E); }
        { SchedDense S = make_dense((const char*)ws, WS_H2, 2048, (const char*)(ws + WS_SHGU), MTOK, 512, 1024);
          EpiSwiglu E{(bf16_t*)(ws + WS_HSH)}; pg8::gemm_phase<EpiSwiglu, SchedDense>(lds, S, E); }
    }
    SEAM(9);
    if (IN(10)) {
        PHASE_ARGS();
        {
            LAS unsigned* hist = (LAS unsigned*)lds; LAS unsigned* gbase = hist + 256; LAS unsigned* eloc = hist + 512; LAS unsigned* sloc = hist + 2560;
            const int tok0 = (int)blockIdx.x * 256;
            if (tid < 256) hist[tid] = 0u;
            __syncthreads();
            for (int k = 0; k < 32; ++k) route_token(in, ws, hist, eloc, sloc, tok0 + wave * 32 + k, wave * 32 + k, lane);
            __syncthreads();
            if (tid < 256) { const unsigned h = hist[tid]; gbase[tid] = h ? __hip_atomic_fetch_add(ctl + CW_CNT + chunk_of_tok(tok0) * 256 + tid, h, RLX_AGENT) : 0u; }
            __syncthreads();
            for (int i = tid; i < 2048; i += NTHREADS) ((int*)(ws + WS_ASGS))[tok0 * 8 + i] = (int)(sloc[i] + gbase[eloc[i]]);
            __syncthreads();
        }
        SchedDense S = make_dense((const char*)ws, WS_HSH, 512, (const char*)(ws + WS_SHD), MTOK, 1024, 256);
        EpiShDown E{(unsigned char*)(ws + WS_SHOUT)}; pg8::gemm_phase<EpiShDown, SchedDense>(lds, S, E);
    }
    SEAM(10);
    if (IN(11) || IN(12)) {
        for (int i = tid; i < NCHUNK * 256; i += NTHREADS) { const unsigned c = __hip_atomic_load(ctl + CW_CNT + i, RLX_AGENT); tstart[(i >> 8) * 260 + (i & 255) + 1] = (int)((c + 255u) >> 8); }
        if (tid < NCHUNK) tstart[tid * 260] = 0;
        __syncthreads();
        if (tid < NCHUNK) { int sacc = 0; for (int e = 1; e <= 256; ++e) { sacc += tstart[tid * 260 + e]; tstart[tid * 260 + e] = sacc; } }
        __syncthreads();
    }
    if (IN(11)) {
        PHASE_ARGS();
        for (int a = gw * 64 + lane; a < MTOK * TOPK; a += NGW * 64) { const int e = ((const int*)(ws + WS_ASGE))[a], ch = chunk_of_tok(a >> 3); const int pos = ch * CHUNK_ROWS + 256 * tstart[ch * 260 + e] + ((const int*)(ws + WS_ASGS))[a];
            ((int*)(ws + WS_ROWASG))[pos] = a; ((float*)(ws + WS_ROWW))[pos] = ((const float*)(ws + WS_ASGW))[a]; }
    }
    SEAM(11);
    if (IN(12)) {
        PHASE_ARGS();
        for (int ch = 0; ch < NCHUNK; ++ch) {
            { SchedMoeGU S; S.abase = (const char*)ws; S.a_kstep = 128; S.K = 1024; S.tstart = tstart + ch * 260; S.rowasg = (const int*)(ws + WS_ROWASG) + ch * CHUNK_ROWS; S.W = (const char*)(ws + WS_WGU); S.G = G; S.c = (int)blockIdx.x;
              EpiSwiglu E{(bf16_t*)(ws + WS_HID)}; pg8::gemm_phase<EpiSwiglu, SchedMoeGU>(lds, S, E); }
            if (ch > 0) final_chunk(in, ws, out, ctl + CW_FCTR + 64 * (ch - 1), ch - 1, MISC + 16, tid, wave, lane);
            xcd_barrier(bar);
            { SchedMoeD S; S.abase = (const char*)ws; S.a_kstep = 128; S.K = 256; S.tstart = tstart + ch * 260; S.W = (const char*)(ws + WS_WD); S.G = G; S.c = (int)blockIdx.x;
              EpiMoeDown E{(unsigned char*)(ws + WS_OUTS), (const int*)(ws + WS_ROWASG) + ch * CHUNK_ROWS, (const float*)(ws + WS_ROWW) + ch * CHUNK_ROWS, ch * CHUNK_ASG}; pg8::gemm_phase<EpiMoeDown, SchedMoeD>(lds, S, E); }
            xcd_barrier(bar);
        }
        final_chunk(in, ws, out, ctl + CW_FCTR + 64 * (NCHUNK - 1), NCHUNK - 1, MISC + 16, tid, wave, lane);
    }
#undef IN
#undef SEAM
}

extern "C" void kernel_launch(void* const* d_in, const int* in_sizes, int n_in, void* d_out, int out_size, void* d_ws, size_t ws_size, hipStream_t stream) {
    static int grid = 0;
    if (grid == 0) {
        if (n_in != 31 || out_size != MTOK * DM || ws_size < WS_END) { fprintf(stderr, "kernel_launch: unexpected shapes: n_in %d out %d ws %zu (need %zu)\n", n_in, out_size, ws_size, (size_t)WS_END); grid = -1; return; }
        int dev = 0, cus = 0, per_cu = 0;
        if (hipGetDevice(&dev) != hipSuccess || hipDeviceGetAttribute(&cus, hipDeviceAttributeMultiprocessorCount, dev) != hipSuccess) { grid = -1; return; }
        if (hipFuncSetAttribute((const void*)fwd_kernel, hipFuncAttributeMaxDynamicSharedMemorySize, LDS_BYTES) != hipSuccess) { fprintf(stderr, "kernel_launch: hipFuncSetAttribute failed\n"); grid = -1; return; }
        if (hipOccupancyMaxActiveBlocksPerMultiprocessor(&per_cu, (const void*)fwd_kernel, NTHREADS, LDS_BYTES) != hipSuccess || per_cu < 1) { fprintf(stderr, "kernel_launch: occupancy query says %d\n", per_cu); }
        (void)hipGetLastError();
        grid = cus;
    }
    if (grid < 0) return;
    if (hipMemsetAsync((char*)d_ws + WS_CTL, 0, CTL_ZERO_BYTES, stream) != hipSuccess) return;
    Args a{};
    const float** ip = (const float**)&a.in;
    for (int i = 0; i < 31; ++i) ip[i] = (const float*)d_in[i];
    a.out = (float*)d_out; a.ws = (unsigned char*)d_ws; a.ph_lo = 0; a.ph_hi = 13;
    hipLaunchKernelGGL(fwd_kernel, dim3(grid), dim3(NTHREADS), LDS_BYTES, stream, a);
}
```

```cpp
#include <hip/hip_runtime.h>
#include <cstdio>
#include <cstdint>

#define LAS __attribute__((address_space(3)))
#define GAS __attribute__((address_space(1)))
typedef unsigned short bf16_t;
typedef short bf16x8 __attribute__((ext_vector_type(8)));
typedef short bf16x4 __attribute__((ext_vector_type(4)));
typedef float f32x4 __attribute__((ext_vector_type(4)));
typedef float f32x2 __attribute__((ext_vector_type(2)));
typedef unsigned u32x4 __attribute__((ext_vector_type(4)));
typedef unsigned u32x2 __attribute__((ext_vector_type(2)));

constexpr int DM = 1024, NB = 8, SEQ = 8192, MTOK = NB * SEQ;
constexpr int SSM_W = 512, SSM_G = 32, SSM_P = 64;
constexpr int NH = 16, HD = 64, NKV = 4, KVW = 256;
constexpr int NCMP = 511, NCMP_PAD = 512;
constexpr int NEXP = 256, TOPK = 8, DEXP = 256;
constexpr int NPROJ = 5376;
constexpr float DN_ALPHA = 1.189207115002721f;
constexpr float LN_EPS = 1e-5f;
constexpr int NWAVES = 8, NTHREADS = 512;

constexpr size_t MiB = 1u << 20;
constexpr size_t WS_CTL = 0, CTL_ZERO_BYTES = 1 * MiB;
constexpr size_t WS_MOD = 1 * MiB;
constexpr size_t WS_TAB = 1 * MiB + 512 * 1024;
constexpr size_t WS_WIN = 2 * MiB;
constexpr size_t WS_GLU = 13 * MiB;
constexpr size_t WS_WOUT = 15 * MiB;
constexpr size_t WS_ROUT = 17 * MiB;
constexpr size_t WS_SHGU = 17 * MiB + 512 * 1024;
constexpr size_t WS_SHD = 18 * MiB + 512 * 1024;
constexpr size_t WS_CW1 = 19 * MiB;
constexpr size_t WS_CW2 = 21 * MiB;
constexpr size_t WS_S5T = 21 * MiB + 512 * 1024;
constexpr size_t WS_BASE = 24 * MiB;
constexpr size_t WS_H1 = WS_BASE;
constexpr size_t WS_YNSA = WS_H1;
constexpr size_t WS_U = WS_H1 + 128 * MiB;
constexpr size_t WS_Q = WS_U + 64 * MiB;
constexpr size_t WS_MERGED = WS_Q;
constexpr size_t WS_KCR = WS_Q + 128 * MiB;
constexpr size_t WS_VCR = WS_KCR + 32 * MiB;
constexpr size_t WS_KS = WS_VCR + 32 * MiB;
constexpr size_t WS_VST = WS_KS + 32 * MiB;
constexpr size_t WS_KW = WS_VST + 32 * MiB;
constexpr size_t WS_VWT = WS_KW + 32 * MiB;
constexpr size_t WS_MG = WS_VWT + 32 * MiB;
constexpr size_t WS_GATES = WS_MG + 256 * MiB;
constexpr size_t WS_Z = WS_GATES + 12 * MiB;
constexpr size_t WS_CMPH = WS_Z + 64 * MiB;
constexpr size_t WS_KC = WS_CMPH + 16 * MiB;
constexpr size_t WS_VCT = WS_KC + 2 * MiB;
constexpr size_t WS_S5ST = WS_VCT + 2 * MiB;
constexpr size_t WS_MIX_END = WS_S5ST + 1 * MiB;
constexpr int NCHUNK = 2, CHUNK_TOK = 32768, CHUNK_ASG = CHUNK_TOK * 8, CHUNK_ROWS = 327680, CHUNK_TILES = CHUNK_ROWS / 256;
constexpr float OUTS_SCALE = 64.0f;
__host__ __device__ __forceinline__ int chunk_of_tok(int tok) { return tok >> 15; }
__host__ __device__ __forceinline__ int chunk_ntok(int ch) { return CHUNK_TOK; }
constexpr size_t WS_H2 = WS_BASE;
constexpr size_t WS_WGU = WS_H2 + 129 * MiB;
constexpr size_t WS_WD = WS_WGU + 256 * MiB;
constexpr size_t WS_OUTS = WS_WD + 128 * MiB;
constexpr size_t WS_LOGIT = WS_OUTS;
constexpr size_t WS_HID = WS_OUTS + 256 * MiB;
constexpr size_t WS_HSH = WS_HID;
constexpr size_t WS_ASGE = WS_HID + 160 * MiB;
constexpr size_t WS_ASGS = WS_ASGE + 2 * MiB;
constexpr size_t WS_ASGW = WS_ASGS + 2 * MiB;
constexpr size_t WS_ROWASG = WS_ASGW + 2 * MiB;
constexpr size_t WS_ROWW = WS_ROWASG + 3 * MiB;
constexpr size_t WS_LNST = WS_ROWW + 3 * MiB;
constexpr size_t WS_SHOUT = WS_LNST + 1 * MiB;
constexpr size_t WS_END = WS_SHOUT + 64 * MiB;
static_assert(WS_MIX_END <= WS_END, "map");
constexpr int CW_BAR = 4096;
constexpr int CW_CNT = 8192;
constexpr int CW_FCTR = 9216;
constexpr size_t TAB_CMPB = 0;
constexpr size_t TAB_LUT = 4096;
constexpr size_t S5_AFR = 0;
constexpr size_t S5_CFR = 256 * 1024;
constexpr size_t S5_A = 384 * 1024;
constexpr size_t S5_A16 = S5_A + 16384;
constexpr size_t S5_AC = S5_A16 + 16384;

constexpr int RING_BYTES = 131072;
constexpr int MISC_OFF = 133120;
constexpr int LUT_OFF = MISC_OFF + 1024;
constexpr int TILES_OFF = LUT_OFF + 8448;
constexpr int NB_OFF = TILES_OFF + 4160;
constexpr int LDS_BYTES = 163840;
static_assert(NB_OFF % 16 == 0 && NB_OFF + 16 * 264 * 4 <= LDS_BYTES, "near-bias table");
static_assert(RING_BYTES <= MISC_OFF, "GEMM stage ring below the control words");
static_assert(TILES_OFF + 4 * 260 * 4 <= LDS_BYTES, "lds map");

#define RLX_AGENT __ATOMIC_RELAXED, __HIP_MEMORY_SCOPE_AGENT
#define LDS_WAIT() asm volatile("s_waitcnt lgkmcnt(0)" ::: "memory")
#define VM_WAIT() asm volatile("s_waitcnt vmcnt(0)" ::: "memory")
__device__ __forceinline__ unsigned f2bf(float f) { unsigned u = __builtin_bit_cast(unsigned, f); return (u + 0x7fffu + ((u >> 16) & 1u)) >> 16; }
typedef __bf16 nbf16x2 __attribute__((ext_vector_type(2)));
__device__ __forceinline__ unsigned pk2(float lo, float hi) { const f32x2 v = {lo, hi}; return __builtin_bit_cast(unsigned, __builtin_convertvector(v, nbf16x2)); }
__device__ __forceinline__ float bf2f(unsigned short b) { return __builtin_bit_cast(float, ((unsigned)b) << 16); }
__device__ __forceinline__ float bflo(unsigned w) { return __builtin_bit_cast(float, w << 16); }
__device__ __forceinline__ float bfhi(unsigned w) { return __builtin_bit_cast(float, w & 0xffff0000u); }
__device__ __forceinline__ float sigmoidf_(float x) { return 1.0f / (1.0f + __expf(-x)); }
__device__ __forceinline__ float siluf_(float x) { return x / (1.0f + __expf(-x)); }
__device__ __forceinline__ float gelu_tanh(float x) { const float u = 0.7978845608028654f * (x + 0.044715f * x * x * x); const float e = __expf(2.0f * u); return x * (1.0f - 1.0f / (e + 1.0f)); }
__device__ __forceinline__ float wave_sum(float v) {
#pragma unroll
    for (int o = 1; o < 64; o <<= 1) v += __shfl_xor(v, o);
    return v;
}

#define XB_TMO      128
#define XB_XCNT(j)  (256  + 64 * (j))
#define XB_XSUB(j)  (1280 + 64 * (j))
#define XB_XGEN(j)  (2304 + 64 * (j))
#define XB_TOP      3328
#define XB_TOPGEN   3392
#define XCD_BAR_WORDS 3456
#define XB_SPIN_CAP (1u << 18)
__device__ __forceinline__ unsigned xb_ld(unsigned* p)              { return __hip_atomic_load(p, __ATOMIC_RELAXED, __HIP_MEMORY_SCOPE_AGENT); }
__device__ __forceinline__ unsigned xb_add(unsigned* p, unsigned v) { return __hip_atomic_fetch_add(p, v, __ATOMIC_RELAXED, __HIP_MEMORY_SCOPE_AGENT); }
__device__ __forceinline__ unsigned xb_xcc_id() { return (unsigned)__builtin_amdgcn_s_getreg((3 << 11) | 20) & 0xFu; }
#define XB_SPIN(cond, bar) do { unsigned _sp = 0; while (cond) { __builtin_amdgcn_s_sleep(1); \
    if ((++_sp & 255u) == 0u) { if (xb_ld(&(bar)[XB_TMO])) break; if (_sp > XB_SPIN_CAP) { atomicAdd(&(bar)[XB_TMO], 1u); break; } } } } while (0)
struct XcdBarrier { unsigned* bar; unsigned x; volatile LAS unsigned* st; };
__device__ __forceinline__ XcdBarrier xcd_barrier_post(unsigned* bar, volatile LAS unsigned* st) {
    XcdBarrier b; b.bar = bar; b.x = xb_xcc_id(); b.st = st;
    if (threadIdx.x == 0) (void)xb_add(&bar[XB_XCNT(b.x)], 1u);
    return b;
}
__device__ __forceinline__ void xcd_barrier_complete(unsigned* bar, unsigned x, unsigned& nloc, unsigned& nx) {
    const unsigned G = gridDim.x * gridDim.y * gridDim.z;
    unsigned sum, cnt, mine, sp = 0u;
    for (;;) {
        sum = 0u; cnt = 0u; mine = 0u;
#pragma unroll
        for (unsigned j = 0; j < 16; ++j) { const unsigned c = xb_ld(&bar[XB_XCNT(j)]); sum += c; cnt += (c > 0u) ? 1u : 0u; mine = (j == x) ? c : mine; }
        if (sum == G) break;
        __builtin_amdgcn_s_sleep(1);
        if ((++sp & 255u) == 0u) { if (xb_ld(&bar[XB_TMO])) break; if (sp > XB_SPIN_CAP) { atomicAdd(&bar[XB_TMO], 1u); break; } }
    }
    nloc = mine > 0u ? mine : 1u; nx = cnt > 0u ? cnt : 1u;
}
__device__ __forceinline__ void xcd_barrier(const XcdBarrier& b) {
    asm volatile("s_waitcnt vmcnt(0)" ::: "memory");
    __syncthreads();
    if (threadIdx.x == 0) {
        unsigned* bar = b.bar;
        __builtin_amdgcn_s_waitcnt(0);
        unsigned nloc = b.st[0], nx = b.st[1];
        if (nloc == 0u) { xcd_barrier_complete(bar, b.x, nloc, nx); b.st[0] = nloc; b.st[1] = nx; }
        const unsigned old = xb_add(&bar[XB_XSUB(b.x)], 1u);
        const unsigned gen = old / nloc;
        if (old + 1u == (gen + 1u) * nloc) {
            __builtin_amdgcn_fence(__ATOMIC_RELEASE, "agent");
            asm volatile("s_waitcnt vmcnt(0)" ::: "memory");
            const unsigned og = xb_add(&bar[XB_TOP], 1u);
            const unsigned tg = og / nx;
            if (og + 1u == (tg + 1u) * nx) xb_add(&bar[XB_TOPGEN], 1u);
            else XB_SPIN(xb_ld(&bar[XB_TOPGEN]) == tg, bar);
            __builtin_amdgcn_fence(__ATOMIC_ACQUIRE, "agent");
            xb_add(&bar[XB_XGEN(b.x)], 1u);
            asm volatile("s_waitcnt vmcnt(0)" ::: "memory");
        } else {
            XB_SPIN(xb_ld(&bar[XB_XGEN(b.x)]) == gen, bar);
            __builtin_amdgcn_fence(__ATOMIC_ACQUIRE, "agent");
            asm volatile("s_waitcnt vmcnt(0)" ::: "memory");
        }
    }
    __syncthreads();
}

namespace pg8 {
constexpr int BM = 256, BK = 64, HALF = 128, HTB = HALF * BK * 2, STAGE_BYTES = 8 * HTB, NXCD = 8, WGM = 8;
__host__ __device__ __forceinline__ int lds_byte(int r, int c) { const int st = (r >> 4) * 2 + (c >> 5), rr = r & 15, cc = c & 31, ob = rr * 64 + cc * 2; return st * 1024 + (ob ^ (((ob >> 9) & 1) << 5)); }
__host__ __device__ __forceinline__ void stage_rc(int b, int& R, int& C) { const int st = b / 1024, sb = b % 1024, swz = sb ^ (((sb >> 9) & 1) << 5); R = (st >> 1) * 16 + swz / 64; C = (st & 1) * 32 + (swz % 64) / 2; }
__host__ __device__ __forceinline__ int perm32(int rho) { const int n = rho >> 4, i = rho & 15; return 8 * (i >> 2) + 4 * n + (i & 3); }
struct Unit { int pm, pn; };
struct DenseOrder {
    int nM, nN, nwg, G, c;
    __device__ void init(int nM_, int nN_, int G_, int c_) { nM = nM_; nN = nN_; nwg = nM * nN; G = G_; c = c_; }
    __device__ bool next(int i, Unit& u) const {
        const long L = (long)i * G + c; if (L >= nwg) return false;
        int wgid = (int)L; { const int q = nwg / NXCD, r = nwg % NXCD, xcd = wgid % NXCD, off = wgid / NXCD; wgid = (xcd < r ? xcd * (q + 1) : r * (q + 1) + (xcd - r) * q) + off; }
        const int nig = WGM * nN, gid = wgid / nig, fm = gid * WGM, gsz = (nM - fm) < WGM ? (nM - fm) : WGM;
        u.pm = fm + ((wgid % nig) % gsz); u.pn = (wgid % nig) / gsz; return true;
    }
};
template <class Epi, class Sched>
__device__ __forceinline__ void gemm_phase(LAS unsigned char* lds, const Sched& S, const Epi& E) {
    int tid_ = threadIdx.x; asm volatile("" : "+v"(tid_));
    const int tid = tid_, wid = __builtin_amdgcn_readfirstlane(tid >> 6), lane = tid & 63, wr = wid >> 2, wc = wid & 3, fr = lane & 15, fq = lane >> 4;
    const int K = S.K, nt = K / BK;
    int RA[2], CA[2]; unsigned voffB[2];
#pragma unroll
    for (int i = 0; i < 2; ++i) { int R, C; stage_rc(tid * 16 + i * 8192, R, C); const int Rb = Epi::PERM ? ((R & ~31) + perm32(R & 31)) : R;
        RA[i] = R; CA[i] = C * 2; voffB[i] = (unsigned)(Rb * K + C) * 2u; }
    const size_t kstep = (size_t)(BK * 2);
    const size_t hstep = (size_t)HALF * K * 2;
    const size_t ka = (size_t)S.a_kstep;
    const unsigned ldsw = (unsigned)wid * 1024u;
    const int aoff = lds_byte(wr * 64 + fr, fq * 8), boff = lds_byte(wc * 32 + fr, fq * 8);
#define PG8_SA(b, h) (((b) * 2 + (h)) * HTB)
#define PG8_SB(b, h) ((4 + (b) * 2 + (h)) * HTB)
#define PG8_STAGE(bufoff, gbase, v0, v1) do { \
        __builtin_amdgcn_global_load_lds((const unsigned*)((const char*)(gbase) + (v0)), (LAS unsigned*)(lds + (bufoff) + ldsw), 16, 0, 0); \
        __builtin_amdgcn_global_load_lds((const unsigned*)((const char*)(gbase) + (v1)), (LAS unsigned*)(lds + (bufoff) + ldsw + 8192), 16, 0, 0); } while (0)
#define PG8_LDA(dst, b, h) do { _Pragma("unroll") for (int m = 0; m < 4; ++m) _Pragma("unroll") for (int k = 0; k < 2; ++k) dst[m][k] = *(const LAS bf16x8*)(lds + PG8_SA(b, h) + aoff + m * 2048 + k * 1024); } while (0)
#define PG8_LDB(dst, b, h) do { _Pragma("unroll") for (int n = 0; n < 2; ++n) _Pragma("unroll") for (int k = 0; k < 2; ++k) dst[n][k] = *(const LAS bf16x8*)(lds + PG8_SB(b, h) + boff + n * 2048 + k * 1024); } while (0)
#define PG8_MMA(ai, bj, At, Bt) do { __builtin_amdgcn_s_setprio(1); _Pragma("unroll") for (int m = 0; m < 4; ++m) _Pragma("unroll") for (int n = 0; n < 2; ++n) _Pragma("unroll") for (int k = 0; k < 2; ++k) \
        acc[ai][bj][m][n] = __builtin_amdgcn_mfma_f32_16x16x32_bf16(Bt[n][k], At[m][k], acc[ai][bj][m][n], 0, 0, 0); __builtin_amdgcn_s_setprio(0); } while (0)
#define PG8_WAIT_V(n) asm volatile("s_waitcnt vmcnt(" #n ")" ::: "memory")
#define PG8_WAIT_L(n) asm volatile("s_waitcnt lgkmcnt(" #n ")" ::: "memory")
#define PG8_BAR __builtin_amdgcn_s_barrier()
#define PG8_SCHED __builtin_amdgcn_sched_barrier(0)
    Unit cur, nxt; int ui = 0;
    if (!S.next(0, cur)) return;
    f32x4 acc[2][2][4][2];
#pragma unroll
    for (int a = 0; a < 2; ++a)
#pragma unroll
        for (int b = 0; b < 2; ++b)
#pragma unroll
            for (int m = 0; m < 4; ++m)
#pragma unroll
                for (int n = 0; n < 2; ++n) acc[a][b][m][n] = (f32x4){0.f, 0.f, 0.f, 0.f};
    bf16x8 At[4][2], B0[2][2], B1[2][2];
    const char* const abase = S.abase;
    unsigned va00 = S.a_off(cur, RA[0]) + CA[0], va01 = S.a_off(cur, RA[1]) + CA[1], va10 = S.a_off(cur, RA[0] + HALF) + CA[0], va11 = S.a_off(cur, RA[1] + HALF) + CA[1];
    const char* cB = S.b_ptr(cur);
    PG8_STAGE(PG8_SB(0, 0), cB, voffB[0], voffB[1]); PG8_STAGE(PG8_SB(0, 1), cB + hstep, voffB[0], voffB[1]); PG8_STAGE(PG8_SA(0, 0), abase, va00, va01); PG8_STAGE(PG8_SA(0, 1), abase, va10, va11);
    if (wr == 1) PG8_BAR;
    PG8_WAIT_V(2); PG8_BAR;
    PG8_STAGE(PG8_SB(1, 0), cB + kstep, voffB[0], voffB[1]); PG8_STAGE(PG8_SA(1, 0), abase + ka, va00, va01); PG8_STAGE(PG8_SB(1, 1), cB + hstep + kstep, voffB[0], voffB[1]);
    PG8_WAIT_V(6); PG8_BAR;
    for (;;) {
        const bool has_next = S.next(ui + 1, nxt);
        unsigned na00 = va00, na01 = va01, na10 = va10, na11 = va11; const char* nB = cB;
        if (has_next) { na00 = S.a_off(nxt, RA[0]) + CA[0]; na01 = S.a_off(nxt, RA[1]) + CA[1]; na10 = S.a_off(nxt, RA[0] + HALF) + CA[0]; na11 = S.a_off(nxt, RA[1] + HALF) + CA[1]; nB = S.b_ptr(nxt); }
        for (int t = 0; t < nt; t += 2) {
            const bool last = (t == nt - 2);
            const char* a1 = abase + (size_t)(t + 1) * ka;
            const char* a2 = last ? abase : abase + (size_t)(t + 2) * ka; const char* b2 = last ? nB : cB + (size_t)(t + 2) * kstep;
            const char* a3 = a2 + ka; const char* b3 = b2 + kstep;
            const unsigned x00 = last ? na00 : va00, x01 = last ? na01 : va01, x10 = last ? na10 : va10, x11 = last ? na11 : va11;
            PG8_LDB(B0, 0, 0); PG8_LDB(B1, 0, 1); PG8_SCHED; PG8_LDA(At, 0, 0); PG8_STAGE(PG8_SA(1, 1), a1, va10, va11);
            PG8_WAIT_V(8); PG8_WAIT_L(0); PG8_BAR; PG8_MMA(0, 0, At, B0); PG8_MMA(0, 1, At, B1); PG8_BAR; PG8_SCHED;
            PG8_LDA(At, 0, 1); PG8_STAGE(PG8_SB(0, 0), b2, voffB[0], voffB[1]); PG8_STAGE(PG8_SB(0, 1), b2 + hstep, voffB[0], voffB[1]); PG8_STAGE(PG8_SA(0, 0), a2, x00, x01);
            PG8_WAIT_V(8); PG8_WAIT_L(0); PG8_BAR; PG8_MMA(1, 0, At, B0); PG8_MMA(1, 1, At, B1); PG8_BAR; PG8_SCHED;
            PG8_LDB(B0, 1, 0); PG8_LDB(B1, 1, 1); PG8_SCHED; PG8_LDA(At, 1, 0); PG8_STAGE(PG8_SA(0, 1), a2, x10, x11);
            PG8_WAIT_V(8); PG8_WAIT_L(0); PG8_BAR; PG8_MMA(0, 0, At, B0); PG8_MMA(0, 1, At, B1); PG8_BAR; PG8_SCHED;
            PG8_LDA(At, 1, 1); PG8_STAGE(PG8_SB(1, 0), b3, voffB[0], voffB[1]); PG8_STAGE(PG8_SB(1, 1), b3 + hstep, voffB[0], voffB[1]); PG8_STAGE(PG8_SA(1, 0), a3, x00, x01);
            PG8_WAIT_V(8); PG8_WAIT_L(0); PG8_BAR; PG8_MMA(1, 0, At, B0); PG8_MMA(1, 1, At, B1); PG8_BAR; PG8_SCHED;
        }
        if (wr == 0) PG8_BAR;
        E(acc, cur, wr, wc, fr, fq);
        if (!has_next) break;
#pragma unroll
        for (int a = 0; a < 2; ++a)
#pragma unroll
            for (int b = 0; b < 2; ++b)
#pragma unroll
                for (int m = 0; m < 4; ++m)
#pragma unroll
                    for (int n = 0; n < 2; ++n) acc[a][b][m][n] = (f32x4){0.f, 0.f, 0.f, 0.f};
        cur = nxt; cB = nB; va00 = na00; va01 = na01; va10 = na10; va11 = na11; ++ui;
        if (wr == 1) PG8_BAR;
    }
    PG8_WAIT_V(0);
    PG8_BAR;
#undef PG8_SA
#undef PG8_SB
#undef PG8_STAGE
#undef PG8_LDA
#undef PG8_LDB
#undef PG8_MMA
#undef PG8_WAIT_V
#undef PG8_WAIT_L
#undef PG8_BAR
#undef PG8_SCHED
}
}

__host__ __device__ __forceinline__ int vperm(int key) { const int x = key & 31; return (key & ~31) | (8 * ((x >> 2) & 3) + 4 * ((x >> 4) & 1) + (x & 3)); }
using pg8::Unit;
struct SchedDense {
    const char* abase; unsigned a_kstep; int K;
    unsigned a_base; unsigned lda; const char* Bt; pg8::DenseOrder ord;
    __device__ __forceinline__ bool next(int i, Unit& u) const { return ord.next(i, u); }
    __device__ __forceinline__ unsigned a_off(const Unit& u, int R) const { return a_base + (unsigned)(u.pm * 256 + R) * lda; }
    __device__ __forceinline__ const char* b_ptr(const Unit& u) const { return Bt + (size_t)u.pn * 256 * K * 2; }
};
__device__ __forceinline__ SchedDense make_dense(const char* ws, size_t a_off, int lda_bytes, const char* Bt, int M, int N, int K) {
    SchedDense S; S.abase = ws; S.a_kstep = 128; S.K = K; S.a_base = (unsigned)a_off; S.lda = (unsigned)lda_bytes; S.Bt = Bt; S.ord.init(M / 256, N / 256, (int)gridDim.x, (int)blockIdx.x); return S;
}
struct SchedCmp1 {
    const char* abase; unsigned a_kstep; int K; const char* Bt; pg8::DenseOrder ord;
    __device__ __forceinline__ bool next(int i, Unit& u) const { return ord.next(i, u); }
    __device__ __forceinline__ unsigned a_off(const Unit& u, int R) const {
        const int row = u.pm * 256 + R, g = row & 3, bn = row >> 2, b = bn >> 9; int n = bn & 511; n = n > 510 ? 510 : n;
        return (unsigned)(u.pn ? WS_VCR : WS_KCR) + (unsigned)(((b * SEQ + 16 * n) * KVW + g * HD) * 2);
    }
    __device__ __forceinline__ const char* b_ptr(const Unit& u) const { return Bt + (size_t)u.pn * 256 * 2048 * 2; }
};
struct SchedCmp2 {
    const char* abase; unsigned a_kstep; int K; const char* Bt; pg8::DenseOrder ord;
    __device__ __forceinline__ bool next(int i, Unit& u) const { return ord.next(i, u); }
    __device__ __forceinline__ unsigned a_off(const Unit& u, int R) const { return (unsigned)WS_CMPH + (unsigned)(((u.pn * 16384) + u.pm * 256 + R) * 512); }
    __device__ __forceinline__ const char* b_ptr(const Unit& u) const { return Bt + (size_t)u.pn * 256 * 256 * 2; }
};

struct EpiProj {
    static constexpr bool PERM = true;
    unsigned char* ws;
    __device__ __forceinline__ void operator()(const f32x4 (&acc)[2][2][4][2], const Unit& u, int wr, int wc, int fr, int fq) const {
        const int pn = u.pn;
#pragma unroll
        for (int ai = 0; ai < 2; ++ai)
#pragma unroll
            for (int m = 0; m < 4; ++m) {
                const int row = u.pm * 256 + 128 * ai + 64 * wr + 16 * m + fr;
#pragma unroll
                for (int bj = 0; bj < 2; ++bj) {
                    const int c8 = 128 * bj + 32 * wc + 8 * fq;
                    float v[8];
#pragma unroll
                    for (int j = 0; j < 4; ++j) { v[j] = acc[ai][bj][m][0][j]; v[4 + j] = acc[ai][bj][m][1][j]; }
                    if (pn < 12 && pn != 9 && pn != 11) {
                        bf16_t* dst; float sc = 1.0f;
                        if (pn < 2) dst = (bf16_t*)(ws + WS_U) + (size_t)row * 512 + pn * 256 + c8;
                        else if (pn < 6) { dst = (bf16_t*)(ws + WS_Q) + (size_t)row * 1024 + (pn - 2) * 256 + c8; sc = 0.125f * 1.4426950408889634f; }
                        else { const size_t off = pn == 6 ? WS_KCR : pn == 7 ? WS_VCR : pn == 8 ? WS_KS : WS_KW; dst = (bf16_t*)(ws + off) + (size_t)row * 256 + c8; }
                        u32x4 w; w.x = pk2(v[0] * sc, v[1] * sc); w.y = pk2(v[2] * sc, v[3] * sc); w.z = pk2(v[4] * sc, v[5] * sc); w.w = pk2(v[6] * sc, v[7] * sc);
                        *(u32x4*)dst = w;
                    } else if (pn == 9 || pn == 11) {
                        bf16_t* base = (bf16_t*)(ws + (pn == 9 ? WS_VST : WS_VWT));
                        const int b = row >> 13, t = row & (SEQ - 1);
#pragma unroll
                        for (int e = 0; e < 8; ++e) { const int c = c8 + e, g = c >> 6, d = c & 63; base[((size_t)((b * 4 + g) * 64 + d)) * SEQ + vperm(t)] = (bf16_t)f2bf(v[e]); }
                    } else if (pn < 20) {
                        bf16_t* dst = (bf16_t*)(ws + WS_MG) + (size_t)row * 2048 + (pn - 12) * 256 + c8;
                        u32x4 w; w.x = pk2(sigmoidf_(v[0]), sigmoidf_(v[1])); w.y = pk2(sigmoidf_(v[2]), sigmoidf_(v[3])); w.z = pk2(sigmoidf_(v[4]), sigmoidf_(v[5])); w.w = pk2(sigmoidf_(v[6]), sigmoidf_(v[7]));
                        *(u32x4*)dst = w;
                    } else {
                        if (c8 < 48) { float* dst = (float*)(ws + WS_GATES) + (size_t)row * 48 + c8;
                            *(f32x4*)dst = (f32x4){sigmoidf_(v[0]), sigmoidf_(v[1]), sigmoidf_(v[2]), sigmoidf_(v[3])}; *(f32x4*)(dst + 4) = (f32x4){sigmoidf_(v[4]), sigmoidf_(v[5]), sigmoidf_(v[6]), sigmoidf_(v[7])}; }
                    }
                }
            }
    }
};
struct EpiCmp1 {
    static constexpr bool PERM = true;
    unsigned char* ws;
    __device__ __forceinline__ void operator()(const f32x4 (&acc)[2][2][4][2], const Unit& u, int wr, int wc, int fr, int fq) const {
        const float* bias = (const float*)(ws + WS_CTL + 65536) + u.pn * 256;
#pragma unroll
        for (int bj = 0; bj < 2; ++bj) {
            const int c8 = 128 * bj + 32 * wc + 8 * fq;
            const f32x4 b0 = *(const f32x4*)(bias + c8), b1 = *(const f32x4*)(bias + c8 + 4);
#pragma unroll
            for (int ai = 0; ai < 2; ++ai)
#pragma unroll
                for (int m = 0; m < 4; ++m) {
                    const int row = u.pm * 256 + 128 * ai + 64 * wr + 16 * m + fr;
                    const f32x4 x0 = acc[ai][bj][m][0] + b0, x1 = acc[ai][bj][m][1] + b1;
                    u32x4 w; w.x = pk2(gelu_tanh(x0[0]), gelu_tanh(x0[1])); w.y = pk2(gelu_tanh(x0[2]), gelu_tanh(x0[3])); w.z = pk2(gelu_tanh(x1[0]), gelu_tanh(x1[1])); w.w = pk2(gelu_tanh(x1[2]), gelu_tanh(x1[3]));
                    *(u32x4*)((bf16_t*)(ws + WS_CMPH) + ((size_t)u.pn * 16384 + row) * 256 + c8) = w;
                }
        }
    }
};
struct EpiCmp2 {
    static constexpr bool PERM = false;
    unsigned char* ws;
    __device__ __forceinline__ void operator()(const f32x4 (&acc)[2][2][4][2], const Unit& u, int wr, int wc, int fr, int fq) const {
        if (wc >= 2) return;
#pragma unroll
        for (int ai = 0; ai < 2; ++ai)
#pragma unroll
            for (int m = 0; m < 4; ++m) {
                const int row = u.pm * 256 + 128 * ai + 64 * wr + 16 * m + fr;
#pragma unroll
                for (int n = 0; n < 2; ++n) {
                    const int c = 32 * wc + 16 * n + 4 * fq; const f32x4 x = acc[ai][0][m][n];
                    if (u.pn == 0) { u32x2 w; w.x = pk2(x[0], x[1]); w.y = pk2(x[2], x[3]); *(u32x2*)((bf16_t*)(ws + WS_KC) + (size_t)row * 64 + c) = w; }
                    else { const int g = row & 3, bn = row >> 2, b = bn >> 9, nn = bn & 511; bf16_t* base = (bf16_t*)(ws + WS_VCT) + ((size_t)((b * 4 + g) * 64 + c)) * NCMP_PAD + vperm(nn);
#pragma unroll
                        for (int j = 0; j < 4; ++j) base[(size_t)j * NCMP_PAD] = (bf16_t)f2bf(x[j]); }
                }
            }
    }
};
struct EpiGlu {
    static constexpr bool PERM = true;
    unsigned char* ws;
    __device__ __forceinline__ void operator()(const f32x4 (&acc)[2][2][4][2], const Unit& u, int wr, int wc, int fr, int fq) const {
        const int col = u.pn * 128 + 32 * wc + 8 * fq;
#pragma unroll
        for (int ai = 0; ai < 2; ++ai) {
            u32x4 g0[4], g1[4], yn[4];
#pragma unroll
            for (int m = 0; m < 4; ++m) { const int row = u.pm * 256 + 128 * ai + 64 * wr + 16 * m + fr;
                g0[m] = *(const u32x4*)((const bf16_t*)(ws + WS_MG) + (size_t)row * 2048 + col);
                g1[m] = *(const u32x4*)((const bf16_t*)(ws + WS_MG) + (size_t)row * 2048 + 1024 + col);
                yn[m] = *(const u32x4*)((const bf16_t*)(ws + WS_YNSA) + (size_t)row * 1024 + col); }
#pragma unroll
            for (int m = 0; m < 4; ++m) { const int row = u.pm * 256 + 128 * ai + 64 * wr + 16 * m + fr;
                float o[8];
#pragma unroll
                for (int e = 0; e < 8; ++e) { const float val = acc[ai][0][m][e >> 2][e & 3], gate = acc[ai][1][m][e >> 2][e & 3]; const float ys = val * sigmoidf_(gate);
                    const unsigned w0 = g0[m][e >> 1], w1 = g1[m][e >> 1], wy = yn[m][e >> 1];
                    const float a0 = (e & 1) ? bfhi(w0) : bflo(w0), a1 = (e & 1) ? bfhi(w1) : bflo(w1), yy = (e & 1) ? bfhi(wy) : bflo(wy);
                    o[e] = a0 * ys + a1 * yy; }
                u32x4 w; w.x = pk2(o[0], o[1]); w.y = pk2(o[2], o[3]); w.z = pk2(o[4], o[5]); w.w = pk2(o[6], o[7]);
                *(u32x4*)((bf16_t*)(ws + WS_MERGED) + (size_t)row * 1024 + col) = w; }
        }
    }
};
struct EpiWout {
    static constexpr bool PERM = false;
    const float* x; float* out; const float* gmod;
    __device__ __forceinline__ void operator()(const f32x4 (&acc)[2][2][4][2], const Unit& u, int wr, int wc, int fr, int fq) const {
        const int b = u.pm >> 5;
#pragma unroll
        for (int bj = 0; bj < 2; ++bj)
#pragma unroll
            for (int n = 0; n < 2; ++n) {
                const int col = u.pn * 256 + 128 * bj + 32 * wc + 16 * n + 4 * fq; const f32x4 gv = *(const f32x4*)(gmod + (size_t)b * 6144 + col);
                f32x4 xv[2][4];
#pragma unroll
                for (int ai = 0; ai < 2; ++ai)
#pragma unroll
                    for (int m = 0; m < 4; ++m) xv[ai][m] = *(const f32x4*)(x + (size_t)(u.pm * 256 + 128 * ai + 64 * wr + 16 * m + fr) * 1024 + col);
#pragma unroll
                for (int ai = 0; ai < 2; ++ai)
#pragma unroll
                    for (int m = 0; m < 4; ++m) *(f32x4*)(out + (size_t)(u.pm * 256 + 128 * ai + 64 * wr + 16 * m + fr) * 1024 + col) = xv[ai][m] * DN_ALPHA + gv * acc[ai][bj][m][n];
            }
    }
};
struct EpiF32 {
    static constexpr bool PERM = false;
    float* C; int ldc;
    __device__ __forceinline__ void operator()(const f32x4 (&acc)[2][2][4][2], const Unit& u, int wr, int wc, int fr, int fq) const {
#pragma unroll
        for (int ai = 0; ai < 2; ++ai)
#pragma unroll
            for (int m = 0; m < 4; ++m) { float* rowp = C + (size_t)(u.pm * 256 + 128 * ai + 64 * wr + 16 * m + fr) * ldc + u.pn * 256 + 32 * wc + 4 * fq;
#pragma unroll
                for (int bj = 0; bj < 2; ++bj)
#pragma unroll
                    for (int n = 0; n < 2; ++n) *(f32x4*)(rowp + bj * 128 + n * 16) = acc[ai][bj][m][n]; }
    }
};
struct EpiSwiglu {
    static constexpr bool PERM = true;
    bf16_t* H;
    __device__ __forceinline__ void operator()(const f32x4 (&acc)[2][2][4][2], const Unit& u, int wr, int wc, int fr, int fq) const {
#pragma unroll
        for (int ai = 0; ai < 2; ++ai)
#pragma unroll
            for (int m = 0; m < 4; ++m) {
                const size_t row = (size_t)u.pm * 256 + 128 * ai + 64 * wr + 16 * m + fr; const int col = u.pn * 128 + 32 * wc + 8 * fq;
                float o[8];
#pragma unroll
                for (int e = 0; e < 8; ++e) o[e] = siluf_(acc[ai][0][m][e >> 2][e & 3]) * acc[ai][1][m][e >> 2][e & 3];
                u32x4 w; w.x = pk2(o[0], o[1]); w.y = pk2(o[2], o[3]); w.z = pk2(o[4], o[5]); w.w = pk2(o[6], o[7]);
                *(u32x4*)(H + row * 256 + col) = w;
            }
    }
};

__device__ __forceinline__ int find_expert(const LAS int* tstart, int tau) {
    int lo = 0, hi = 256;
    while (hi - lo > 1) { const int mid = (lo + hi) >> 1; if (tstart[mid] <= tau) lo = mid; else hi = mid; }
    return lo;
}
struct SchedMoeGU {
    const char* abase; unsigned a_kstep; int K; const LAS int* tstart; const int* rowasg; const char* W; int G, c;
    __device__ __forceinline__ bool next(int i, Unit& u) const { const int x = c & 7, slot = c >> 3, per = (G >> 3) >> 1; const int tau = (i * 8 + x) * per + (slot >> 1); if ((G & 15) != 0 || tau >= tstart[256]) { if ((G & 15) != 0) { const int L = i * G + c; if (L >= 2 * tstart[256]) return false; u.pm = L >> 1; u.pn = L & 1; return true; } return false; } u.pm = tau; u.pn = slot & 1; return true; }
    __device__ __forceinline__ unsigned a_off(const Unit& u, int R) const { const int a = rowasg[u.pm * 256 + R]; const unsigned tok = a < 0 ? (unsigned)MTOK : (unsigned)a >> 3; return (unsigned)WS_H2 + tok * 2048u; }
    __device__ __forceinline__ const char* b_ptr(const Unit& u) const { const int e = find_expert(tstart, u.pm); return W + ((size_t)e * 512 + u.pn * 256) * 1024 * 2; }
};
struct SchedMoeD {
    const char* abase; unsigned a_kstep; int K; const LAS int* tstart; const char* W; int G, c;
    __device__ __forceinline__ bool next(int i, Unit& u) const { const int x = c & 7, slot = c >> 3, per = (G >> 3) >> 2; const int tau = (i * 8 + x) * per + (slot >> 2); if ((G & 31) != 0 || tau >= tstart[256]) { if ((G & 31) != 0) { const int L = i * G + c; if (L >= 4 * tstart[256]) return false; u.pm = L >> 2; u.pn = L & 3; return true; } return false; } u.pm = tau; u.pn = slot & 3; return true; }
    __device__ __forceinline__ unsigned a_off(const Unit& u, int R) const { return (unsigned)WS_HID + (unsigned)(u.pm * 256 + R) * 512u; }
    __device__ __forceinline__ const char* b_ptr(const Unit& u) const { const int e = find_expert(tstart, u.pm); return W + ((size_t)e * 1024 + u.pn * 256) * 256 * 2; }
};
struct EpiMoeDown {
    static constexpr bool PERM = true;
    unsigned char* O; const int* rowasg; const float* roww; int asg0;
    __device__ __forceinline__ void operator()(const f32x4 (&acc)[2][2][4][2], const Unit& u, int wr, int wc, int fr, int fq) const {
        int av[2][4]; float wv[2][4];
#pragma unroll
        for (int ai = 0; ai < 2; ++ai)
#pragma unroll
            for (int m = 0; m < 4; ++m) { const int row = u.pm * 256 + 128 * ai + 64 * wr + 16 * m + fr; av[ai][m] = rowasg[row]; wv[ai][m] = roww[row] * OUTS_SCALE; }
#pragma unroll
        for (int ai = 0; ai < 2; ++ai)
#pragma unroll
            for (int m = 0; m < 4; ++m) {
                const int a = av[ai][m]; const float w = wv[ai][m];
                if (a >= 0) { unsigned char* rowp = O + (size_t)(a - asg0) * 1024 + u.pn * 256 + 32 * wc + 8 * fq;
#pragma unroll
                    for (int bj = 0; bj < 2; ++bj) { f32x4 x0 = acc[ai][bj][m][0] * w, x1 = acc[ai][bj][m][1] * w;
#pragma unroll
                        for (int e = 0; e < 4; ++e) { x0[e] = fminf(fmaxf(x0[e], -440.f), 440.f); x1[e] = fminf(fmaxf(x1[e], -440.f), 440.f); }
                        int w0 = __builtin_amdgcn_cvt_pk_fp8_f32(x0[0], x0[1], 0, false); w0 = __builtin_amdgcn_cvt_pk_fp8_f32(x0[2], x0[3], w0, true);
                        int w1 = __builtin_amdgcn_cvt_pk_fp8_f32(x1[0], x1[1], 0, false); w1 = __builtin_amdgcn_cvt_pk_fp8_f32(x1[2], x1[3], w1, true);
                        u32x2 o; o.x = (unsigned)w0; o.y = (unsigned)w1; *(u32x2*)(rowp + bj * 128) = o; } }
            }
    }
};
struct EpiShDown {
    static constexpr bool PERM = true;
    unsigned char* O;
    __device__ __forceinline__ void operator()(const f32x4 (&acc)[2][2][4][2], const Unit& u, int wr, int wc, int fr, int fq) const {
#pragma unroll
        for (int ai = 0; ai < 2; ++ai)
#pragma unroll
            for (int m = 0; m < 4; ++m) { unsigned char* rowp = O + (size_t)(u.pm * 256 + 128 * ai + 64 * wr + 16 * m + fr) * 1024 + u.pn * 256 + 32 * wc + 8 * fq;
#pragma unroll
                for (int bj = 0; bj < 2; ++bj) { f32x4 x0 = acc[ai][bj][m][0] * OUTS_SCALE, x1 = acc[ai][bj][m][1] * OUTS_SCALE;
#pragma unroll
                    for (int e = 0; e < 4; ++e) { x0[e] = fminf(fmaxf(x0[e], -440.f), 440.f); x1[e] = fminf(fmaxf(x1[e], -440.f), 440.f); }
                    int w0 = __builtin_amdgcn_cvt_pk_fp8_f32(x0[0], x0[1], 0, false); w0 = __builtin_amdgcn_cvt_pk_fp8_f32(x0[2], x0[3], w0, true);
                    int w1 = __builtin_amdgcn_cvt_pk_fp8_f32(x1[0], x1[1], 0, false); w1 = __builtin_amdgcn_cvt_pk_fp8_f32(x1[2], x1[3], w1, true);
                    u32x2 o; o.x = (unsigned)w0; o.y = (unsigned)w1; *(u32x2*)(rowp + bj * 128) = o; } }
    }
};

__device__ __forceinline__ void transpose_item(const float* src, size_t ld, int nvalid, bf16_t* dst, size_t dld, LAS float* scr, int lane) {
    { const int j4 = lane & 7, k8 = lane >> 3;
        f32x4 v[8];
#pragma unroll
        for (int i = 0; i < 8; ++i) v[i] = 4 * j4 < nvalid ? *(const f32x4*)(src + (size_t)(8 * i + k8) * ld + 4 * j4) : (f32x4){0.f, 0.f, 0.f, 0.f};
#pragma unroll
        for (int i = 0; i < 8; ++i) { LAS float* d = scr + (8 * i + k8) * 33 + 4 * j4; d[0] = v[i][0]; d[1] = v[i][1]; d[2] = v[i][2]; d[3] = v[i][3]; } }
    LDS_WAIT(); asm volatile("" ::: "memory");
    const int c = lane & 7;
#pragma unroll
    for (int j = 0; j < 4; ++j) { const int n = (lane >> 3) + 8 * j; const LAS float* s = scr + (8 * c) * 33 + n;
        u32x4 o; o.x = pk2(s[0 * 33], s[1 * 33]); o.y = pk2(s[2 * 33], s[3 * 33]); o.z = pk2(s[4 * 33], s[5 * 33]); o.w = pk2(s[6 * 33], s[7 * 33]);
        *(u32x4*)(dst + (size_t)n * dld + 8 * c) = o; }
    LDS_WAIT(); asm volatile("" ::: "memory");
}
__device__ __forceinline__ void transpose_item2(const float* srcA, size_t ldA, bf16_t* dstA, size_t dldA, const float* srcB, size_t ldB, bf16_t* dstB, size_t dldB, LAS float* scr, int lane) {
    const int j4 = lane & 7, k8 = lane >> 3, c = lane & 7;
    f32x4 va[8], vb[8];
#pragma unroll
    for (int i = 0; i < 8; ++i) va[i] = *(const f32x4*)(srcA + (size_t)(8 * i + k8) * ldA + 4 * j4);
#pragma unroll
    for (int i = 0; i < 8; ++i) vb[i] = *(const f32x4*)(srcB + (size_t)(8 * i + k8) * ldB + 4 * j4);
#pragma unroll
    for (int i = 0; i < 8; ++i) { LAS float* d = scr + (8 * i + k8) * 33 + 4 * j4; d[0] = va[i][0]; d[1] = va[i][1]; d[2] = va[i][2]; d[3] = va[i][3]; }
    LDS_WAIT(); asm volatile("" ::: "memory");
#pragma unroll
    for (int j = 0; j < 4; ++j) { const int n = (lane >> 3) + 8 * j; const LAS float* sp = scr + (8 * c) * 33 + n;
        u32x4 o; o.x = pk2(sp[0 * 33], sp[1 * 33]); o.y = pk2(sp[2 * 33], sp[3 * 33]); o.z = pk2(sp[4 * 33], sp[5 * 33]); o.w = pk2(sp[6 * 33], sp[7 * 33]);
        *(u32x4*)(dstA + (size_t)n * dldA + 8 * c) = o; }
    LDS_WAIT(); asm volatile("" ::: "memory");
#pragma unroll
    for (int i = 0; i < 8; ++i) { LAS float* d = scr + (8 * i + k8) * 33 + 4 * j4; d[0] = vb[i][0]; d[1] = vb[i][1]; d[2] = vb[i][2]; d[3] = vb[i][3]; }
    LDS_WAIT(); asm volatile("" ::: "memory");
#pragma unroll
    for (int j = 0; j < 4; ++j) { const int n = (lane >> 3) + 8 * j; const LAS float* sp = scr + (8 * c) * 33 + n;
        u32x4 o; o.x = pk2(sp[0 * 33], sp[1 * 33]); o.y = pk2(sp[2 * 33], sp[3 * 33]); o.z = pk2(sp[4 * 33], sp[5 * 33]); o.w = pk2(sp[6 * 33], sp[7 * 33]);
        *(u32x4*)(dstB + (size_t)n * dldB + 8 * c) = o; }
    LDS_WAIT(); asm volatile("" ::: "memory");
}
struct In {
    const float *x, *c, *ada_w, *ada_b, *w_in, *lam_re, *lam_im, *log_step, *b_re, *b_im, *c_re, *c_im, *ssm_d, *glu_w, *cmp_pos, *cmp_w1, *cmp_w2, *rel_bias, *w_out,
        *ln1_g, *ln1_b, *router_w, *router_bias, *w_gate, *w_up, *w_down, *sh_gate, *sh_up, *sh_down, *ln2_g, *ln2_b;
};
static_assert(sizeof(In) == 31 * sizeof(void*), "In");

__device__ __forceinline__ void p0_small_weights(const In& in, unsigned char* ws, LAS float* scr, int gw, int NGW, int lane) {
    constexpr int I_WIN = 168 * 16, I_GLU = 64 * 8, I_WOUT = 32 * 16, I_ROUT = 8 * 16, I_SHGU = 16 * 16, I_SHD = 32 * 4, I_CW1 = 2 * 8 * 32, I_CW2 = 2 * 2 * 4;
    constexpr int NITEMS = I_WIN + I_GLU + I_WOUT + I_ROUT + I_SHGU + I_SHD + I_CW1 + I_CW2;
    for (int it = gw; it < NITEMS; it += NGW) {
        int r = it;
        if (r < I_WIN) { const int db = r / 16, kb = r % 16, n0 = 32 * db; int src, nv = 32;
            if (n0 < 3072) src = n0; else if (n0 < 5120) src = n0 + 48; else if (n0 < 5152) src = n0 - 2048; else if (n0 == 5152) { src = 3104; nv = 16; } else { src = 0; nv = 0; }
            transpose_item(in.w_in + (size_t)(64 * kb) * 5168 + src, 5168, nv, (bf16_t*)(ws + WS_WIN) + (size_t)n0 * 1024 + 64 * kb, 1024, scr, lane); continue; } r -= I_WIN;
        if (r < I_GLU) { const int db = r / 8, kb = r % 8, n0 = 32 * db, pn = n0 >> 8, half = (n0 >> 7) & 1, j = n0 & 127;
            transpose_item(in.glu_w + (size_t)(64 * kb) * 2048 + half * 1024 + pn * 128 + j, 2048, 32, (bf16_t*)(ws + WS_GLU) + (size_t)n0 * 512 + 64 * kb, 512, scr, lane); continue; } r -= I_GLU;
        if (r < I_WOUT) { const int db = r / 16, kb = r % 16;
            transpose_item(in.w_out + (size_t)(64 * kb) * 1024 + 32 * db, 1024, 32, (bf16_t*)(ws + WS_WOUT) + (size_t)(32 * db) * 1024 + 64 * kb, 1024, scr, lane); continue; } r -= I_WOUT;
        if (r < I_ROUT) { const int db = r / 16, kb = r % 16;
            transpose_item(in.router_w + (size_t)(64 * kb) * 256 + 32 * db, 256, 32, (bf16_t*)(ws + WS_ROUT) + (size_t)(32 * db) * 1024 + 64 * kb, 1024, scr, lane); continue; } r -= I_ROUT;
        if (r < I_SHGU) { const int db = r / 16, kb = r % 16, n0 = 32 * db, pn = n0 >> 8, half = (n0 >> 7) & 1, j = n0 & 127;
            transpose_item((half ? in.sh_up : in.sh_gate) + (size_t)(64 * kb) * 256 + pn * 128 + j, 256, 32, (bf16_t*)(ws + WS_SHGU) + (size_t)n0 * 1024 + 64 * kb, 1024, scr, lane); continue; } r -= I_SHGU;
        if (r < I_SHD) { const int db = r / 4, kb = r % 4;
            transpose_item(in.sh_down + (size_t)(64 * kb) * 1024 + 32 * db, 1024, 32, (bf16_t*)(ws + WS_SHD) + (size_t)(32 * db) * 256 + 64 * kb, 256, scr, lane); continue; } r -= I_SHD;
        if (r < I_CW1) { const int ts = r / 256, rr = r % 256, db = rr / 32, kb = rr % 32;
            transpose_item(in.cmp_w1 + (size_t)ts * 2048 * 256 + (size_t)(64 * kb) * 256 + 32 * db, 256, 32, (bf16_t*)(ws + WS_CW1) + (size_t)ts * 256 * 2048 + (size_t)(32 * db) * 2048 + 64 * kb, 2048, scr, lane); continue; } r -= I_CW1;
        { const int ts = r / 8, rr = r % 8, db = rr / 4, kb = rr % 4;
            transpose_item(in.cmp_w2 + (size_t)ts * 256 * 64 + (size_t)(64 * kb) * 64 + 32 * db, 64, 32, (bf16_t*)(ws + WS_CW2) + (size_t)ts * 256 * 256 + (size_t)(32 * db) * 256 + 64 * kb, 256, scr, lane); }
    }
    for (int i = gw * 64 + lane; i < 2 * 192 * 32; i += NGW * 64) { const int ts = i / (192 * 32), rr = i % (192 * 32); *(u32x4*)(ws + WS_CW2 + (size_t)ts * 256 * 512 + (size_t)64 * 512 + (size_t)rr * 16) = (u32x4){0u, 0u, 0u, 0u}; }
}
struct ConvItem { const float* src; size_t ld; bf16_t* dst; size_t dld; };
__device__ __forceinline__ void convert_expert_weights(const In& in, unsigned char* ws, LAS float* scr, int gw, int NGW, int lane, int part) {
    constexpr int I_GU = 256, I_D = 128;
    bool have = false; ConvItem pa{nullptr, 0, nullptr, 0};
    for (int it = gw; it < NEXP * (I_GU + I_D); it += NGW) {
        const int e = it / (I_GU + I_D), r = it % (I_GU + I_D);
        { const bool mid = e >= 63 && e <= 190; const bool early = r >= I_GU || !mid; if (early != (part == 0)) continue; }
        ConvItem d;
        if (r < I_GU) { const int db = r / 16, kb = r % 16, n0 = 32 * db, pn = n0 >> 8, half = (n0 >> 7) & 1, j = n0 & 127;
            d.src = (half ? in.w_up : in.w_gate) + (size_t)e * 1024 * 256 + (size_t)(64 * kb) * 256 + pn * 128 + j; d.ld = 256; d.dst = (bf16_t*)(ws + WS_WGU) + ((size_t)e * 512 + n0) * 1024 + 64 * kb; d.dld = 1024; }
        else { const int rr = r - I_GU, db = rr / 4, kb = rr % 4;
            d.src = in.w_down + (size_t)e * 256 * 1024 + (size_t)(64 * kb) * 1024 + 32 * db; d.ld = 1024; d.dst = (bf16_t*)(ws + WS_WD) + ((size_t)e * 1024 + 32 * db) * 256 + 64 * kb; d.dld = 256; }
        if (!have) { pa = d; have = true; }
        else { transpose_item2(pa.src, pa.ld, pa.dst, pa.dld, d.src, d.ld, d.dst, d.dld, scr, lane); have = false; }
    }
    if (have) transpose_item(pa.src, pa.ld, 32, pa.dst, pa.dld, scr, lane);
}

__device__ __forceinline__ void p0_mod(const In& in, unsigned char* ws, LAS unsigned char* lds, int tid) {
    LAS float* cond = (LAS float*)lds;
    LAS float* part = (LAS float*)(lds + 32768);
    for (int i = tid; i < 8192; i += NTHREADS) cond[i] = siluf_(in.c[i]);
    __syncthreads();
    const int col = tid % 24, ks = tid / 24, e = (int)blockIdx.x * 24 + col;
    if (tid < 504) {
        float a[8];
#pragma unroll
        for (int b = 0; b < 8; ++b) a[b] = 0.f;
        for (int k = ks; k < 1024; k += 21) { const float w = in.ada_w[(size_t)k * 6144 + e];
#pragma unroll
            for (int b = 0; b < 8; ++b) a[b] += cond[b * 1024 + k] * w; }
#pragma unroll
        for (int b = 0; b < 8; ++b) part[(ks * 24 + col) * 8 + b] = a[b];
    }
    __syncthreads();
    if (tid < 192) { const int c2 = tid % 24, b = tid / 24; float s = 0.f; for (int k = 0; k < 21; ++k) s += part[(k * 24 + c2) * 8 + b];
        const int e2 = (int)blockIdx.x * 24 + c2; ((float*)(ws + WS_MOD))[b * 6144 + e2] = s + in.ada_b[e2]; }
    __syncthreads();
}
__device__ __forceinline__ void p0_tables(const In& in, unsigned char* ws, LAS unsigned char* lds, int tid) {
    const int w = (int)blockIdx.x;
    if (w < 16) {
        const int ts = w >> 3, kq = w & 7, c = tid & 255, kh = tid >> 8; float s = 0.f;
        const float* pos = in.cmp_pos + ts * 2048; const float* w1 = in.cmp_w1 + (size_t)ts * 2048 * 256;
        for (int k = kq * 256 + kh * 128; k < kq * 256 + kh * 128 + 128; ++k) s += pos[k] * w1[(size_t)k * 256 + c];
        ((float*)(ws + WS_CTL + 131072))[((ts * 8 + kq) * 2 + kh) * 256 + c] = s;
    } else if (w == 16) {
        for (int i = tid; i < 16 * 132; i += NTHREADS) { const int h = i / 132, dd = i % 132; int bk;
            if (dd < 16) bk = dd; else { const int v = 16 + (int)(__logf((float)dd * (1.0f / 16.0f)) / 2.0794415416798357f * 16.0f); bk = v < 31 ? v : 31; }
            if (dd >= 128) bk = 31;
            ((float*)(ws + WS_TAB + TAB_LUT))[i] = in.rel_bias[bk * 16 + h] * 1.4426950408889634f; }
    } else if (w >= 32 && w < 64) {
        const int g = w - 32;
        LAS float* bbr = (LAS float*)lds; LAS float* bbi = bbr + 1024;
        if (tid < 64) { const int p = tid; const float lr = in.lam_re[g * 64 + p], li = in.lam_im[g * 64 + p], dt = expf(in.log_step[g]);
            const float mag = expf(lr * dt), ar = mag * cosf(li * dt), ai = mag * sinf(li * dt), den = lr * lr + li * li;
            const float kr = ((ar - 1.0f) * lr + ai * li) / den, ki = (ai * lr - (ar - 1.0f) * li) / den;
            for (int c = 0; c < 16; ++c) { const float br = in.b_re[(g * 64 + p) * 16 + c], bi = in.b_im[(g * 64 + p) * 16 + c]; bbr[p * 16 + c] = kr * br - ki * bi; bbi[p * 16 + c] = kr * bi + ki * br; }
            float* A = (float*)(ws + WS_S5T + S5_A) + (g * 64 + p) * 2; A[0] = ar; A[1] = ai;
            float xr = ar, xi = ai; for (int s = 0; s < 10; ++s) { const float nr = xr * xr - xi * xi, ni = 2.0f * xr * xi; xr = nr; xi = ni; }
            float* AC = (float*)(ws + WS_S5T + S5_AC) + (g * 64 + p) * 2; AC[0] = xr; AC[1] = xi; }
        __syncthreads();
        { const int f = tid >> 6, lane = tid & 63, pt = f >> 1, ri = f & 1, p = 16 * pt + (lane & 15), q = lane >> 4;
            bf16_t* dst = (bf16_t*)(ws + WS_S5T + S5_AFR) + ((size_t)(g * 8 + f) * 64 + lane) * 8;
            for (int j = 0; j < 8; ++j) { const float v = q < 2 ? (ri ? bbi : bbr)[p * 16 + 8 * q + j] : 0.f; dst[j] = (bf16_t)f2bf(v); } }
        if (tid < 256) { const int s = tid >> 6, lane = tid & 63, c = lane & 15, q = lane >> 4;
            bf16_t* dst = (bf16_t*)(ws + WS_S5T + S5_CFR) + ((size_t)(g * 4 + s) * 64 + lane) * 8;
            for (int j = 0; j < 8; ++j) { const int k = 32 * s + 8 * q + j, p = k >> 1; const float v = (k & 1) ? -in.c_im[(g * 16 + c) * 64 + p] : in.c_re[(g * 16 + c) * 64 + p]; dst[j] = (bf16_t)f2bf(v); } }
        __syncthreads();
    }
}

struct RowV { f32x4 v[4]; };
__device__ __forceinline__ RowV row_load(const float* p, int lane) { RowV r; const f32x4* q = (const f32x4*)p + lane;
#pragma unroll
    for (int j = 0; j < 4; ++j) r.v[j] = q[64 * j]; return r; }
__device__ __forceinline__ void row_norm(RowV& r) {
    float s = 0.f;
#pragma unroll
    for (int j = 0; j < 4; ++j) s += (r.v[j].x + r.v[j].y) + (r.v[j].z + r.v[j].w);
    const float mean = wave_sum(s) * (1.f / DM); float s2 = 0.f;
#pragma unroll
    for (int j = 0; j < 4; ++j) { r.v[j] = r.v[j] - mean; s2 += (r.v[j].x * r.v[j].x + r.v[j].y * r.v[j].y) + (r.v[j].z * r.v[j].z + r.v[j].w * r.v[j].w); }
    const float rstd = 1.f / sqrtf(wave_sum(s2) * (1.f / DM) + LN_EPS);
#pragma unroll
    for (int j = 0; j < 4; ++j) r.v[j] = r.v[j] * rstd;
}
__device__ __forceinline__ void row_norm_stats(RowV& r, float& mean_o, float& rstd_o) {
    float s = 0.f;
#pragma unroll
    for (int j = 0; j < 4; ++j) s += (r.v[j].x + r.v[j].y) + (r.v[j].z + r.v[j].w);
    const float mean = wave_sum(s) * (1.f / DM); float s2 = 0.f;
#pragma unroll
    for (int j = 0; j < 4; ++j) { r.v[j] = r.v[j] - mean; s2 += (r.v[j].x * r.v[j].x + r.v[j].y * r.v[j].y) + (r.v[j].z * r.v[j].z + r.v[j].w * r.v[j].w); }
    const float rstd = 1.f / sqrtf(wave_sum(s2) * (1.f / DM) + LN_EPS);
#pragma unroll
    for (int j = 0; j < 4; ++j) r.v[j] = r.v[j] * rstd;
    mean_o = mean; rstd_o = rstd;
}
__device__ __forceinline__ void row_store_bf16(bf16_t* p, const RowV& r, int lane) { u32x2* o = (u32x2*)p + lane;
#pragma unroll
    for (int j = 0; j < 4; ++j) { u32x2 w; w.x = pk2(r.v[j].x, r.v[j].y); w.y = pk2(r.v[j].z, r.v[j].w); o[64 * j] = w; } }
__device__ __forceinline__ void ph_h1(const In& in, unsigned char* ws, int gw, int NGW, int lane) {
    const float* mod = (const float*)(ws + WS_MOD);
    for (int row = gw; row < MTOK; row += NGW) { const int b = row >> 13;
        RowV r = row_load(in.x + (size_t)row * DM, lane); row_norm(r);
        const RowV sh = row_load(mod + b * 6144, lane), sc = row_load(mod + b * 6144 + 1024, lane);
#pragma unroll
        for (int j = 0; j < 4; ++j) r.v[j] = r.v[j] * (sc.v[j] + 1.0f) + sh.v[j];
        row_store_bf16((bf16_t*)(ws + WS_H1) + (size_t)row * DM, r, lane); }
}
__device__ __forceinline__ void ph_ln1(const In& in, unsigned char* ws, float* r1, int gw, int NGW, int lane) {
    const float* mod = (const float*)(ws + WS_MOD);
    const RowV g = row_load(in.ln1_g, lane), bb = row_load(in.ln1_b, lane);
    for (int row = gw; row < MTOK; row += NGW) { const int b = row >> 13;
        RowV r = row_load(r1 + (size_t)row * DM, lane); float mean, rstd; row_norm_stats(r, mean, rstd);
        if (lane == 0) *(f32x2*)((float*)(ws + WS_LNST) + (size_t)row * 2) = (f32x2){mean, rstd};
#pragma unroll
        for (int j = 0; j < 4; ++j) r.v[j] = r.v[j] * g.v[j] + bb.v[j];
        row_norm(r);
        const RowV sh = row_load(mod + b * 6144 + 3072, lane), sc = row_load(mod + b * 6144 + 4096, lane);
#pragma unroll
        for (int j = 0; j < 4; ++j) r.v[j] = r.v[j] * (sc.v[j] + 1.0f) + sh.v[j];
        row_store_bf16((bf16_t*)(ws + WS_H2) + (size_t)row * DM, r, lane); }
}
__device__ __forceinline__ void final_row(const In& in, unsigned char* ws, float* out, int tok, int chunk, const RowV& g, const RowV& bb, const RowV& g1, const RowV& b1, int lane) {
    const float* mod = (const float*)(ws + WS_MOD); const int b = tok >> 13;
    RowV v = row_load(out + (size_t)tok * DM, lane); const RowV g2 = row_load(mod + b * 6144 + 5120, lane);
    const f32x2 stt = *(const f32x2*)((const float*)(ws + WS_LNST) + (size_t)tok * 2);
    const unsigned* sp = (const unsigned*)(ws + WS_OUTS + (size_t)(tok - chunk * CHUNK_TOK) * 8 * DM) + lane;
    const unsigned* shp = (const unsigned*)(ws + WS_SHOUT + (size_t)tok * DM) + lane;
    f32x4 acc[4];
#pragma unroll
    for (int j = 0; j < 4; ++j) { const int w = (int)shp[64 * j]; const f32x2 lo = __builtin_amdgcn_cvt_pk_f32_fp8(w, false), hi = __builtin_amdgcn_cvt_pk_f32_fp8(w, true); acc[j] = (f32x4){lo.x, lo.y, hi.x, hi.y}; }
#pragma unroll
    for (int k = 0; k < 8; ++k)
#pragma unroll
        for (int j = 0; j < 4; ++j) { const int w = (int)sp[k * 256 + 64 * j]; const f32x2 lo = __builtin_amdgcn_cvt_pk_f32_fp8(w, false), hi = __builtin_amdgcn_cvt_pk_f32_fp8(w, true);
            acc[j] = acc[j] + (f32x4){lo.x, lo.y, hi.x, hi.y}; }
#pragma unroll
    for (int j = 0; j < 4; ++j) { const f32x4 x1 = (v.v[j] - stt.x) * stt.y * g1.v[j] + b1.v[j]; v.v[j] = x1 * DN_ALPHA + g2.v[j] * (acc[j] * (1.0f / OUTS_SCALE)); }
    row_norm(v);
    f32x4* o = (f32x4*)(out + (size_t)tok * DM) + lane;
#pragma unroll
    for (int j = 0; j < 4; ++j) o[64 * j] = v.v[j] * g.v[j] + bb.v[j];
}
__device__ __forceinline__ void final_chunk(const In& in, unsigned char* ws, float* out, unsigned* ticket, int chunk, volatile LAS unsigned* bcast, int tid, int wave, int lane) {
    int ll = lane; asm volatile("" : "+v"(ll));
    const RowV g = row_load(in.ln2_g, ll), bb = row_load(in.ln2_b, ll), g1 = row_load(in.ln1_g, ll), b1 = row_load(in.ln1_b, ll);
    for (;;) {
        __syncthreads();
        if (tid == 0) bcast[0] = __hip_atomic_fetch_add(ticket, 64u, RLX_AGENT);
        __syncthreads();
        const unsigned base = bcast[0];
        if (base >= (unsigned)chunk_ntok(chunk)) break;
        for (int i = 0; i < 8; ++i) final_row(in, ws, out, chunk * CHUNK_TOK + (int)base + wave * 8 + i, chunk, g, bb, g1, b1, lane);
    }
}
constexpr int S5_LDS_PER_WAVE = 4352;
template <bool FULL>
__device__ __forceinline__ void s5_task(const In& in, unsigned char* ws, LAS unsigned char* wlds, int b, int g, int ch, int lane) {
    const int col = lane & 15, q = lane >> 4;
    LAS unsigned* BU = (LAS unsigned*)wlds;
    LAS unsigned char* XB = wlds;
    bf16x8 afr[8], cfr[4];
#pragma unroll
    for (int f = 0; f < 8; ++f) afr[f] = *(const bf16x8*)((const bf16_t*)(ws + WS_S5T + S5_AFR) + ((size_t)(g * 8 + f) * 64 + lane) * 8);
    if (FULL) {
#pragma unroll
        for (int s = 0; s < 4; ++s) cfr[s] = *(const bf16x8*)((const bf16_t*)(ws + WS_S5T + S5_CFR) + ((size_t)(g * 4 + s) * 64 + lane) * 8);
    }
    const float ar = ((const float*)(ws + WS_S5T + S5_A))[(g * 64 + lane) * 2], ai = ((const float*)(ws + WS_S5T + S5_A))[(g * 64 + lane) * 2 + 1];
    float xr = 0.f, xi = 0.f;
    float* st = (float*)(ws + WS_S5ST);
    if (FULL) {
        const float cr_ = ((const float*)(ws + WS_S5T + S5_AC))[(g * 64 + lane) * 2], ci_ = ((const float*)(ws + WS_S5T + S5_AC))[(g * 64 + lane) * 2 + 1];
        for (int c2 = 0; c2 < ch; ++c2) { const float sr = st[((size_t)((b * 32 + g) * 8 + c2) * 64 + lane) * 2], si = st[((size_t)((b * 32 + g) * 8 + c2) * 64 + lane) * 2 + 1];
            const float nr = cr_ * xr - ci_ * xi + sr, ni = cr_ * xi + ci_ * xr + si; xr = nr; xi = ni; }
    }
    const bf16_t* U = (const bf16_t*)(ws + WS_U);
    f32x4 dsk = (f32x4){0.f, 0.f, 0.f, 0.f};
    if (FULL) dsk = *(const f32x4*)(in.ssm_d + g * 16 + 4 * q);
    const size_t row00 = (size_t)b * SEQ + (size_t)ch * 1024;
    for (int sb = 0; sb < 64; ++sb) {
        const size_t row0 = row00 + 16 * sb;
        bf16x8 ufr = (bf16x8){0, 0, 0, 0, 0, 0, 0, 0};
        if (q < 2) ufr = *(const bf16x8*)(U + (row0 + col) * 512 + g * 16 + 8 * q);
#pragma unroll
        for (int pt = 0; pt < 4; ++pt) {
            const f32x4 dr = __builtin_amdgcn_mfma_f32_16x16x32_bf16(afr[2 * pt], ufr, (f32x4){0.f, 0.f, 0.f, 0.f}, 0, 0, 0);
            const f32x4 di = __builtin_amdgcn_mfma_f32_16x16x32_bf16(afr[2 * pt + 1], ufr, (f32x4){0.f, 0.f, 0.f, 0.f}, 0, 0, 0);
            u32x4 w; w.x = pk2(dr[0], di[0]); w.y = pk2(dr[1], di[1]); w.z = pk2(dr[2], di[2]); w.w = pk2(dr[3], di[3]);
            *(LAS u32x4*)(BU + col * 68 + 16 * pt + 4 * q) = w; }
        asm volatile("s_waitcnt lgkmcnt(0)" ::: "memory");
#pragma unroll
        for (int t = 0; t < 16; ++t) { const unsigned bw = BU[t * 68 + lane]; const float br = bflo(bw), bi = bfhi(bw);
            const float nr = ar * xr - ai * xi + br, ni = ar * xi + ai * xr + bi; xr = nr; xi = ni;
            if (FULL) *(LAS unsigned*)(XB + t * 272 + 4 * lane) = pk2(xr, xi); }
        asm volatile("s_waitcnt lgkmcnt(0)" ::: "memory");
        if (FULL) {
            f32x4 y = (f32x4){0.f, 0.f, 0.f, 0.f};
#pragma unroll
            for (int s = 0; s < 4; ++s) { const bf16x8 xf = *(const LAS bf16x8*)(XB + col * 272 + (32 * s + 8 * q) * 2); y = __builtin_amdgcn_mfma_f32_16x16x32_bf16(cfr[s], xf, y, 0, 0, 0); }
            const u32x2 uw = *(const u32x2*)(U + (row0 + col) * 512 + g * 16 + 4 * q);
            const f32x4 uv = (f32x4){bflo(uw.x), bfhi(uw.x), bflo(uw.y), bfhi(uw.y)};
            y = y + dsk * uv;
            u32x2 o; o.x = pk2(gelu_tanh(y[0]), gelu_tanh(y[1])); o.y = pk2(gelu_tanh(y[2]), gelu_tanh(y[3]));
            *(u32x2*)((bf16_t*)(ws + WS_Z) + (row0 + col) * 512 + g * 16 + 4 * q) = o;
            asm volatile("s_waitcnt lgkmcnt(0)" ::: "memory");
        }
    }
    if (!FULL) { st[((size_t)((b * 32 + g) * 8 + ch) * 64 + lane) * 2] = xr; st[((size_t)((b * 32 + g) * 8 + ch) * 64 + lane) * 2 + 1] = xi; }
}

constexpr int NSA_KB = 0, NSA_VB = 32768, NSA_IMP = 65536, NSA_RES = 65536;
static_assert(NSA_IMP + 67584 <= MISC_OFF && NSA_RES + 65536 <= MISC_OFF, "attention LDS map");
__device__ __forceinline__ bf16x8 pack8(const f32x4& a, const f32x4& b) {
    u32x4 w; w.x = pk2(a[0], a[1]); w.y = pk2(a[2], a[3]); w.z = pk2(b[0], b[1]); w.w = pk2(b[2], b[3]); return __builtin_bit_cast(bf16x8, w);
}
struct Softmax { float m; f32x4 l; };
typedef unsigned u32x2s __attribute__((ext_vector_type(2)));
__device__ __forceinline__ float fmax_x16(float x) { return fmaxf(x, __shfl_xor(x, 16)); }
__device__ __forceinline__ float fmax_x32(float x) { return fmaxf(x, __shfl_xor(x, 32)); }
__device__ __forceinline__ float fadd_x16(float x) { return x + __shfl_xor(x, 16); }
__device__ __forceinline__ float fadd_x32(float x) { return x + __shfl_xor(x, 32); }
__device__ __forceinline__ unsigned or_x16(unsigned u) { return u | __shfl_xor(u, 16); }
__device__ __forceinline__ unsigned or_x32(unsigned u) { return u | __shfl_xor(u, 32); }
__device__ __forceinline__ float dpp_x1(float x) { return __builtin_bit_cast(float, __builtin_amdgcn_update_dpp(0, __builtin_bit_cast(int, x), 0xB1, 0xF, 0xF, true)); }
__device__ __forceinline__ float dpp_x2(float x) { return __builtin_bit_cast(float, __builtin_amdgcn_update_dpp(0, __builtin_bit_cast(int, x), 0x4E, 0xF, 0xF, true)); }
__device__ __forceinline__ int dpp_x1i(int x) { return __builtin_amdgcn_update_dpp(0, x, 0xB1, 0xF, 0xF, true); }
__device__ __forceinline__ int dpp_x2i(int x) { return __builtin_amdgcn_update_dpp(0, x, 0x4E, 0xF, 0xF, true); }
__device__ __forceinline__ float ex2(float x) { return __builtin_amdgcn_exp2f(x); }
__device__ __forceinline__ float max16(const f32x4 (&S)[4]) {
    float a = fmaxf(fmaxf(S[0][0], S[0][1]), S[0][2]); a = fmaxf(fmaxf(a, S[0][3]), S[1][0]); a = fmaxf(fmaxf(a, S[1][1]), S[1][2]);
    float b = fmaxf(fmaxf(S[2][0], S[2][1]), S[2][2]); b = fmaxf(fmaxf(b, S[2][3]), S[3][0]); b = fmaxf(fmaxf(b, S[3][1]), S[3][2]);
    return fmaxf(fmaxf(a, S[1][3]), fmaxf(b, S[3][3]));
}
#define ONES8 ((bf16x8){(bf16_t)0x3F80, (bf16_t)0x3F80, (bf16_t)0x3F80, (bf16_t)0x3F80, (bf16_t)0x3F80, (bf16_t)0x3F80, (bf16_t)0x3F80, (bf16_t)0x3F80})
__device__ __forceinline__ void best_pair(float& bv, int& bj, float ov, int oj) { const bool take = (ov > bv) | ((ov == bv) & (oj < bj)); bv = take ? ov : bv; bj = take ? oj : bj; }
__device__ __forceinline__ void best_x16(float& bv, int& bj) { const float ov = __shfl_xor(bv, 16); const int oj = __shfl_xor(bj, 16); best_pair(bv, bj, ov, oj); }
__device__ __forceinline__ void best_x32(float& bv, int& bj) { const float ov = __shfl_xor(bv, 32); const int oj = __shfl_xor(bj, 32); best_pair(bv, bj, ov, oj); }
struct Stage { u32x4 k, v; };
__device__ __forceinline__ void stage_load(Stage& s, const unsigned char* kg, size_t kstride, const unsigned char* vg, size_t vstride, int tid, bool hasv) {
    const int row = tid >> 3, ch = tid & 7;
    s.k = *(const u32x4*)(kg + (size_t)row * kstride + ch * 16);
    if (hasv) s.v = *(const u32x4*)(vg + (size_t)row * vstride + ch * 16);
}
__device__ __forceinline__ void stage_store(const Stage& s, LAS unsigned char* lds, int buf, int tid, bool hasv) {
    const int row = tid >> 3, ch = tid & 7, off = row * 128 + ((ch ^ (row & 7)) << 4);
    *(LAS u32x4*)(lds + NSA_KB + buf * 8192 + off) = s.k;
    if (hasv) *(LAS u32x4*)(lds + NSA_VB + buf * 8192 + off) = s.v;
}
__device__ __forceinline__ bf16x8 lds_frag(const LAS unsigned char* base, int row, int ch) { return *(const LAS bf16x8*)(base + row * 128 + ((ch ^ (row & 7)) << 4)); }

__device__ __forceinline__ void select_blocks(const LAS float* impw, int tl, int r, int q, int cur, unsigned (&w)[4]) {
    w[0] = w[1] = w[2] = w[3] = 0u;
    if (cur < 16) { w[0] = (2u << cur) - 1u; return; }
    const int s16 = r * 4 + q;
    float cand[8];
#pragma unroll
    for (int k = 0; k < 8; ++k) { const int j = s16 + 16 * k; cand[k] = (j >= 1 && j <= cur - 2) ? impw[tl * 264 + j] + impw[tl * 264 + 132 + j] : -1.0f; }
    unsigned chosen = 0u;
    for (int it = 0; it < 13; ++it) {
        float bv = -2.0f; int bj = 1 << 20;
#pragma unroll
        for (int k = 0; k < 8; ++k) { const bool ok = !((chosen >> k) & 1u) && cand[k] > bv; bv = ok ? cand[k] : bv; bj = ok ? s16 + 16 * k : bj; }
        best_pair(bv, bj, dpp_x1(bv), dpp_x1i(bj)); best_pair(bv, bj, dpp_x2(bv), dpp_x2i(bj)); best_x16(bv, bj); best_x32(bv, bj);
        if ((bj & 15) == s16) chosen |= 1u << (bj >> 4);
    }
#pragma unroll
    for (int k = 0; k < 8; ++k) { const unsigned bit = ((chosen >> k) & 1u) << (s16 + 16 * (k & 1)); w[k >> 1] |= bit; }
#pragma unroll
    for (int x = 0; x < 4; ++x) { unsigned v = w[x]; v |= (unsigned)dpp_x1i((int)v); v |= (unsigned)dpp_x2i((int)v); v = or_x16(v); v = or_x32(v); w[x] = v; }
    w[0] |= 1u;
#pragma unroll
    for (int x = 0; x < 4; ++x) { if (((cur - 1) >> 5) == x) w[x] |= 1u << ((cur - 1) & 31); if ((cur >> 5) == x) w[x] |= 1u << (cur & 31); }
}

__device__ __forceinline__ float dpp_r4(float x) { return __builtin_bit_cast(float, __builtin_amdgcn_update_dpp(0, __builtin_bit_cast(int, x), 0x124, 0xF, 0xF, true)); }
__device__ __forceinline__ float dpp_r8(float x) { return __builtin_bit_cast(float, __builtin_amdgcn_update_dpp(0, __builtin_bit_cast(int, x), 0x128, 0xF, 0xF, true)); }
__device__ __forceinline__ int dpp_r4i(int x) { return __builtin_amdgcn_update_dpp(0, x, 0x124, 0xF, 0xF, true); }
__device__ __forceinline__ int dpp_r8i(int x) { return __builtin_amdgcn_update_dpp(0, x, 0x128, 0xF, 0xF, true); }
__device__ __forceinline__ void select_blocks8(const LAS float* impw, LAS unsigned* mk, int lane, int cur, unsigned (&u)[2][4]) {
    const int i = lane & 15, k = lane >> 4;
    unsigned m4[2][4];
    if (cur < 16) {
#pragma unroll
        for (int c = 0; c < 2; ++c) { m4[c][0] = (2u << cur) - 1u; m4[c][1] = 0u; m4[c][2] = 0u; m4[c][3] = 0u; }
    } else {
        float cand[2][8]; unsigned chosen[2] = {0u, 0u};
#pragma unroll
        for (int c = 0; c < 2; ++c)
#pragma unroll
            for (int m = 0; m < 8; ++m) { const int j = i + 16 * m; const LAS float* p = impw + (4 * c + k) * 264; const float va = p[j], vb2 = p[132 + j];
                cand[c][m] = ((j >= 1) & (j <= cur - 2)) ? va + vb2 : -1.0f; }
        for (int it = 0; it < 13; ++it) {
#pragma unroll
            for (int c = 0; c < 2; ++c) {
                float bv = -2.0f; int bj = 1 << 20;
#pragma unroll
                for (int m = 0; m < 8; ++m) { const bool ok = !((chosen[c] >> m) & 1u) && cand[c][m] > bv; bv = ok ? cand[c][m] : bv; bj = ok ? i + 16 * m : bj; }
                best_pair(bv, bj, dpp_r8(bv), dpp_r8i(bj)); best_pair(bv, bj, dpp_r4(bv), dpp_r4i(bj)); best_pair(bv, bj, dpp_x2(bv), dpp_x2i(bj)); best_pair(bv, bj, dpp_x1(bv), dpp_x1i(bj));
                if ((bj & 15) == i) chosen[c] |= 1u << (bj >> 4);
            }
        }
        const int c1 = cur - 1;
        const unsigned long long flo = 1ull | (c1 < 64 ? 1ull << c1 : 0ull) | (cur < 64 ? 1ull << cur : 0ull), fhi = (c1 >= 64 ? 1ull << (c1 - 64) : 0ull) | (cur >= 64 ? 1ull << (cur - 64) : 0ull);
#pragma unroll
        for (int c = 0; c < 2; ++c) {
#pragma unroll
            for (int x = 0; x < 4; ++x) m4[c][x] = 0u;
#pragma unroll
            for (int m = 0; m < 8; ++m) m4[c][m >> 1] |= ((chosen[c] >> m) & 1u) << (i + 16 * (m & 1));
#pragma unroll
            for (int x = 0; x < 4; ++x) { unsigned v = m4[c][x]; v |= (unsigned)dpp_r8i((int)v); v |= (unsigned)dpp_r4i((int)v); v |= (unsigned)dpp_x2i((int)v); v |= (unsigned)dpp_x1i((int)v); m4[c][x] = v; }
            m4[c][0] |= (unsigned)flo; m4[c][1] |= (unsigned)(flo >> 32); m4[c][2] |= (unsigned)fhi; m4[c][3] |= (unsigned)(fhi >> 32);
        }
    }
#pragma unroll
    for (int c = 0; c < 2; ++c) {
        if (i == 0) *(LAS u32x4*)(mk + (4 * c + k) * 4) = (u32x4){m4[c][0], m4[c][1], m4[c][2], m4[c][3]};
#pragma unroll
        for (int x = 0; x < 4; ++x) { unsigned v = m4[c][x]; v = or_x16(v); v = or_x32(v); u[c][x] = __builtin_amdgcn_readfirstlane(v); }
    }
}

template <int MODE, bool SELMASK>
__device__ __forceinline__ void attn_block(const LAS unsigned char* kb, const LAS unsigned char* vb, const bf16x8 (&qf)[2][2], int col, int q, const int (&tq)[2], int key0, const LAS float* nbq, float bias_far,
                                           bool sel0, bool sel1, Softmax (&st)[2], f32x4 (&O)[2][4]) {
    const f32x4 z4 = (f32x4){0.f, 0.f, 0.f, 0.f};
    const float NEG = -__builtin_inff();
    f32x4 S[2][4];
#pragma unroll
    for (int kt = 0; kt < 4; ++kt) { const bf16x8 k0 = lds_frag(kb, 16 * kt + col, q), k1 = lds_frag(kb, 16 * kt + col, 4 + q);
#pragma unroll
        for (int c = 0; c < 2; ++c) { S[c][kt] = __builtin_amdgcn_mfma_f32_16x16x32_bf16(k0, qf[c][0], z4, 0, 0, 0); S[c][kt] = __builtin_amdgcn_mfma_f32_16x16x32_bf16(k1, qf[c][1], S[c][kt], 0, 0, 0); } }
    float rowb[2] = {bias_far, bias_far}, cm[2];
#pragma unroll
    for (int c = 0; c < 2; ++c) {
        const bool sel = c == 0 ? sel0 : sel1;
        if (MODE == 0) { if (SELMASK) rowb[c] = sel ? bias_far : NEG; }
        else if (MODE == 1) { rowb[c] = (SELMASK && !sel) ? NEG : 0.f;
            const LAS float* bp = nbq - (tq[c] - key0);
#pragma unroll
            for (int kt = 0; kt < 4; ++kt) S[c][kt] = S[c][kt] + *(const LAS f32x4*)(bp + 16 * kt); }
        else {
#pragma unroll
            for (int kt = 0; kt < 4; ++kt)
#pragma unroll
                for (int e = 0; e < 4; ++e) { const int d = tq[c] - (key0 + 16 * kt + 4 * q + e); S[c][kt][e] = d < 512 ? S[c][kt][e] : NEG; } }
        cm[c] = max16(S[c]) + rowb[c];
    }
    if (__any(cm[0] > st[0].m || cm[1] > st[1].m)) {
#pragma unroll
        for (int c = 0; c < 2; ++c) { float x = fmax_x16(cm[c]); x = fmax_x32(x);
            const float mn = fmaxf(st[c].m, x), alpha = ex2(st[c].m - mn);
            st[c].m = mn; st[c].l = st[c].l * alpha;
#pragma unroll
            for (int dt = 0; dt < 4; ++dt) O[c][dt] = O[c][dt] * alpha; }
    }
    bf16x8 pf[2][2];
#pragma unroll
    for (int c = 0; c < 2; ++c) {
        const float off = rowb[c] - st[c].m;
#pragma unroll
        for (int kt = 0; kt < 4; ++kt) { f32x4 p = S[c][kt] + off;
#pragma unroll
            for (int e = 0; e < 4; ++e) p[e] = ex2(p[e]);
            S[c][kt] = p; }
        pf[c][0] = pack8(S[c][0], S[c][1]); pf[c][1] = pack8(S[c][2], S[c][3]);
        st[c].l = __builtin_amdgcn_mfma_f32_16x16x32_bf16(ONES8, pf[c][0], st[c].l, 0, 0, 0); st[c].l = __builtin_amdgcn_mfma_f32_16x16x32_bf16(ONES8, pf[c][1], st[c].l, 0, 0, 0);
    }
#pragma unroll
    for (int c32 = 0; c32 < 2; ++c32)
#pragma unroll
        for (int dt = 0; dt < 4; ++dt) { const bf16x8 vf = lds_frag(vb, 16 * dt + col, 4 * c32 + q);
            O[0][dt] = __builtin_amdgcn_mfma_f32_16x16x32_bf16(vf, pf[0][c32], O[0][dt], 0, 0, 0);
            O[1][dt] = __builtin_amdgcn_mfma_f32_16x16x32_bf16(vf, pf[1][c32], O[1][dt], 0, 0, 0); }
}

template <int C>
__device__ __forceinline__ void attn_block_far1(const LAS unsigned char* kb, const LAS unsigned char* vb, const bf16x8 (&qf)[2][2], int col, int q, float bias_far, bool sel, Softmax (&st)[2], f32x4 (&O)[2][4]) {
    const f32x4 z4 = (f32x4){0.f, 0.f, 0.f, 0.f};
    const float NEG = -__builtin_inff();
    f32x4 S[4];
#pragma unroll
    for (int kt = 0; kt < 4; ++kt) { const bf16x8 k0 = lds_frag(kb, 16 * kt + col, q), k1 = lds_frag(kb, 16 * kt + col, 4 + q);
        S[kt] = __builtin_amdgcn_mfma_f32_16x16x32_bf16(k0, qf[C][0], z4, 0, 0, 0); S[kt] = __builtin_amdgcn_mfma_f32_16x16x32_bf16(k1, qf[C][1], S[kt], 0, 0, 0); }
    const float rowb = sel ? bias_far : NEG;
    float cm = max16(S) + rowb;
    if (__any(cm > st[C].m)) { float x = fmax_x16(cm); x = fmax_x32(x);
        const float mn = fmaxf(st[C].m, x), alpha = ex2(st[C].m - mn);
        st[C].m = mn; st[C].l = st[C].l * alpha;
#pragma unroll
        for (int dt = 0; dt < 4; ++dt) O[C][dt] = O[C][dt] * alpha; }
    const float off = rowb - st[C].m;
#pragma unroll
    for (int kt = 0; kt < 4; ++kt) { f32x4 p = S[kt] + off;
#pragma unroll
        for (int e = 0; e < 4; ++e) p[e] = ex2(p[e]);
        S[kt] = p; }
    const bf16x8 pf0 = pack8(S[0], S[1]), pf1 = pack8(S[2], S[3]);
    st[C].l = __builtin_amdgcn_mfma_f32_16x16x32_bf16(ONES8, pf0, st[C].l, 0, 0, 0); st[C].l = __builtin_amdgcn_mfma_f32_16x16x32_bf16(ONES8, pf1, st[C].l, 0, 0, 0);
#pragma unroll
    for (int dt = 0; dt < 4; ++dt) { const bf16x8 vf0 = lds_frag(vb, 16 * dt + col, q), vf1 = lds_frag(vb, 16 * dt + col, 4 + q);
        O[C][dt] = __builtin_amdgcn_mfma_f32_16x16x32_bf16(vf0, pf0, O[C][dt], 0, 0, 0); O[C][dt] = __builtin_amdgcn_mfma_f32_16x16x32_bf16(vf1, pf1, O[C][dt], 0, 0, 0); }
}

template <bool SELMASK>
__device__ __forceinline__ void attn_far_fast(const LAS unsigned char* kb, const LAS unsigned char* vb, const bf16x8 (&qf)[2][2], int col, int q, float bias_far, bool sel0, bool sel1, Softmax (&st)[2], f32x4 (&O)[2][4]) {
    const f32x4 z4 = (f32x4){0.f, 0.f, 0.f, 0.f};
    const float NEG = -__builtin_inff();
    f32x4 S[2][4];
#pragma unroll
    for (int kt = 0; kt < 4; ++kt) { const bf16x8 k0 = lds_frag(kb, 16 * kt + col, q), k1 = lds_frag(kb, 16 * kt + col, 4 + q);
#pragma unroll
        for (int c = 0; c < 2; ++c) { S[c][kt] = __builtin_amdgcn_mfma_f32_16x16x32_bf16(k0, qf[c][0], z4, 0, 0, 0); S[c][kt] = __builtin_amdgcn_mfma_f32_16x16x32_bf16(k1, qf[c][1], S[c][kt], 0, 0, 0); } }
    bf16x8 pf[2][2];
#pragma unroll
    for (int c = 0; c < 2; ++c) {
        const bool sel = c == 0 ? sel0 : sel1;
        const float off = ((SELMASK && !sel) ? NEG : bias_far) - st[c].m;
#pragma unroll
        for (int kt = 0; kt < 4; ++kt) { f32x4 p = S[c][kt] + off;
#pragma unroll
            for (int e = 0; e < 4; ++e) p[e] = ex2(p[e]);
            S[c][kt] = p; }
        pf[c][0] = pack8(S[c][0], S[c][1]); pf[c][1] = pack8(S[c][2], S[c][3]);
        st[c].l = __builtin_amdgcn_mfma_f32_16x16x32_bf16(ONES8, pf[c][0], st[c].l, 0, 0, 0); st[c].l = __builtin_amdgcn_mfma_f32_16x16x32_bf16(ONES8, pf[c][1], st[c].l, 0, 0, 0);
    }
#pragma unroll
    for (int c32 = 0; c32 < 2; ++c32)
#pragma unroll
        for (int dt = 0; dt < 4; ++dt) { const bf16x8 vf = lds_frag(vb, 16 * dt + col, 4 * c32 + q);
            O[0][dt] = __builtin_amdgcn_mfma_f32_16x16x32_bf16(vf, pf[0][c32], O[0][dt], 0, 0, 0);
            O[1][dt] = __builtin_amdgcn_mfma_f32_16x16x32_bf16(vf, pf[1][c32], O[1][dt], 0, 0, 0); }
}
template <int C>
__device__ __forceinline__ void attn_far1_fast(const LAS unsigned char* kb, const LAS unsigned char* vb, const bf16x8 (&qf)[2][2], int col, int q, float bias_far, bool sel, Softmax (&st)[2], f32x4 (&O)[2][4]) {
    const f32x4 z4 = (f32x4){0.f, 0.f, 0.f, 0.f};
    const float NEG = -__builtin_inff();
    f32x4 S[4];
#pragma unroll
    for (int kt = 0; kt < 4; ++kt) { const bf16x8 k0 = lds_frag(kb, 16 * kt + col, q), k1 = lds_frag(kb, 16 * kt + col, 4 + q);
        S[kt] = __builtin_amdgcn_mfma_f32_16x16x32_bf16(k0, qf[C][0], z4, 0, 0, 0); S[kt] = __builtin_amdgcn_mfma_f32_16x16x32_bf16(k1, qf[C][1], S[kt], 0, 0, 0); }
    const float off = (sel ? bias_far : NEG) - st[C].m;
#pragma unroll
    for (int kt = 0; kt < 4; ++kt) { f32x4 p = S[kt] + off;
#pragma unroll
        for (int e = 0; e < 4; ++e) p[e] = ex2(p[e]);
        S[kt] = p; }
    const bf16x8 pf0 = pack8(S[0], S[1]), pf1 = pack8(S[2], S[3]);
    st[C].l = __builtin_amdgcn_mfma_f32_16x16x32_bf16(ONES8, pf0, st[C].l, 0, 0, 0); st[C].l = __builtin_amdgcn_mfma_f32_16x16x32_bf16(ONES8, pf1, st[C].l, 0, 0, 0);
#pragma unroll
    for (int dt = 0; dt < 4; ++dt) { const bf16x8 vf0 = lds_frag(vb, 16 * dt + col, q), vf1 = lds_frag(vb, 16 * dt + col, 4 + q);
        O[C][dt] = __builtin_amdgcn_mfma_f32_16x16x32_bf16(vf0, pf0, O[C][dt], 0, 0, 0); O[C][dt] = __builtin_amdgcn_mfma_f32_16x16x32_bf16(vf1, pf1, O[C][dt], 0, 0, 0); }
}
__device__ __forceinline__ bool attn_overflowed(const Softmax (&st)[2], const f32x4 (&O)[2][4]) {
    float a = 0.f;
#pragma unroll
    for (int c = 0; c < 2; ++c) { a += fabsf(st[c].l[0]);
#pragma unroll
        for (int dt = 0; dt < 4; ++dt) a += (fabsf(O[c][dt][0]) + fabsf(O[c][dt][1])) + (fabsf(O[c][dt][2]) + fabsf(O[c][dt][3])); }
    return !(a < 1e37f);
}

__device__ __forceinline__ void nsa_unit(unsigned char* ws, LAS unsigned char* lds, const LAS float* lut, int b, int g, int tau, int tid_in) {
    int tid = tid_in; asm volatile("" : "+v"(tid));
    const int lane = tid & 63, wave = __builtin_amdgcn_readfirstlane(tid >> 6);
    const int col = lane & 15, q = lane >> 4, tl = col >> 2, r = col & 3, h = g * 4 + r, t0 = 64 * tau, cur = tau;
    const f32x4 z4 = (f32x4){0.f, 0.f, 0.f, 0.f};
    const float NEG = -__builtin_inff();
    int tq[2]; bf16x8 qf[2][2];
#pragma unroll
    for (int c = 0; c < 2; ++c) { tq[c] = t0 + 8 * wave + 4 * c + tl; const size_t qrow = (size_t)b * SEQ + tq[c];
        const bf16_t* Qp = (const bf16_t*)(ws + WS_Q) + qrow * 1024 + h * 64 + 8 * q; qf[c][0] = *(const bf16x8*)Qp; qf[c][1] = *(const bf16x8*)(Qp + 32); }
#define NSA_GATE(c, k) (((const float*)(ws + WS_GATES))[((size_t)b * SEQ + tq[c]) * 48 + h * 3 + (k)])
    const LAS float* lrow = lut + h * 132;
    const float bias_far = lrow[128];
    const int dl = (4 - tl) & 3;
    const LAS float* nbq = (const LAS float*)(lds + NB_OFF) + (r * 4 + dl) * 264 + 196 - dl + 4 * q;
    LAS f32x4* resw = (LAS f32x4*)(lds + NSA_RES + wave * 8192) + lane;
    f32x4 Oc[2][4];
#pragma unroll
    for (int c = 0; c < 2; ++c)
#pragma unroll
        for (int dt = 0; dt < 4; ++dt) Oc[c][dt] = z4;
    LAS float* impw = (LAS float*)(lds + NSA_IMP) + wave * 2112;
    volatile LAS unsigned* ovf = (volatile LAS unsigned*)(lds + MISC_OFF) + 20;
    if (tid == 0) { ovf[0] = 0u; ovf[1] = 0u; }
    Stage stg;
    const int nvmax = (t0 + 63 >= 31) ? ((t0 + 63 - 31) >> 4) + 1 : 0;
    const int ncb = (nvmax + 63) >> 6;
    int nv[2];
#pragma unroll
    for (int c = 0; c < 2; ++c) nv[c] = tq[c] >= 31 ? ((tq[c] - 31) >> 4) + 1 : 0;
    const unsigned char* kcg = ws + WS_KC + ((size_t)(b * 512) * 4 + g) * 128;
    const unsigned char* vcg = ws + WS_VCT + ((size_t)((b * 4 + g) * 64)) * NCMP_PAD * 2;
    float M[2] = {-1e30f, -1e30f}, L[2] = {0.f, 0.f};
    if (ncb > 0) {
        const int nfar = (t0 - 159 >= 0) ? (((t0 - 159) >> 4) + 1) >> 6 : 0;
        stage_load(stg, kcg, 512, nullptr, 0, tid, false); stage_store(stg, lds, 0, tid, false); __syncthreads();
        for (int i = 0; i < ncb; ++i) {
            if (i + 1 < ncb) stage_load(stg, kcg + (size_t)(i + 1) * 64 * 512, 512, nullptr, 0, tid, false);
            else stage_load(stg, kcg, 512, vcg, NCMP_PAD * 2, tid, true);
            const LAS unsigned char* kb = lds + NSA_KB + (i & 1) * 8192;
            f32x4 S[2][4];
#pragma unroll
            for (int kt = 0; kt < 4; ++kt) { const bf16x8 kf0 = lds_frag(kb, 16 * kt + col, q), kf1 = lds_frag(kb, 16 * kt + col, 4 + q);
#pragma unroll
                for (int c = 0; c < 2; ++c) { S[c][kt] = __builtin_amdgcn_mfma_f32_16x16x32_bf16(kf0, qf[c][0], z4, 0, 0, 0); S[c][kt] = __builtin_amdgcn_mfma_f32_16x16x32_bf16(kf1, qf[c][1], S[c][kt], 0, 0, 0); } }
#pragma unroll
            for (int c = 0; c < 2; ++c) {
                float rowb = bias_far;
                if (i >= nfar) { rowb = 0.f;
                    const int tqlo = t0 + 8 * wave + 4 * c, tqhi = tqlo + 3;
#pragma unroll
                    for (int kt = 0; kt < 4; ++kt) { const int nlo = 64 * i + 16 * kt;
                        if (16 * (nlo + 15) + 31 + 128 <= tqlo) S[c][kt] = S[c][kt] + bias_far;
                        else if (16 * nlo + 31 > tqhi) S[c][kt] = (f32x4){NEG, NEG, NEG, NEG};
                        else {
#pragma unroll
                            for (int e = 0; e < 4; ++e) { const int n = nlo + 4 * q + e; int dist = tq[c] - (16 * n + 31); dist = dist < 0 ? 0 : (dist > 128 ? 128 : dist);
                                const float bv = lrow[dist]; const float sv = S[c][kt][e] + bv; S[c][kt][e] = n < nv[c] ? sv : NEG; } } } }
                const float tm = fmaxf(fmaxf(fmaxf(fmaxf(S[c][0][0], S[c][0][1]), fmaxf(S[c][0][2], S[c][0][3])), fmaxf(fmaxf(S[c][1][0], S[c][1][1]), fmaxf(S[c][1][2], S[c][1][3]))),
                                       fmaxf(fmaxf(fmaxf(S[c][2][0], S[c][2][1]), fmaxf(S[c][2][2], S[c][2][3])), fmaxf(fmaxf(S[c][3][0], S[c][3][1]), fmaxf(S[c][3][2], S[c][3][3])))) + rowb;
                const float mn = fmaxf(M[c], tm); L[c] *= ex2(M[c] - mn); M[c] = mn;
                const float off = rowb - mn; float sum = 0.f;
#pragma unroll
                for (int kt = 0; kt < 4; ++kt)
#pragma unroll
                    for (int e = 0; e < 4; ++e) sum += ex2(S[c][kt][e] + off);
                L[c] += sum;
            }
            if (i + 1 < ncb) stage_store(stg, lds, (i + 1) & 1, tid, false);
            __syncthreads();
        }
#pragma unroll
        for (int c = 0; c < 2; ++c) { float mo = fmax_x16(M[c]); mo = fmax_x32(mo); L[c] *= ex2(M[c] - mo); M[c] = mo; L[c] = fadd_x16(L[c]); L[c] = fadd_x32(L[c]); }
        float offN[2];
#pragma unroll
        for (int c = 0; c < 2; ++c) offN[c] = -M[c] - __builtin_amdgcn_logf(fmaxf(L[c], 1e-30f));
        f32x4 (&O)[2][4] = Oc;
        stage_store(stg, lds, 0, tid, true); __syncthreads();
        for (int i = 0; i < ncb; ++i) {
            if (i + 1 < ncb) stage_load(stg, kcg + (size_t)(i + 1) * 64 * 512, 512, vcg + (size_t)(i + 1) * 128, NCMP_PAD * 2, tid, true);
            const LAS unsigned char* kb = lds + NSA_KB + (i & 1) * 8192; const LAS unsigned char* vb = lds + NSA_VB + (i & 1) * 8192;
            f32x4 S[2][4];
#pragma unroll
            for (int kt = 0; kt < 4; ++kt) { const bf16x8 kf0 = lds_frag(kb, 16 * kt + col, q), kf1 = lds_frag(kb, 16 * kt + col, 4 + q);
#pragma unroll
                for (int c = 0; c < 2; ++c) { S[c][kt] = __builtin_amdgcn_mfma_f32_16x16x32_bf16(kf0, qf[c][0], z4, 0, 0, 0); S[c][kt] = __builtin_amdgcn_mfma_f32_16x16x32_bf16(kf1, qf[c][1], S[c][kt], 0, 0, 0); } }
#pragma unroll
            for (int c = 0; c < 2; ++c) {
                if (i >= nfar) {
                    const int tqlo = t0 + 8 * wave + 4 * c, tqhi = tqlo + 3; const float offF = bias_far + offN[c];
#pragma unroll
                    for (int kt = 0; kt < 4; ++kt) { const int nlo = 64 * i + 16 * kt;
                        if (16 * (nlo + 15) + 31 + 128 <= tqlo) {
#pragma unroll
                            for (int e = 0; e < 4; ++e) S[c][kt][e] = ex2(S[c][kt][e] + offF); }
                        else if (16 * nlo + 31 > tqhi) S[c][kt] = (f32x4){0.f, 0.f, 0.f, 0.f};
                        else {
#pragma unroll
                            for (int e = 0; e < 4; ++e) { const int n = nlo + 4 * q + e; int dist = tq[c] - (16 * n + 31); dist = dist < 0 ? 0 : (dist > 128 ? 128 : dist);
                                const float bv = lrow[dist]; const float pv = ex2(S[c][kt][e] + bv + offN[c]); S[c][kt][e] = n < nv[c] ? pv : 0.f; } } }
                } else { const float off = bias_far + offN[c];
#pragma unroll
                    for (int kt = 0; kt < 4; ++kt)
#pragma unroll
                        for (int e = 0; e < 4; ++e) S[c][kt][e] = ex2(S[c][kt][e] + off); }
#pragma unroll
                for (int kt = 0; kt < 4; ++kt) { float sA = (S[c][kt][0] + S[c][kt][1]) + (S[c][kt][2] + S[c][kt][3]), c3 = S[c][kt][3];
                    sA += dpp_x1(sA); sA += dpp_x2(sA); c3 += dpp_x1(c3); c3 += dpp_x2(c3);
                    if (r == 0) { const int jb = 4 * (4 * i + kt) + q; impw[(4 * c + tl) * 264 + jb] = sA; impw[(4 * c + tl) * 264 + 132 + jb + 1] = c3; } }
            }
            const bf16x8 pf00 = pack8(S[0][0], S[0][1]), pf01 = pack8(S[0][2], S[0][3]), pf10 = pack8(S[1][0], S[1][1]), pf11 = pack8(S[1][2], S[1][3]);
#pragma unroll
            for (int dt = 0; dt < 4; ++dt) { const bf16x8 vf0 = lds_frag(vb, 16 * dt + col, q), vf1 = lds_frag(vb, 16 * dt + col, 4 + q);
                O[0][dt] = __builtin_amdgcn_mfma_f32_16x16x32_bf16(vf0, pf00, O[0][dt], 0, 0, 0); O[1][dt] = __builtin_amdgcn_mfma_f32_16x16x32_bf16(vf0, pf10, O[1][dt], 0, 0, 0);
                O[0][dt] = __builtin_amdgcn_mfma_f32_16x16x32_bf16(vf1, pf01, O[0][dt], 0, 0, 0); O[1][dt] = __builtin_amdgcn_mfma_f32_16x16x32_bf16(vf1, pf11, O[1][dt], 0, 0, 0); }
            if (i + 1 < ncb) stage_store(stg, lds, (i + 1) & 1, tid, true);
            __syncthreads();
        }
    }
    unsigned u[2][4];
    Stage stg2;
    const unsigned char* kg_s = ws + WS_KS + ((size_t)b * SEQ * 256 + g * 64) * 2;
    const unsigned char* vg_s = ws + WS_VST + ((size_t)((b * 4 + g) * 64)) * SEQ * 2;
    stage_load(stg, kg_s, 512, vg_s, SEQ * 2, tid, true);
    if (1 <= cur) stage_load(stg2, kg_s + (size_t)64 * 512, 512, vg_s + 128, SEQ * 2, tid, true);
    asm volatile("s_waitcnt lgkmcnt(0)" ::: "memory");
    LAS unsigned* selw = (LAS unsigned*)(lds + TILES_OFF) + wave * 32;
    select_blocks8(impw, selw, lane, cur, u);
    __syncthreads();
#pragma unroll
    for (int c = 0; c < 2; ++c) { const float gc = NSA_GATE(c, 0);
#pragma unroll
        for (int dt = 0; dt < 4; ++dt) resw[(c * 4 + dt) * 64] = Oc[c][dt] * gc; }
    {
        f32x4 O[2][4]; Softmax st[2];
#pragma unroll
        for (int c = 0; c < 2; ++c) { st[c].m = -1e30f; st[c].l = z4;
#pragma unroll
            for (int dt = 0; dt < 4; ++dt) O[c][dt] = z4; }
        const unsigned char* kg = kg_s; const unsigned char* vg = vg_s;
        const unsigned char* kgw = ws + WS_KW + ((size_t)b * SEQ * 256 + g * 64) * 2;
        const unsigned char* vgw = ws + WS_VWT + ((size_t)((b * 4 + g) * 64)) * SEQ * 2;
        const int jlo_w = cur >= 8 ? cur - 8 : 0;
#define SLC_LOAD(ST, J) stage_load(ST, kg + (size_t)(J) * 64 * 512, 512, vg + (size_t)(J) * 128, SEQ * 2, tid, true)
#define SLC_STEP(SAFE, J, BUF) do { const int j_ = (J); \
            const unsigned uw0 = (j_ >> 5) == 0 ? u[0][0] : (j_ >> 5) == 1 ? u[0][1] : (j_ >> 5) == 2 ? u[0][2] : u[0][3]; \
            const unsigned uw1 = (j_ >> 5) == 0 ? u[1][0] : (j_ >> 5) == 1 ? u[1][1] : (j_ >> 5) == 2 ? u[1][2] : u[1][3]; \
            if (((uw0 | uw1) >> (j_ & 31)) & 1u) { \
                const bool sel0 = (cw0 >> (j_ & 31)) & 1u, sel1 = (cw1 >> (j_ & 31)) & 1u; \
                const LAS unsigned char* kb = lds + NSA_KB + (BUF) * 8192; const LAS unsigned char* vb = lds + NSA_VB + (BUF) * 8192; \
                if (j_ + 3 > cur) attn_block<1, true>(kb, vb, qf, col, q, tq, 64 * j_, nbq, bias_far, sel0, sel1, st, O); \
                else { const bool d0_ = (uw0 >> (j_ & 31)) & 1u, d1_ = (uw1 >> (j_ & 31)) & 1u; \
                    if (SAFE) { \
                        if (d0_ && d1_) attn_block<0, true>(kb, vb, qf, col, q, tq, 64 * j_, nbq, bias_far, sel0, sel1, st, O); \
                        else if (d0_) attn_block_far1<0>(kb, vb, qf, col, q, bias_far, sel0, st, O); \
                        else attn_block_far1<1>(kb, vb, qf, col, q, bias_far, sel1, st, O); \
                    } else if (j_ == 0) attn_block<0, true>(kb, vb, qf, col, q, tq, 0, nbq, bias_far, sel0, sel1, st, O); \
                    else if (d0_ && d1_) attn_far_fast<true>(kb, vb, qf, col, q, bias_far, sel0, sel1, st, O); \
                    else if (d0_) attn_far1_fast<0>(kb, vb, qf, col, q, bias_far, sel0, st, O); \
                    else attn_far1_fast<1>(kb, vb, qf, col, q, bias_far, sel1, st, O); } } } while (0)
#define SLC_LOOP(SAFE) do { \
        if (SAFE) { SLC_LOAD(stg, 0); if (1 <= cur) SLC_LOAD(stg2, 1); } \
        stage_store(stg, lds, 0, tid, true); if (1 <= cur) stage_store(stg2, lds, 1, tid, true); __syncthreads(); \
        unsigned cw0 = 0u, cw1 = 0u; \
        for (int j = 0; j <= cur; j += 2) { \
            if ((j & 31) == 0) { cw0 = selw[tl * 4 + (j >> 5)]; cw1 = selw[16 + tl * 4 + (j >> 5)]; } \
            if (j + 2 <= cur) SLC_LOAD(stg, j + 2); \
            else stage_load(stg, kgw + (size_t)jlo_w * 64 * 512, 512, vgw + (size_t)jlo_w * 128, SEQ * 2, tid, true);     \
            if (j + 3 <= cur) SLC_LOAD(stg2, j + 3); \
            SLC_STEP(SAFE, j, j & 3); \
            if (j + 1 <= cur) SLC_STEP(SAFE, j + 1, (j + 1) & 3); \
            if (j + 2 <= cur) stage_store(stg, lds, (j + 2) & 3, tid, true); \
            if (j + 3 <= cur) stage_store(stg2, lds, (j + 3) & 3, tid, true); \
            __syncthreads(); \
        } } while (0)
        SLC_LOOP(false);
        if (__any(attn_overflowed(st, O))) ovf[0] = 1u;
        __syncthreads();
        if (ovf[0] != 0u) {
#pragma unroll
            for (int c = 0; c < 2; ++c) { st[c].m = -1e30f; st[c].l = z4;
#pragma unroll
                for (int dt = 0; dt < 4; ++dt) O[c][dt] = z4; }
            SLC_LOOP(true);
        }
#undef SLC_LOOP
#undef SLC_LOAD
#undef SLC_STEP
#pragma unroll
        for (int c = 0; c < 2; ++c) { const float sc = NSA_GATE(c, 1) / fmaxf(st[c].l[0], 1e-30f);
#pragma unroll
            for (int dt = 0; dt < 4; ++dt) resw[(c * 4 + dt) * 64] = resw[(c * 4 + dt) * 64] + O[c][dt] * sc; }
    }
    {
        f32x4 O[2][4]; Softmax st[2];
#pragma unroll
        for (int c = 0; c < 2; ++c) { st[c].m = -1e30f; st[c].l = z4;
#pragma unroll
            for (int dt = 0; dt < 4; ++dt) O[c][dt] = z4; }
        const unsigned char* kg = ws + WS_KW + ((size_t)b * SEQ * 256 + g * 64) * 2;
        const unsigned char* vg = ws + WS_VWT + ((size_t)((b * 4 + g) * 64)) * SEQ * 2;
        const int jlo = cur >= 8 ? cur - 8 : 0;
#define WIN_LOOP(SAFE) do { \
        if (SAFE) stage_load(stg, kg + (size_t)jlo * 64 * 512, 512, vg + (size_t)jlo * 128, SEQ * 2, tid, true); \
        stage_store(stg, lds, 0, tid, true); __syncthreads(); \
        for (int j = jlo; j <= cur; ++j) { \
            const int bi = (j - jlo) & 1; \
            if (j + 1 <= cur) stage_load(stg, kg + (size_t)(j + 1) * 64 * 512, 512, vg + (size_t)(j + 1) * 128, SEQ * 2, tid, true); \
            const LAS unsigned char* kb = lds + NSA_KB + bi * 8192; const LAS unsigned char* vb = lds + NSA_VB + bi * 8192; \
            if (j + 3 > cur) attn_block<1, false>(kb, vb, qf, col, q, tq, 64 * j, nbq, bias_far, true, true, st, O); \
            else if (j + 8 == cur) attn_block<2, false>(kb, vb, qf, col, q, tq, 64 * j, nbq, bias_far, true, true, st, O); \
            else if ((SAFE) || j < jlo + 2) attn_block<0, false>(kb, vb, qf, col, q, tq, 64 * j, nbq, bias_far, true, true, st, O); \
            else attn_far_fast<false>(kb, vb, qf, col, q, bias_far, true, true, st, O); \
            if (j + 1 <= cur) stage_store(stg, lds, bi ^ 1, tid, true); \
            __syncthreads(); \
        } } while (0)
        WIN_LOOP(false);
        if (__any(attn_overflowed(st, O))) ovf[1] = 1u;
        __syncthreads();
        if (ovf[1] != 0u) {
#pragma unroll
            for (int c = 0; c < 2; ++c) { st[c].m = -1e30f; st[c].l = z4;
#pragma unroll
                for (int dt = 0; dt < 4; ++dt) O[c][dt] = z4; }
            WIN_LOOP(true);
        }
#undef WIN_LOOP
#pragma unroll
        for (int c = 0; c < 2; ++c) { const float sc = NSA_GATE(c, 2) / fmaxf(st[c].l[0], 1e-30f);
            bf16_t* yo = (bf16_t*)(ws + WS_YNSA) + ((size_t)b * SEQ + tq[c]) * 1024 + h * 64 + 4 * q;
#pragma unroll
            for (int dt = 0; dt < 4; ++dt) { const f32x4 rv = resw[(c * 4 + dt) * 64] + O[c][dt] * sc; u32x2 o; o.x = pk2(rv[0], rv[1]); o.y = pk2(rv[2], rv[3]); *(u32x2*)(yo + 16 * dt) = o; } }
    }
}

__device__ __forceinline__ float dpp_ror4(float x) { return __builtin_bit_cast(float, __builtin_amdgcn_update_dpp(0, __builtin_bit_cast(int, x), 0x124, 0xF, 0xF, true)); }
__device__ __forceinline__ float dpp_ror8(float x) { return __builtin_bit_cast(float, __builtin_amdgcn_update_dpp(0, __builtin_bit_cast(int, x), 0x128, 0xF, 0xF, true)); }
__device__ __forceinline__ int dpp_ror4i(int x) { return __builtin_amdgcn_update_dpp(0, x, 0x124, 0xF, 0xF, true); }
__device__ __forceinline__ int dpp_ror8i(int x) { return __builtin_amdgcn_update_dpp(0, x, 0x128, 0xF, 0xF, true); }
__device__ __forceinline__ void route_token(const In& in, unsigned char* ws, LAS unsigned* hist, LAS unsigned* eloc, LAS unsigned* sloc, int tok, int tloc, int lane) {
    const f32x4 lg = *((const f32x4*)((const float*)(ws + WS_LOGIT) + (size_t)tok * 256) + lane);
    const f32x4 rb = *((const f32x4*)in.router_bias + lane);
    float s[4], v[4];
#pragma unroll
    for (int i = 0; i < 4; ++i) { s[i] = sigmoidf_(lg[i]); v[i] = s[i] + rb[i]; }
    unsigned taken = 0u; float my_s = 0.f; int my_e = 0;
    for (int k = 0; k < TOPK; ++k) {
        float bv = -__builtin_inff(); int bi = 1 << 20;
#pragma unroll
        for (int i = 0; i < 4; ++i) { const bool ok = !((taken >> i) & 1u) && v[i] > bv; bv = ok ? v[i] : bv; bi = ok ? 4 * lane + i : bi; }
        best_pair(bv, bi, dpp_ror8(bv), dpp_ror8i(bi)); best_pair(bv, bi, dpp_ror4(bv), dpp_ror4i(bi)); best_pair(bv, bi, dpp_x2(bv), dpp_x2i(bi)); best_pair(bv, bi, dpp_x1(bv), dpp_x1i(bi));
        { const float ov = __shfl_xor(bv, 16); const int oi = __shfl_xor(bi, 16); best_pair(bv, bi, ov, oi); }
        { const float ov = __shfl_xor(bv, 32); const int oi = __shfl_xor(bi, 32); best_pair(bv, bi, ov, oi); }
        const bool mine = (bi >> 2) == lane;
        if (mine) taken |= 1u << (bi & 3);
        const float sw = (bi & 3) == 0 ? s[0] : (bi & 3) == 1 ? s[1] : (bi & 3) == 2 ? s[2] : s[3];
        const float bs = __shfl(sw, bi >> 2);
        if (lane == k) { my_s = bs; my_e = bi; }
    }
    float sum = lane < TOPK ? my_s : 0.f;
    sum += dpp_x1(sum); sum += dpp_x2(sum); sum += dpp_ror4(sum); sum += dpp_ror8(sum);
    if (lane < TOPK) {
        const unsigned slot = __hip_atomic_fetch_add(hist + my_e, 1u, __ATOMIC_RELAXED, __HIP_MEMORY_SCOPE_WORKGROUP);
        eloc[tloc * 8 + lane] = (unsigned)my_e; sloc[tloc * 8 + lane] = slot;
        ((int*)(ws + WS_ASGE))[tok * 8 + lane] = my_e; ((float*)(ws + WS_ASGW))[tok * 8 + lane] = my_s / sum * 2.5f;
    }
}

#ifndef DBG_MODE
#define DBG_MODE 0
#endif
struct Args { In in; float* out; unsigned char* ws; int ph_lo, ph_hi; };
static_assert(sizeof(Args) == 31 * 8 + 8 + 8 + 8, "Args has no padding");

#define CAS __attribute__((address_space(4)))
struct PhaseArgs { In in; float* out; unsigned char* ws; };
__device__ __forceinline__ PhaseArgs load_args() {
    const CAS unsigned char* kp = (const CAS unsigned char*)__builtin_amdgcn_kernarg_segment_ptr(); asm volatile("" : "+s"(kp));
    const float* const CAS* pp = (const float* const CAS*)kp; PhaseArgs r; const float** rp = (const float**)&r.in;
#pragma unroll
    for (int i = 0; i < 31; ++i) rp[i] = pp[i];
    r.out = (float*)pp[31]; r.ws = (unsigned char*)pp[32]; return r;
}
#define PHASE_ARGS() const PhaseArgs pa_ = load_args(); const In& in = pa_.in; float* const out = pa_.out; unsigned char* const ws = pa_.ws; (void)in; (void)out; (void)ws
__global__ void __launch_bounds__(NTHREADS, 2) fwd_kernel(Args args) {
    extern __shared__ __attribute__((aligned(16))) unsigned char lds_raw[];
    LAS unsigned char* lds = (LAS unsigned char*)lds_raw;
    volatile LAS unsigned* MISC = (volatile LAS unsigned*)(lds + MISC_OFF);
    const int tid = threadIdx.x, lane = tid & 63, wave = __builtin_amdgcn_readfirstlane(tid >> 6);
    const int G = gridDim.x, gw = (int)blockIdx.x * NWAVES + wave, NGW = G * NWAVES;
    unsigned* ctl = (unsigned*)(args.ws + WS_CTL);
    for (int u = tid; u < 256; u += NTHREADS) ((LAS unsigned*)(lds + MISC_OFF))[u] = 0u;
    __syncthreads();
    XcdBarrier bar = xcd_barrier_post(ctl + CW_BAR, MISC + 8);
    const int lo = args.ph_lo, hi = args.ph_hi;
#define IN(k) (lo <= (k) && (k) < hi)
#define SEAM(k) do { if (IN(k) && IN((k) + 1)) xcd_barrier(bar); } while (0)
    LAS float* lut = (LAS float*)(lds + LUT_OFF);
    LAS int* tstart = (LAS int*)(lds + TILES_OFF);

    if (IN(0)) {
        PHASE_ARGS();
        p0_mod(in, ws, lds, tid);
        p0_tables(in, ws, lds, tid);
        if (blockIdx.x >= 64) p0_small_weights(in, ws, (LAS float*)(lds + wave * 8448), gw - 64 * NWAVES, NGW - 64 * NWAVES, lane);
    }
    SEAM(0);
    if (IN(1)) { PHASE_ARGS();
        if (blockIdx.x == 0) {
            const float* part = (const float*)(ws + WS_CTL + 131072);
            const int ts = tid >> 8, c = tid & 255; float sb = 0.f;
            for (int pz = 0; pz < 16; ++pz) sb += part[(ts * 16 + pz) * 256 + c];
            ((float*)(ws + WS_CTL + 65536))[ts * 256 + c] = sb; }
        ph_h1(in, ws, gw, NGW, lane); }
    SEAM(1);
    if (IN(2)) {
        PHASE_ARGS();
        SchedDense S = make_dense((const char*)ws, WS_H1, 2048, (const char*)(ws + WS_WIN), MTOK, NPROJ, 1024);
        EpiProj E{ws};
        pg8::gemm_phase<EpiProj, SchedDense>(lds, S, E);
    }
    SEAM(2);
    if (IN(3)) {
        PHASE_ARGS();
        { SchedCmp1 S; S.abase = (const char*)ws; S.a_kstep = 512; S.K = 2048; S.Bt = (const char*)(ws + WS_CW1); S.ord.init(64, 2, G, (int)blockIdx.x);
          EpiCmp1 E{ws}; pg8::gemm_phase<EpiCmp1, SchedCmp1>(lds, S, E); }
        __syncthreads();
        s5_task<false>(in, ws, lds + wave * S5_LDS_PER_WAVE, gw >> 8, (gw >> 3) & 31, gw & 7, lane);
    }
    SEAM(3);
    if (IN(4)) {
        PHASE_ARGS();
        { SchedCmp2 S; S.abase = (const char*)ws; S.a_kstep = 128; S.K = 256; S.Bt = (const char*)(ws + WS_CW2); S.ord.init(64, 2, G, (int)blockIdx.x);
          EpiCmp2 E{ws}; pg8::gemm_phase<EpiCmp2, SchedCmp2>(lds, S, E); }
        __syncthreads();
        s5_task<true>(in, ws, lds + wave * S5_LDS_PER_WAVE, gw >> 8, (gw >> 3) & 31, gw & 7, lane);
    }
    SEAM(4);
    if (IN(5)) {
        PHASE_ARGS();
        for (int i = tid; i < 16 * 132; i += NTHREADS) lut[i] = ((const float*)(ws + WS_TAB + TAB_LUT))[i];
        __syncthreads();
        if ((tid >> 6) >= 4) __builtin_amdgcn_s_setprio(2);
        for (int i = 0; i < 16; ++i) { const int bg = 8 * (i >> 2) + ((int)blockIdx.x & 7), wi = (int)blockIdx.x >> 3, k = i & 3;
            const int tau = k == 0 ? wi : k == 1 ? 63 - wi : k == 2 ? 64 + wi : 127 - wi;
            if (k == 0) {
                __syncthreads();
                LAS float* nbt = (LAS float*)(lds + NB_OFF);
                for (int x = tid; x < 16 * 264; x += NTHREADS) { const int rr = x / 1056, sh = (x / 264) & 3, z = x % 264, d = 196 - z - sh;
                    nbt[x] = d < 0 ? -__builtin_inff() : lut[((bg & 3) * 4 + rr) * 132 + (d > 128 ? 128 : d)]; }
                __syncthreads();
            }
            nsa_unit(ws, lds, lut, bg >> 2, bg & 3, tau, tid); }
        __builtin_amdgcn_s_setprio(0);
    }
    SEAM(5);
    if (IN(6)) {
        PHASE_ARGS();
        SchedDense S = make_dense((const char*)ws, WS_Z, 1024, (const char*)(ws + WS_GLU), MTOK, 2048, 512);
        EpiGlu E{ws}; pg8::gemm_phase<EpiGlu, SchedDense>(lds, S, E);
    }
    SEAM(6);
    if (IN(7)) {
        PHASE_ARGS();
        SchedDense S = make_dense((const char*)ws, WS_MERGED, 2048, (const char*)(ws + WS_WOUT), MTOK, 1024, 1024);
        EpiWout E{in.x, out, (const float*)(ws + WS_MOD) + 2048};
        static_assert(WS_WD >= WS_KS && WS_WD + 128 * MiB <= WS_MG + 256 * MiB && WS_WGU + 63 * MiB <= WS_Q && WS_WGU + 191 * MiB >= WS_Q + 128 * MiB, "early conversion targets must not overlap MERGED (live in this phase)");
        if (blockIdx.x & 1) { convert_expert_weights(in, ws, (LAS float*)(lds + wave * 8448), gw, NGW, lane, 0); __syncthreads(); }
        pg8::gemm_phase<EpiWout, SchedDense>(lds, S, E);
        if (!(blockIdx.x & 1)) { __syncthreads(); convert_expert_weights(in, ws, (LAS float*)(lds + wave * 8448), gw, NGW, lane, 0); }
    }
    SEAM(7);
    if (IN(8)) {
        PHASE_ARGS();
        ph_ln1(in, ws, out, gw, NGW, lane);
        for (int i = gw * 64 + lane; i < 128; i += NGW * 64) ((u32x4*)((bf16_t*)(ws + WS_H2) + (size_t)MTOK * DM))[i] = (u32x4){0u, 0u, 0u, 0u};
        for (int i = gw * 64 + lane; i < NCHUNK * CHUNK_ROWS; i += NGW * 64) { ((int*)(ws + WS_ROWASG))[i] = -1; ((float*)(ws + WS_ROWW))[i] = 0.f; }
        convert_expert_weights(in, ws, (LAS float*)(lds + wave * 8448), gw, NGW, lane, 1);
    }
    SEAM(8);
    if (IN(9)) {
        PHASE_ARGS();
        { SchedDense S = make_dense((const char*)ws, WS_H2, 2048, (const char*)(ws + WS_ROUT), MTOK, 256, 1024);
          EpiF32 E{(float*)(ws + WS_LOGIT), 256}; pg8::gemm_phase<EpiF32, SchedDense>(lds, S, E); }
        { SchedDense S = make_dense((const char*)ws, WS_H2, 2048, (const char*)(ws + WS_SHGU), MTOK, 512, 1024);
          EpiSwiglu E{(bf16_t*)(ws + WS_HSH)}; pg8::gemm_phase<EpiSwiglu, SchedDense>(lds, S, E); }
    }
    SEAM(9);
    if (IN(10)) {
        PHASE_ARGS();
        {
            LAS unsigned* hist = (LAS unsigned*)lds; LAS unsigned* gbase = hist + 256; LAS unsigned* eloc = hist + 512; LAS unsigned* sloc = hist + 2560;
            const int tok0 = (int)blockIdx.x * 256;
            if (tid < 256) hist[tid] = 0u;
            __syncthreads();
            for (int k = 0; k < 32; ++k) route_token(in, ws, hist, eloc, sloc, tok0 + wave * 32 + k, wave * 32 + k, lane);
            __syncthreads();
            if (tid < 256) { const unsigned h = hist[tid]; gbase[tid] = h ? __hip_atomic_fetch_add(ctl + CW_CNT + chunk_of_tok(tok0) * 256 + tid, h, RLX_AGENT) : 0u; }
            __syncthreads();
            for (int i = tid; i < 2048; i += NTHREADS) ((int*)(ws + WS_ASGS))[tok0 * 8 + i] = (int)(sloc[i] + gbase[eloc[i]]);
            __syncthreads();
        }
        SchedDense S = make_dense((const char*)ws, WS_HSH, 512, (const char*)(ws + WS_SHD), MTOK, 1024, 256);
        EpiShDown E{(unsigned char*)(ws + WS_SHOUT)}; pg8::gemm_phase<EpiShDown, SchedDense>(lds, S, E);
    }
    SEAM(10);
    if (IN(11) || IN(12)) {
        for (int i = tid; i < NCHUNK * 256; i += NTHREADS) { const unsigned c = __hip_atomic_load(ctl + CW_CNT + i, RLX_AGENT); tstart[(i >> 8) * 260 + (i & 255) + 1] = (int)((c + 255u) >> 8); }
        if (tid < NCHUNK) tstart[tid * 260] = 0;
        __syncthreads();
        if (tid < NCHUNK) { int sacc = 0; for (int e = 1; e <= 256; ++e) { sacc += tstart[tid * 260 + e]; tstart[tid * 260 + e] = sacc; } }
        __syncthreads();
    }
    if (IN(11)) {
        PHASE_ARGS();
        for (int a = gw * 64 + lane; a < MTOK * TOPK; a += NGW * 64) { const int e = ((const int*)(ws + WS_ASGE))[a], ch = chunk_of_tok(a >> 3); const int pos = ch * CHUNK_ROWS + 256 * tstart[ch * 260 + e] + ((const int*)(ws + WS_ASGS))[a];
            ((int*)(ws + WS_ROWASG))[pos] = a; ((float*)(ws + WS_ROWW))[pos] = ((const float*)(ws + WS_ASGW))[a]; }
    }
    SEAM(11);
    if (IN(12)) {
        PHASE_ARGS();
        for (int ch = 0; ch < NCHUNK; ++ch) {
            { SchedMoeGU S; S.abase = (const char*)ws; S.a_kstep = 128; S.K = 1024; S.tstart = tstart + ch * 260; S.rowasg = (const int*)(ws + WS_ROWASG) + ch * CHUNK_ROWS; S.W = (const char*)(ws + WS_WGU); S.G = G; S.c = (int)blockIdx.x;
              EpiSwiglu E{(bf16_t*)(ws + WS_HID)}; pg8::gemm_phase<EpiSwiglu, SchedMoeGU>(lds, S, E); }
            if (ch > 0) final_chunk(in, ws, out, ctl + CW_FCTR + 64 * (ch - 1), ch - 1, MISC + 16, tid, wave, lane);
            xcd_barrier(bar);
            { SchedMoeD S; S.abase = (const char*)ws; S.a_kstep = 128; S.K = 256; S.tstart = tstart + ch * 260; S.W = (const char*)(ws + WS_WD); S.G = G; S.c = (int)blockIdx.x;
              EpiMoeDown E{(unsigned char*)(ws + WS_OUTS), (const int*)(ws + WS_ROWASG) + ch * CHUNK_ROWS, (const float*)(ws + WS_ROWW) + ch * CHUNK_ROWS, ch * CHUNK_ASG}; pg8::gemm_phase<EpiMoeDown, SchedMoeD>(lds, S, E); }
            xcd_barrier(bar);
        }
        final_chunk(in, ws, out, ctl + CW_FCTR + 64 * (NCHUNK - 1), NCHUNK - 1, MISC + 16, tid, wave, lane);
    }
#undef IN
#undef SEAM
}

extern "C" void kernel_launch(void* const* d_in, const int* in_sizes, int n_in, void* d_out, int out_size, void* d_ws, size_t ws_size, hipStream_t stream) {
    static int grid = 0;
    if (grid == 0) {
        if (n_in != 31 || out_size != MTOK * DM || ws_size < WS_END) { fprintf(stderr, "kernel_launch: unexpected shapes: n_in %d out %d ws %zu (need %zu)\n", n_in, out_size, ws_size, (size_t)WS_END); grid = -1; return; }
        int dev = 0, cus = 0, per_cu = 0;
        if (hipGetDevice(&dev) != hipSuccess || hipDeviceGetAttribute(&cus, hipDeviceAttributeMultiprocessorCount, dev) != hipSuccess) { grid = -1; return; }
        if (hipFuncSetAttribute((const void*)fwd_kernel, hipFuncAttributeMaxDynamicSharedMemorySize, LDS_BYTES) != hipSuccess) { fprintf(stderr, "kernel_launch: hipFuncSetAttribute failed\n"); grid = -1; return; }
        if (hipOccupancyMaxActiveBlocksPerMultiprocessor(&per_cu, (const void*)fwd_kernel, NTHREADS, LDS_BYTES) != hipSuccess || per_cu < 1) { fprintf(stderr, "kernel_launch: occupancy query says %d\n", per_cu); }
        (void)hipGetLastError();
        grid = cus;
    }
    if (grid < 0) return;
    if (hipMemsetAsync((char*)d_ws + WS_CTL, 0, CTL_ZERO_BYTES, stream) != hipSuccess) return;
    Args a{};
    const float** ip = (const float**)&a.in;
    for (int i = 0; i < 31; ++i) ip[i] = (const float*)d_in[i];
    a.out = (float*)d_out; a.ws = (unsigned char*)d_ws; a.ph_lo = 0; a.ph_hi = 13;
    hipLaunchKernelGGL(fwd_kernel, dim3(grid), dim3(NTHREADS), LDS_BYTES, stream, a);
}
```

```cpp
#include <hip/hip_runtime.h>
#include <cstdio>
#include <cstdint>

#define LAS __attribute__((address_space(3)))
#define GAS __attribute__((address_space(1)))
typedef unsigned short bf16_t;
typedef short bf16x8 __attribute__((ext_vector_type(8)));
typedef short bf16x4 __attribute__((ext_vector_type(4)));
typedef float f32x4 __attribute__((ext_vector_type(4)));
typedef float f32x2 __attribute__((ext_vector_type(2)));
typedef unsigned u32x4 __attribute__((ext_vector_type(4)));
typedef unsigned u32x2 __attribute__((ext_vector_type(2)));

constexpr int DM = 1024, NB = 8, SEQ = 8192, MTOK = NB * SEQ;
constexpr int SSM_W = 512, SSM_G = 32, SSM_P = 64;
constexpr int NH = 16, HD = 64, NKV = 4, KVW = 256;
constexpr int NCMP = 511, NCMP_PAD = 512;
constexpr int NEXP = 256, TOPK = 8, DEXP = 256;
constexpr int NPROJ = 5376;
constexpr float DN_ALPHA = 1.189207115002721f;
constexpr float LN_EPS = 1e-5f;
constexpr int NWAVES = 8, NTHREADS = 512;

constexpr size_t MiB = 1u << 20;
constexpr size_t WS_CTL = 0, CTL_ZERO_BYTES = 1 * MiB;
constexpr size_t WS_MOD = 1 * MiB;
constexpr size_t WS_TAB = 1 * MiB + 512 * 1024;
constexpr size_t WS_WIN = 2 * MiB;
constexpr size_t WS_GLU = 13 * MiB;
constexpr size_t WS_WOUT = 15 * MiB;
constexpr size_t WS_ROUT = 17 * MiB;
constexpr size_t WS_SHGU = 17 * MiB + 512 * 1024;
constexpr size_t WS_SHD = 18 * MiB + 512 * 1024;
constexpr size_t WS_CW1 = 19 * MiB;
constexpr size_t WS_CW2 = 21 * MiB;
constexpr size_t WS_S5T = 21 * MiB + 512 * 1024;
constexpr size_t WS_BASE = 24 * MiB;
constexpr size_t WS_H1 = WS_BASE;
constexpr size_t WS_YNSA = WS_H1;
constexpr size_t WS_U = WS_H1 + 128 * MiB;
constexpr size_t WS_Q = WS_U + 64 * MiB;
constexpr size_t WS_MERGED = WS_Q;
constexpr size_t WS_KCR = WS_Q + 128 * MiB;
constexpr size_t WS_VCR = WS_KCR + 32 * MiB;
constexpr size_t WS_KS = WS_VCR + 32 * MiB;
constexpr size_t WS_VST = WS_KS + 32 * MiB;
constexpr size_t WS_KW = WS_VST + 32 * MiB;
constexpr size_t WS_VWT = WS_KW + 32 * MiB;
constexpr size_t WS_MG = WS_VWT + 32 * MiB;
constexpr size_t WS_GATES = WS_MG + 256 * MiB;
constexpr size_t WS_Z = WS_GATES + 12 * MiB;
constexpr size_t WS_CMPH = WS_Z + 64 * MiB;
constexpr size_t WS_KC = WS_CMPH + 16 * MiB;
constexpr size_t WS_VCT = WS_KC + 2 * MiB;
constexpr size_t WS_S5ST = WS_VCT + 2 * MiB;
constexpr size_t WS_MIX_END = WS_S5ST + 1 * MiB;
constexpr int NCHUNK = 2, CHUNK_TOK = 32768, CHUNK_ASG = CHUNK_TOK * 8, CHUNK_ROWS = 327680, CHUNK_TILES = CHUNK_ROWS / 256;
constexpr float OUTS_SCALE = 64.0f;
__host__ __device__ __forceinline__ int chunk_of_tok(int tok) { return tok >> 15; }
__host__ __device__ __forceinline__ int chunk_ntok(int ch) { return CHUNK_TOK; }
constexpr size_t WS_H2 = WS_BASE;
constexpr size_t WS_WGU = WS_H2 + 129 * MiB;
constexpr size_t WS_WD = WS_WGU + 256 * MiB;
constexpr size_t WS_OUTS = WS_WD + 128 * MiB;
constexpr size_t WS_LOGIT = WS_OUTS;
constexpr size_t WS_HID = WS_OUTS + 256 * MiB;
constexpr size_t WS_HSH = WS_HID;
constexpr size_t WS_ASGE = WS_HID + 160 * MiB;
constexpr size_t WS_ASGS = WS_ASGE + 2 * MiB;
constexpr size_t WS_ASGW = WS_ASGS + 2 * MiB;
constexpr size_t WS_ROWASG = WS_ASGW + 2 * MiB;
constexpr size_t WS_ROWW = WS_ROWASG + 3 * MiB;
constexpr size_t WS_LNST = WS_ROWW + 3 * MiB;
constexpr size_t WS_SHOUT = WS_LNST + 1 * MiB;
constexpr size_t WS_END = WS_SHOUT + 64 * MiB;
static_assert(WS_MIX_END <= WS_END, "map");
constexpr int CW_BAR = 4096;
constexpr int CW_CNT = 8192;
constexpr int CW_FCTR = 9216;
constexpr size_t TAB_CMPB = 0;
constexpr size_t TAB_LUT = 4096;
constexpr size_t S5_AFR = 0;
constexpr size_t S5_CFR = 256 * 1024;
constexpr size_t S5_A = 384 * 1024;
constexpr size_t S5_A16 = S5_A + 16384;
constexpr size_t S5_AC = S5_A16 + 16384;

constexpr int RING_BYTES = 131072;
constexpr int MISC_OFF = 133120;
constexpr int LUT_OFF = MISC_OFF + 1024;
constexpr int TILES_OFF = LUT_OFF + 8448;
constexpr int NB_OFF = TILES_OFF + 4160;
constexpr int LDS_BYTES = 163840;
static_assert(NB_OFF % 16 == 0 && NB_OFF + 16 * 264 * 4 <= LDS_BYTES, "near-bias table");
static_assert(RING_BYTES <= MISC_OFF, "GEMM stage ring below the control words");
static_assert(TILES_OFF + 4 * 260 * 4 <= LDS_BYTES, "lds map");

#define RLX_AGENT __ATOMIC_RELAXED, __HIP_MEMORY_SCOPE_AGENT
#define LDS_WAIT() asm volatile("s_waitcnt lgkmcnt(0)" ::: "memory")
#define VM_WAIT() asm volatile("s_waitcnt vmcnt(0)" ::: "memory")
__device__ __forceinline__ unsigned f2bf(float f) { unsigned u = __builtin_bit_cast(unsigned, f); return (u + 0x7fffu + ((u >> 16) & 1u)) >> 16; }
typedef __bf16 nbf16x2 __attribute__((ext_vector_type(2)));
__device__ __forceinline__ unsigned pk2(float lo, float hi) { const f32x2 v = {lo, hi}; return __builtin_bit_cast(unsigned, __builtin_convertvector(v, nbf16x2)); }
__device__ __forceinline__ float bf2f(unsigned short b) { return __builtin_bit_cast(float, ((unsigned)b) << 16); }
__device__ __forceinline__ float bflo(unsigned w) { return __builtin_bit_cast(float, w << 16); }
__device__ __forceinline__ float bfhi(unsigned w) { return __builtin_bit_cast(float, w & 0xffff0000u); }
__device__ __forceinline__ float sigmoidf_(float x) { return 1.0f / (1.0f + __expf(-x)); }
__device__ __forceinline__ float siluf_(float x) { return x / (1.0f + __expf(-x)); }
__device__ __forceinline__ float gelu_tanh(float x) { const float u = 0.7978845608028654f * (x + 0.044715f * x * x * x); const float e = __expf(2.0f * u); return x * (1.0f - 1.0f / (e + 1.0f)); }
__device__ __forceinline__ float wave_sum(float v) {
#pragma unroll
    for (int o = 1; o < 64; o <<= 1) v += __shfl_xor(v, o);
    return v;
}

#define XB_TMO      128
#define XB_XCNT(j)  (256  + 64 * (j))
#define XB_XSUB(j)  (1280 + 64 * (j))
#define XB_XGEN(j)  (2304 + 64 * (j))
#define XB_TOP      3328
#define XB_TOPGEN   3392
#define XCD_BAR_WORDS 3456
#define XB_SPIN_CAP (1u << 18)
__device__ __forceinline__ unsigned xb_ld(unsigned* p)              { return __hip_atomic_load(p, __ATOMIC_RELAXED, __HIP_MEMORY_SCOPE_AGENT); }
__device__ __forceinline__ unsigned xb_add(unsigned* p, unsigned v) { return __hip_atomic_fetch_add(p, v, __ATOMIC_RELAXED, __HIP_MEMORY_SCOPE_AGENT); }
__device__ __forceinline__ unsigned xb_xcc_id() { return (unsigned)__builtin_amdgcn_s_getreg((3 << 11) | 20) & 0xFu; }
#define XB_SPIN(cond, bar) do { unsigned _sp = 0; while (cond) { __builtin_amdgcn_s_sleep(1); \
    if ((++_sp & 255u) == 0u) { if (xb_ld(&(bar)[XB_TMO])) break; if (_sp > XB_SPIN_CAP) { atomicAdd(&(bar)[XB_TMO], 1u); break; } } } } while (0)
struct XcdBarrier { unsigned* bar; unsigned x; volatile LAS unsigned* st; };
__device__ __forceinline__ XcdBarrier xcd_barrier_post(unsigned* bar, volatile LAS unsigned* st) {
    XcdBarrier b; b.bar = bar; b.x = xb_xcc_id(); b.st = st;
    if (threadIdx.x == 0) (void)xb_add(&bar[XB_XCNT(b.x)], 1u);
    return b;
}
__device__ __forceinline__ void xcd_barrier_complete(unsigned* bar, unsigned x, unsigned& nloc, unsigned& nx) {
    const unsigned G = gridDim.x * gridDim.y * gridDim.z;
    unsigned sum, cnt, mine, sp = 0u;
    for (;;) {
        sum = 0u; cnt = 0u; mine = 0u;
#pragma unroll
        for (unsigned j = 0; j < 16; ++j) { const unsigned c = xb_ld(&bar[XB_XCNT(j)]); sum += c; cnt += (c > 0u) ? 1u : 0u; mine = (j == x) ? c : mine; }
        if (sum == G) break;
        __builtin_amdgcn_s_sleep(1);
        if ((++sp & 255u) == 0u) { if (xb_ld(&bar[XB_TMO])) break; if (sp > XB_SPIN_CAP) { atomicAdd(&bar[XB_TMO], 1u); break; } }
    }
    nloc = mine > 0u ? mine : 1u; nx = cnt > 0u ? cnt : 1u;
}
__device__ __forceinline__ void xcd_barrier(const XcdBarrier& b) {
    asm volatile("s_waitcnt vmcnt(0)" ::: "memory");
    __syncthreads();
    if (threadIdx.x == 0) {
        unsigned* bar = b.bar;
        __builtin_amdgcn_s_waitcnt(0);
        unsigned nloc = b.st[0], nx = b.st[1];
        if (nloc == 0u) { xcd_barrier_complete(bar, b.x, nloc, nx); b.st[0] = nloc; b.st[1] = nx; }
        const unsigned old = xb_add(&bar[XB_XSUB(b.x)], 1u);
        const unsigned gen = old / nloc;
        if (old + 1u == (gen + 1u) * nloc) {
            __builtin_amdgcn_fence(__ATOMIC_RELEASE, "agent");
            asm volatile("s_waitcnt vmcnt(0)" ::: "memory");
            const unsigned og = xb_add(&bar[XB_TOP], 1u);
            const unsigned tg = og / nx;
            if (og + 1u == (tg + 1u) * nx) xb_add(&bar[XB_TOPGEN], 1u);
            else XB_SPIN(xb_ld(&bar[XB_TOPGEN]) == tg, bar);
            __builtin_amdgcn_fence(__ATOMIC_ACQUIRE, "agent");
            xb_add(&bar[XB_XGEN(b.x)], 1u);
            asm volatile("s_waitcnt vmcnt(0)" ::: "memory");
        } else {
            XB_SPIN(xb_ld(&bar[XB_XGEN(b.x)]) == gen, bar);
            __builtin_amdgcn_fence(__ATOMIC_ACQUIRE, "agent");
            asm volatile("s_waitcnt vmcnt(0)" ::: "memory");
        }
    }
    __syncthreads();
}

namespace pg8 {
constexpr int BM = 256, BK = 64, HALF = 128, HTB = HALF * BK * 2, STAGE_BYTES = 8 * HTB, NXCD = 8, WGM = 8;
__host__ __device__ __forceinline__ int lds_byte(int r, int c) { const int st = (r >> 4) * 2 + (c >> 5), rr = r & 15, cc = c & 31, ob = rr * 64 + cc * 2; return st * 1024 + (ob ^ (((ob >> 9) & 1) << 5)); }
__host__ __device__ __forceinline__ void stage_rc(int b, int& R, int& C) { const int st = b / 1024, sb = b % 1024, swz = sb ^ (((sb >> 9) & 1) << 5); R = (st >> 1) * 16 + swz / 64; C = (st & 1) * 32 + (swz % 64) / 2; }
__host__ __device__ __forceinline__ int perm32(int rho) { const int n = rho >> 4, i = rho & 15; return 8 * (i >> 2) + 4 * n + (i & 3); }
struct Unit { int pm, pn; };
struct DenseOrder {
    int nM, nN, nwg, G, c;
    __device__ void init(int nM_, int nN_, int G_, int c_) { nM = nM_; nN = nN_; nwg = nM * nN; G = G_; c = c_; }
    __device__ bool next(int i, Unit& u) const {
        const long L = (long)i * G + c; if (L >= nwg) return false;
        int wgid = (int)L; { const int q = nwg / NXCD, r = nwg % NXCD, xcd = wgid % NXCD, off = wgid / NXCD; wgid = (xcd < r ? xcd * (q + 1) : r * (q + 1) + (xcd - r) * q) + off; }
        const int nig = WGM * nN, gid = wgid / nig, fm = gid * WGM, gsz = (nM - fm) < WGM ? (nM - fm) : WGM;
        u.pm = fm + ((wgid % nig) % gsz); u.pn = (wgid % nig) / gsz; return true;
    }
};
template <class Epi, class Sched>
__device__ __forceinline__ void gemm_phase(LAS unsigned char* lds, const Sched& S, const Epi& E) {
    int tid_ = threadIdx.x; asm volatile("" : "+v"(tid_));
    const int tid = tid_, wid = __builtin_amdgcn_readfirstlane(tid >> 6), lane = tid & 63, wr = wid >> 2, wc = wid & 3, fr = lane & 15, fq = lane >> 4;
    const int K = S.K, nt = K / BK;
    int RA[2], CA[2]; unsigned voffB[2];
#pragma unroll
    for (int i = 0; i < 2; ++i) { int R, C; stage_rc(tid * 16 + i * 8192, R, C); const int Rb = Epi::PERM ? ((R & ~31) + perm32(R & 31)) : R;
        RA[i] = R; CA[i] = C * 2; voffB[i] = (unsigned)(Rb * K + C) * 2u; }
    const size_t kstep = (size_t)(BK * 2);
    const size_t hstep = (size_t)HALF * K * 2;
    const size_t ka = (size_t)S.a_kstep;
    const unsigned ldsw = (unsigned)wid * 1024u;
    const int aoff = lds_byte(wr * 64 + fr, fq * 8), boff = lds_byte(wc * 32 + fr, fq * 8);
#define PG8_SA(b, h) (((b) * 2 + (h)) * HTB)
#define PG8_SB(b, h) ((4 + (b) * 2 + (h)) * HTB)
#define PG8_STAGE(bufoff, gbase, v0, v1) do { \
        __builtin_amdgcn_global_load_lds((const unsigned*)((const char*)(gbase) + (v0)), (LAS unsigned*)(lds + (bufoff) + ldsw), 16, 0, 0); \
        __builtin_amdgcn_global_load_lds((const unsigned*)((const char*)(gbase) + (v1)), (LAS unsigned*)(lds + (bufoff) + ldsw + 8192), 16, 0, 0); } while (0)
#define PG8_LDA(dst, b, h) do { _Pragma("unroll") for (int m = 0; m < 4; ++m) _Pragma("unroll") for (int k = 0; k < 2; ++k) dst[m][k] = *(const LAS bf16x8*)(lds + PG8_SA(b, h) + aoff + m * 2048 + k * 1024); } while (0)
#define PG8_LDB(dst, b, h) do { _Pragma("unroll") for (int n = 0; n < 2; ++n) _Pragma("unroll") for (int k = 0; k < 2; ++k) dst[n][k] = *(const LAS bf16x8*)(lds + PG8_SB(b, h) + boff + n * 2048 + k * 1024); } while (0)
#define PG8_MMA(ai, bj, At, Bt) do { __builtin_amdgcn_s_setprio(1); _Pragma("unroll") for (int m = 0; m < 4; ++m) _Pragma("unroll") for (int n = 0; n < 2; ++n) _Pragma("unroll") for (int k = 0; k < 2; ++k) \
        acc[ai][bj][m][n] = __builtin_amdgcn_mfma_f32_16x16x32_bf16(Bt[n][k], At[m][k], acc[ai][bj][m][n], 0, 0, 0); __builtin_amdgcn_s_setprio(0); } while (0)
#define PG8_WAIT_V(n) asm volatile("s_waitcnt vmcnt(" #n ")" ::: "memory")
#define PG8_WAIT_L(n) asm volatile("s_waitcnt lgkmcnt(" #n ")" ::: "memory")
#define PG8_BAR __builtin_amdgcn_s_barrier()
#define PG8_SCHED __builtin_amdgcn_sched_barrier(0)
    Unit cur, nxt; int ui = 0;
    if (!S.next(0, cur)) return;
    f32x4 acc[2][2][4][2];
#pragma unroll
    for (int a = 0; a < 2; ++a)
#pragma unroll
        for (int b = 0; b < 2; ++b)
#pragma unroll
            for (int m = 0; m < 4; ++m)
#pragma unroll
                for (int n = 0; n < 2; ++n) acc[a][b][m][n] = (f32x4){0.f, 0.f, 0.f, 0.f};
    bf16x8 At[4][2], B0[2][2], B1[2][2];
    const char* const abase = S.abase;
    unsigned va00 = S.a_off(cur, RA[0]) + CA[0], va01 = S.a_off(cur, RA[1]) + CA[1], va10 = S.a_off(cur, RA[0] + HALF) + CA[0], va11 = S.a_off(cur, RA[1] + HALF) + CA[1];
    const char* cB = S.b_ptr(cur);
    PG8_STAGE(PG8_SB(0, 0), cB, voffB[0], voffB[1]); PG8_STAGE(PG8_SB(0, 1), cB + hstep, voffB[0], voffB[1]); PG8_STAGE(PG8_SA(0, 0), abase, va00, va01); PG8_STAGE(PG8_SA(0, 1), abase, va10, va11);
    if (wr == 1) PG8_BAR;
    PG8_WAIT_V(2); PG8_BAR;
    PG8_STAGE(PG8_SB(1, 0), cB + kstep, voffB[0], voffB[1]); PG8_STAGE(PG8_SA(1, 0), abase + ka, va00, va01); PG8_STAGE(PG8_SB(1, 1), cB + hstep + kstep, voffB[0], voffB[1]);
    PG8_WAIT_V(6); PG8_BAR;
    for (;;) {
        const bool has_next = S.next(ui + 1, nxt);
        unsigned na00 = va00, na01 = va01, na10 = va10, na11 = va11; const char* nB = cB;
        if (has_next) { na00 = S.a_off(nxt, RA[0]) + CA[0]; na01 = S.a_off(nxt, RA[1]) + CA[1]; na10 = S.a_off(nxt, RA[0] + HALF) + CA[0]; na11 = S.a_off(nxt, RA[1] + HALF) + CA[1]; nB = S.b_ptr(nxt); }
        for (int t = 0; t < nt; t += 2) {
            const bool last = (t == nt - 2);
            const char* a1 = abase + (size_t)(t + 1) * ka;
            const char* a2 = last ? abase : abase + (size_t)(t + 2) * ka; const char* b2 = last ? nB : cB + (size_t)(t + 2) * kstep;
            const char* a3 = a2 + ka; const char* b3 = b2 + kstep;
            const unsigned x00 = last ? na00 : va00, x01 = last ? na01 : va01, x10 = last ? na10 : va10, x11 = last ? na11 : va11;
            PG8_LDB(B0, 0, 0); PG8_LDB(B1, 0, 1); PG8_SCHED; PG8_LDA(At, 0, 0); PG8_STAGE(PG8_SA(1, 1), a1, va10, va11);
            PG8_WAIT_V(8); PG8_WAIT_L(0); PG8_BAR; PG8_MMA(0, 0, At, B0); PG8_MMA(0, 1, At, B1); PG8_BAR; PG8_SCHED;
            PG8_LDA(At, 0, 1); PG8_STAGE(PG8_SB(0, 0), b2, voffB[0], voffB[1]); PG8_STAGE(PG8_SB(0, 1), b2 + hstep, voffB[0], voffB[1]); PG8_STAGE(PG8_SA(0, 0), a2, x00, x01);
            PG8_WAIT_V(8); PG8_WAIT_L(0); PG8_BAR; PG8_MMA(1, 0, At, B0); PG8_MMA(1, 1, At, B1); PG8_BAR; PG8_SCHED;
            PG8_LDB(B0, 1, 0); PG8_LDB(B1, 1, 1); PG8_SCHED; PG8_LDA(At, 1, 0); PG8_STAGE(PG8_SA(0, 1), a2, x10, x11);
            PG8_WAIT_V(8); PG8_WAIT_L(0); PG8_BAR; PG8_MMA(0, 0, At, B0); PG8_MMA(0, 1, At, B1); PG8_BAR; PG8_SCHED;
            PG8_LDA(At, 1, 1); PG8_STAGE(PG8_SB(1, 0), b3, voffB[0], voffB[1]); PG8_STAGE(PG8_SB(1, 1), b3 + hstep, voffB[0], voffB[1]); PG8_STAGE(PG8_SA(1, 0), a3, x00, x01);
            PG8_WAIT_V(8); PG8_WAIT_L(0); PG8_BAR; PG8_MMA(1, 0, At, B0); PG8_MMA(1, 1, At, B1); PG8_BAR; PG8_SCHED;
        }
        if (wr == 0) PG8_BAR;
        E(acc, cur, wr, wc, fr, fq);
        if (!has_next) break;
#pragma unroll
        for (int a = 0; a < 2; ++a)
#pragma unroll
            for (int b = 0; b < 2; ++b)
#pragma unroll
                for (int m = 0; m < 4; ++m)
#pragma unroll
                    for (int n = 0; n < 2; ++n) acc[a][b][m][n] = (f32x4){0.f, 0.f, 0.f, 0.f};
        cur = nxt; cB = nB; va00 = na00; va01 = na01; va10 = na10; va11 = na11; ++ui;
        if (wr == 1) PG8_BAR;
    }
    PG8_WAIT_V(0);
    PG8_BAR;
#undef PG8_SA
#undef PG8_SB
#undef PG8_STAGE
#undef PG8_LDA
#undef PG8_LDB
#undef PG8_MMA
#undef PG8_WAIT_V
#undef PG8_WAIT_L
#undef PG8_BAR
#undef PG8_SCHED
}
}

__host__ __device__ __forceinline__ int vperm(int key) { const int x = key & 31; return (key & ~31) | (8 * ((x >> 2) & 3) + 4 * ((x >> 4) & 1) + (x & 3)); }
using pg8::Unit;
struct SchedDense {
    const char* abase; unsigned a_kstep; int K;
    unsigned a_base; unsigned lda; const char* Bt; pg8::DenseOrder ord;
    __device__ __forceinline__ bool next(int i, Unit& u) const { return ord.next(i, u); }
    __device__ __forceinline__ unsigned a_off(const Unit& u, int R) const { return a_base + (unsigned)(u.pm * 256 + R) * lda; }
    __device__ __forceinline__ const char* b_ptr(const Unit& u) const { return Bt + (size_t)u.pn * 256 * K * 2; }
};
__device__ __forceinline__ SchedDense make_dense(const char* ws, size_t a_off, int lda_bytes, const char* Bt, int M, int N, int K) {
    SchedDense S; S.abase = ws; S.a_kstep = 128; S.K = K; S.a_base = (unsigned)a_off; S.lda = (unsigned)lda_bytes; S.Bt = Bt; S.ord.init(M / 256, N / 256, (int)gridDim.x, (int)blockIdx.x); return S;
}
struct SchedCmp1 {
    const char* abase; unsigned a_kstep; int K; const char* Bt; pg8::DenseOrder ord;
    __device__ __forceinline__ bool next(int i, Unit& u) const { return ord.next(i, u); }
    __device__ __forceinline__ unsigned a_off(const Unit& u, int R) const {
        const int row = u.pm * 256 + R, g = row & 3, bn = row >> 2, b = bn >> 9; int n = bn & 511; n = n > 510 ? 510 : n;
        return (unsigned)(u.pn ? WS_VCR : WS_KCR) + (unsigned)(((b * SEQ + 16 * n) * KVW + g * HD) * 2);
    }
    __device__ __forceinline__ const char* b_ptr(const Unit& u) const { return Bt + (size_t)u.pn * 256 * 2048 * 2; }
};
struct SchedCmp2 {
    const char* abase; unsigned a_kstep; int K; const char* Bt; pg8::DenseOrder ord;
    __device__ __forceinline__ bool next(int i, Unit& u) const { return ord.next(i, u); }
    __device__ __forceinline__ unsigned a_off(const Unit& u, int R) const { return (unsigned)WS_CMPH + (unsigned)(((u.pn * 16384) + u.pm * 256 + R) * 512); }
    __device__ __forceinline__ const char* b_ptr(const Unit& u) const { return Bt + (size_t)u.pn * 256 * 256 * 2; }
};

struct EpiProj {
    static constexpr bool PERM = true;
    unsigned char* ws;
    __device__ __forceinline__ void operator()(const f32x4 (&acc)[2][2][4][2], const Unit& u, int wr, int wc, int fr, int fq) const {
        const int pn = u.pn;
#pragma unroll
        for (int ai = 0; ai < 2; ++ai)
#pragma unroll
            for (int m = 0; m < 4; ++m) {
                const int row = u.pm * 256 + 128 * ai + 64 * wr + 16 * m + fr;
#pragma unroll
                for (int bj = 0; bj < 2; ++bj) {
                    const int c8 = 128 * bj + 32 * wc + 8 * fq;
                    float v[8];
#pragma unroll
                    for (int j = 0; j < 4; ++j) { v[j] = acc[ai][bj][m][0][j]; v[4 + j] = acc[ai][bj][m][1][j]; }
                    if (pn < 12 && pn != 9 && pn != 11) {
                        bf16_t* dst; float sc = 1.0f;
                        if (pn < 2) dst = (bf16_t*)(ws + WS_U) + (size_t)row * 512 + pn * 256 + c8;
                        else if (pn < 6) { dst = (bf16_t*)(ws + WS_Q) + (size_t)row * 1024 + (pn - 2) * 256 + c8; sc = 0.125f * 1.4426950408889634f; }
                        else { const size_t off = pn == 6 ? WS_KCR : pn == 7 ? WS_VCR : pn == 8 ? WS_KS : WS_KW; dst = (bf16_t*)(ws + off) + (size_t)row * 256 + c8; }
                        u32x4 w; w.x = pk2(v[0] * sc, v[1] * sc); w.y = pk2(v[2] * sc, v[3] * sc); w.z = pk2(v[4] * sc, v[5] * sc); w.w = pk2(v[6] * sc, v[7] * sc);
                        *(u32x4*)dst = w;
                    } else if (pn == 9 || pn == 11) {
                        bf16_t* base = (bf16_t*)(ws + (pn == 9 ? WS_VST : WS_VWT));
                        const int b = row >> 13, t = row & (SEQ - 1);
#pragma unroll
                        for (int e = 0; e < 8; ++e) { const int c = c8 + e, g = c >> 6, d = c & 63; base[((size_t)((b * 4 + g) * 64 + d)) * SEQ + vperm(t)] = (bf16_t)f2bf(v[e]); }
                    } else if (pn < 20) {
                        bf16_t* dst = (bf16_t*)(ws + WS_MG) + (size_t)row * 2048 + (pn - 12) * 256 + c8;
                        u32x4 w; w.x = pk2(sigmoidf_(v[0]), sigmoidf_(v[1])); w.y = pk2(sigmoidf_(v[2]), sigmoidf_(v[3])); w.z = pk2(sigmoidf_(v[4]), sigmoidf_(v[5])); w.w = pk2(sigmoidf_(v[6]), sigmoidf_(v[7]));
                        *(u32x4*)dst = w;
                    } else {
                        if (c8 < 48) { float* dst = (float*)(ws + WS_GATES) + (size_t)row * 48 + c8;
                            *(f32x4*)dst = (f32x4){sigmoidf_(v[0]), sigmoidf_(v[1]), sigmoidf_(v[2]), sigmoidf_(v[3])}; *(f32x4*)(dst + 4) = (f32x4){sigmoidf_(v[4]), sigmoidf_(v[5]), sigmoidf_(v[6]), sigmoidf_(v[7])}; }
                    }
                }
            }
    }
};
struct EpiCmp1 {
    static constexpr bool PERM = true;
    unsigned char* ws;
    __device__ __forceinline__ void operator()(const f32x4 (&acc)[2][2][4][2], const Unit& u, int wr, int wc, int fr, int fq) const {
        const float* bias = (const float*)(ws + WS_CTL + 65536) + u.pn * 256;
#pragma unroll
        for (int bj = 0; bj < 2; ++bj) {
            const int c8 = 128 * bj + 32 * wc + 8 * fq;
            const f32x4 b0 = *(const f32x4*)(bias + c8), b1 = *(const f32x4*)(bias + c8 + 4);
#pragma unroll
            for (int ai = 0; ai < 2; ++ai)
#pragma unroll
                for (int m = 0; m < 4; ++m) {
                    const int row = u.pm * 256 + 128 * ai + 64 * wr + 16 * m + fr;
                    const f32x4 x0 = acc[ai][bj][m][0] + b0, x1 = acc[ai][bj][m][1] + b1;
                    u32x4 w; w.x = pk2(gelu_tanh(x0[0]), gelu_tanh(x0[1])); w.y = pk2(gelu_tanh(x0[2]), gelu_tanh(x0[3])); w.z = pk2(gelu_tanh(x1[0]), gelu_tanh(x1[1])); w.w = pk2(gelu_tanh(x1[2]), gelu_tanh(x1[3]));
                    *(u32x4*)((bf16_t*)(ws + WS_CMPH) + ((size_t)u.pn * 16384 + row) * 256 + c8) = w;
                }
        }
    }
};
struct EpiCmp2 {
    static constexpr bool PERM = false;
    unsigned char* ws;
    __device__ __forceinline__ void operator()(const f32x4 (&acc)[2][2][4][2], const Unit& u, int wr, int wc, int fr, int fq) const {
        if (wc >= 2) return;
#pragma unroll
        for (int ai = 0; ai < 2; ++ai)
#pragma unroll
            for (int m = 0; m < 4; ++m) {
                const int row = u.pm * 256 + 128 * ai + 64 * wr + 16 * m + fr;
#pragma unroll
                for (int n = 0; n < 2; ++n) {
                    const int c = 32 * wc + 16 * n + 4 * fq; const f32x4 x = acc[ai][0][m][n];
                    if (u.pn == 0) { u32x2 w; w.x = pk2(x[0], x[1]); w.y = pk2(x[2], x[3]); *(u32x2*)((bf16_t*)(ws + WS_KC) + (size_t)row * 64 + c) = w; }
                    else { const int g = row & 3, bn = row >> 2, b = bn >> 9, nn = bn & 511; bf16_t* base = (bf16_t*)(ws + WS_VCT) + ((size_t)((b * 4 + g) * 64 + c)) * NCMP_PAD + vperm(nn);
#pragma unroll
                        for (int j = 0; j < 4; ++j) base[(size_t)j * NCMP_PAD] = (bf16_t)f2bf(x[j]); }
                }
            }
    }
};
struct EpiGlu {
    static constexpr bool PERM = true;
    unsigned char* ws;
    __device__ __forceinline__ void operator()(const f32x4 (&acc)[2][2][4][2], const Unit& u, int wr, int wc, int fr, int fq) const {
        const int col = u.pn * 128 + 32 * wc + 8 * fq;
#pragma unroll
        for (int ai = 0; ai < 2; ++ai) {
            u32x4 g0[4], g1[4], yn[4];
#pragma unroll
            for (int m = 0; m < 4; ++m) { const int row = u.pm * 256 + 128 * ai + 64 * wr + 16 * m + fr;
                g0[m] = *(const u32x4*)((const bf16_t*)(ws + WS_MG) + (size_t)row * 2048 + col);
                g1[m] = *(const u32x4*)((const bf16_t*)(ws + WS_MG) + (size_t)row * 2048 + 1024 + col);
                yn[m] = *(const u32x4*)((const bf16_t*)(ws + WS_YNSA) + (size_t)row * 1024 + col); }
#pragma unroll
            for (int m = 0; m < 4; ++m) { const int row = u.pm * 256 + 128 * ai + 64 * wr + 16 * m + fr;
                float o[8];
#pragma unroll
                for (int e = 0; e < 8; ++e) { const float val = acc[ai][0][m][e >> 2][e & 3], gate = acc[ai][1][m][e >> 2][e & 3]; const float ys = val * sigmoidf_(gate);
                    const unsigned w0 = g0[m][e >> 1], w1 = g1[m][e >> 1], wy = yn[m][e >> 1];
                    const float a0 = (e & 1) ? bfhi(w0) : bflo(w0), a1 = (e & 1) ? bfhi(w1) : bflo(w1), yy = (e & 1) ? bfhi(wy) : bflo(wy);
                    o[e] = a0 * ys + a1 * yy; }
                u32x4 w; w.x = pk2(o[0], o[1]); w.y = pk2(o[2], o[3]); w.z = pk2(o[4], o[5]); w.w = pk2(o[6], o[7]);
                *(u32x4*)((bf16_t*)(ws + WS_MERGED) + (size_t)row * 1024 + col) = w; }
        }
    }
};
struct EpiWout {
    static constexpr bool PERM = false;
    const float* x; float* out; const float* gmod;
    __device__ __forceinline__ void operator()(const f32x4 (&acc)[2][2][4][2], const Unit& u, int wr, int wc, int fr, int fq) const {
        const int b = u.pm >> 5;
#pragma unroll
        for (int bj = 0; bj < 2; ++bj)
#pragma unroll
            for (int n = 0; n < 2; ++n) {
                const int col = u.pn * 256 + 128 * bj + 32 * wc + 16 * n + 4 * fq; const f32x4 gv = *(const f32x4*)(gmod + (size_t)b * 6144 + col);
                f32x4 xv[2][4];
#pragma unroll
                for (int ai = 0; ai < 2; ++ai)
#pragma unroll
                    for (int m = 0; m < 4; ++m) xv[ai][m] = *(const f32x4*)(x + (size_t)(u.pm * 256 + 128 * ai + 64 * wr + 16 * m + fr) * 1024 + col);
#pragma unroll
                for (int ai = 0; ai < 2; ++ai)
#pragma unroll
                    for (int m = 0; m < 4; ++m) { const f32x4 rv = xv[ai][m] * DN_ALPHA + gv * acc[ai][bj][m][n]; u32x2 w; w.x = pk2(rv[0], rv[1]); w.y = pk2(rv[2], rv[3]);
                        *(u32x2*)((bf16_t*)(out + (size_t)(u.pm * 256 + 128 * ai + 64 * wr + 16 * m + fr) * 1024) + col) = w; }
            }
    }
};
struct EpiF32 {
    static constexpr bool PERM = false;
    float* C; int ldc;
    __device__ __forceinline__ void operator()(const f32x4 (&acc)[2][2][4][2], const Unit& u, int wr, int wc, int fr, int fq) const {
#pragma unroll
        for (int ai = 0; ai < 2; ++ai)
#pragma unroll
            for (int m = 0; m < 4; ++m) { float* rowp = C + (size_t)(u.pm * 256 + 128 * ai + 64 * wr + 16 * m + fr) * ldc + u.pn * 256 + 32 * wc + 4 * fq;
#pragma unroll
                for (int bj = 0; bj < 2; ++bj)
#pragma unroll
                    for (int n = 0; n < 2; ++n) *(f32x4*)(rowp + bj * 128 + n * 16) = acc[ai][bj][m][n]; }
    }
};
struct EpiSwiglu {
    static constexpr bool PERM = true;
    bf16_t* H;
    __device__ __forceinline__ void operator()(const f32x4 (&acc)[2][2][4][2], const Unit& u, int wr, int wc, int fr, int fq) const {
#pragma unroll
        for (int ai = 0; ai < 2; ++ai)
#pragma unroll
            for (int m = 0; m < 4; ++m) {
                const size_t row = (size_t)u.pm * 256 + 128 * ai + 64 * wr + 16 * m + fr; const int col = u.pn * 128 + 32 * wc + 8 * fq;
                float o[8];
#pragma unroll
                for (int e = 0; e < 8; ++e) o[e] = siluf_(acc[ai][0][m][e >> 2][e & 3]) * acc[ai][1][m][e >> 2][e & 3];
                u32x4 w; w.x = pk2(o[0], o[1]); w.y = pk2(o[2], o[3]); w.z = pk2(o[4], o[5]); w.w = pk2(o[6], o[7]);
                *(u32x4*)(H + row * 256 + col) = w;
            }
    }
};

__device__ __forceinline__ int find_expert(const LAS int* tstart, int tau) {
    int lo = 0, hi = 256;
    while (hi - lo > 1) { const int mid = (lo + hi) >> 1; if (tstart[mid] <= tau) lo = mid; else hi = mid; }
    return lo;
}
struct SchedMoeGU {
    const char* abase; unsigned a_kstep; int K; const LAS int* tstart; const int* rowasg; const char* W; int G, c;
    __device__ __forceinline__ bool next(int i, Unit& u) const { const int x = c & 7, slot = c >> 3, per = (G >> 3) >> 1; const int tau = (i * 8 + x) * per + (slot >> 1); if ((G & 15) != 0 || tau >= tstart[256]) { if ((G & 15) != 0) { const int L = i * G + c; if (L >= 2 * tstart[256]) return false; u.pm = L >> 1; u.pn = L & 1; return true; } return false; } u.pm = tau; u.pn = slot & 1; return true; }
    __device__ __forceinline__ unsigned a_off(const Unit& u, int R) const { const int a = rowasg[u.pm * 256 + R]; const unsigned tok = a < 0 ? (unsigned)MTOK : (unsigned)a >> 3; return (unsigned)WS_H2 + tok * 2048u; }
    __device__ __forceinline__ const char* b_ptr(const Unit& u) const { const int e = find_expert(tstart, u.pm); return W + ((size_t)e * 512 + u.pn * 256) * 1024 * 2; }
};
struct SchedMoeD {
    const char* abase; unsigned a_kstep; int K; const LAS int* tstart; const char* W; int G, c;
    __device__ __forceinline__ bool next(int i, Unit& u) const { const int x = c & 7, slot = c >> 3, per = (G >> 3) >> 2; const int tau = (i * 8 + x) * per + (slot >> 2); if ((G & 31) != 0 || tau >= tstart[256]) { if ((G & 31) != 0) { const int L = i * G + c; if (L >= 4 * tstart[256]) return false; u.pm = L >> 2; u.pn = L & 3; return true; } return false; } u.pm = tau; u.pn = slot & 3; return true; }
    __device__ __forceinline__ unsigned a_off(const Unit& u, int R) const { return (unsigned)WS_HID + (unsigned)(u.pm * 256 + R) * 512u; }
    __device__ __forceinline__ const char* b_ptr(const Unit& u) const { const int e = find_expert(tstart, u.pm); return W + ((size_t)e * 1024 + u.pn * 256) * 256 * 2; }
};
struct EpiMoeDown {
    static constexpr bool PERM = true;
    unsigned char* O; const int* rowasg; const float* roww; int asg0;
    __device__ __forceinline__ void operator()(const f32x4 (&acc)[2][2][4][2], const Unit& u, int wr, int wc, int fr, int fq) const {
        int av[2][4]; float wv[2][4];
#pragma unroll
        for (int ai = 0; ai < 2; ++ai)
#pragma unroll
            for (int m = 0; m < 4; ++m) { const int row = u.pm * 256 + 128 * ai + 64 * wr + 16 * m + fr; av[ai][m] = rowasg[row]; wv[ai][m] = roww[row] * OUTS_SCALE; }
#pragma unroll
        for (int ai = 0; ai < 2; ++ai)
#pragma unroll
            for (int m = 0; m < 4; ++m) {
                const int a = av[ai][m]; const float w = wv[ai][m];
                if (a >= 0) { unsigned char* rowp = O + (size_t)(a - asg0) * 1024 + u.pn * 256 + 32 * wc + 8 * fq;
#pragma unroll
                    for (int bj = 0; bj < 2; ++bj) { f32x4 x0 = acc[ai][bj][m][0] * w, x1 = acc[ai][bj][m][1] * w;
#pragma unroll
                        for (int e = 0; e < 4; ++e) { x0[e] = fminf(fmaxf(x0[e], -440.f), 440.f); x1[e] = fminf(fmaxf(x1[e], -440.f), 440.f); }
                        int w0 = __builtin_amdgcn_cvt_pk_fp8_f32(x0[0], x0[1], 0, false); w0 = __builtin_amdgcn_cvt_pk_fp8_f32(x0[2], x0[3], w0, true);
                        int w1 = __builtin_amdgcn_cvt_pk_fp8_f32(x1[0], x1[1], 0, false); w1 = __builtin_amdgcn_cvt_pk_fp8_f32(x1[2], x1[3], w1, true);
                        u32x2 o; o.x = (unsigned)w0; o.y = (unsigned)w1; *(u32x2*)(rowp + bj * 128) = o; } }
            }
    }
};
struct EpiShDown {
    static constexpr bool PERM = true;
    unsigned char* O;
    __device__ __forceinline__ void operator()(const f32x4 (&acc)[2][2][4][2], const Unit& u, int wr, int wc, int fr, int fq) const {
#pragma unroll
        for (int ai = 0; ai < 2; ++ai)
#pragma unroll
            for (int m = 0; m < 4; ++m) { unsigned char* rowp = O + (size_t)(u.pm * 256 + 128 * ai + 64 * wr + 16 * m + fr) * 1024 + u.pn * 256 + 32 * wc + 8 * fq;
#pragma unroll
                for (int bj = 0; bj < 2; ++bj) { f32x4 x0 = acc[ai][bj][m][0] * OUTS_SCALE, x1 = acc[ai][bj][m][1] * OUTS_SCALE;
#pragma unroll
                    for (int e = 0; e < 4; ++e) { x0[e] = fminf(fmaxf(x0[e], -440.f), 440.f); x1[e] = fminf(fmaxf(x1[e], -440.f), 440.f); }
                    int w0 = __builtin_amdgcn_cvt_pk_fp8_f32(x0[0], x0[1], 0, false); w0 = __builtin_amdgcn_cvt_pk_fp8_f32(x0[2], x0[3], w0, true);
                    int w1 = __builtin_amdgcn_cvt_pk_fp8_f32(x1[0], x1[1], 0, false); w1 = __builtin_amdgcn_cvt_pk_fp8_f32(x1[2], x1[3], w1, true);
                    u32x2 o; o.x = (unsigned)w0; o.y = (unsigned)w1; *(u32x2*)(rowp + bj * 128) = o; } }
    }
};

__device__ __forceinline__ void transpose_item(const float* src, size_t ld, int nvalid, bf16_t* dst, size_t dld, LAS float* scr, int lane) {
    { const int j4 = lane & 7, k8 = lane >> 3;
        f32x4 v[8];
#pragma unroll
        for (int i = 0; i < 8; ++i) v[i] = 4 * j4 < nvalid ? *(const f32x4*)(src + (size_t)(8 * i + k8) * ld + 4 * j4) : (f32x4){0.f, 0.f, 0.f, 0.f};
#pragma unroll
        for (int i = 0; i < 8; ++i) { LAS float* d = scr + (8 * i + k8) * 33 + 4 * j4; d[0] = v[i][0]; d[1] = v[i][1]; d[2] = v[i][2]; d[3] = v[i][3]; } }
    LDS_WAIT(); asm volatile("" ::: "memory");
    const int c = lane & 7;
#pragma unroll
    for (int j = 0; j < 4; ++j) { const int n = (lane >> 3) + 8 * j; const LAS float* s = scr + (8 * c) * 33 + n;
        u32x4 o; o.x = pk2(s[0 * 33], s[1 * 33]); o.y = pk2(s[2 * 33], s[3 * 33]); o.z = pk2(s[4 * 33], s[5 * 33]); o.w = pk2(s[6 * 33], s[7 * 33]);
        *(u32x4*)(dst + (size_t)n * dld + 8 * c) = o; }
    LDS_WAIT(); asm volatile("" ::: "memory");
}
__device__ __forceinline__ void transpose_item2(const float* srcA, size_t ldA, bf16_t* dstA, size_t dldA, const float* srcB, size_t ldB, bf16_t* dstB, size_t dldB, LAS float* scr, int lane) {
    const int j4 = lane & 7, k8 = lane >> 3, c = lane & 7;
    f32x4 va[8], vb[8];
#pragma unroll
    for (int i = 0; i < 8; ++i) va[i] = *(const f32x4*)(srcA + (size_t)(8 * i + k8) * ldA + 4 * j4);
#pragma unroll
    for (int i = 0; i < 8; ++i) vb[i] = *(const f32x4*)(srcB + (size_t)(8 * i + k8) * ldB + 4 * j4);
#pragma unroll
    for (int i = 0; i < 8; ++i) { LAS float* d = scr + (8 * i + k8) * 33 + 4 * j4; d[0] = va[i][0]; d[1] = va[i][1]; d[2] = va[i][2]; d[3] = va[i][3]; }
    LDS_WAIT(); asm volatile("" ::: "memory");
#pragma unroll
    for (int j = 0; j < 4; ++j) { const int n = (lane >> 3) + 8 * j; const LAS float* sp = scr + (8 * c) * 33 + n;
        u32x4 o; o.x = pk2(sp[0 * 33], sp[1 * 33]); o.y = pk2(sp[2 * 33], sp[3 * 33]); o.z = pk2(sp[4 * 33], sp[5 * 33]); o.w = pk2(sp[6 * 33], sp[7 * 33]);
        *(u32x4*)(dstA + (size_t)n * dldA + 8 * c) = o; }
    LDS_WAIT(); asm volatile("" ::: "memory");
#pragma unroll
    for (int i = 0; i < 8; ++i) { LAS float* d = scr + (8 * i + k8) * 33 + 4 * j4; d[0] = vb[i][0]; d[1] = vb[i][1]; d[2] = vb[i][2]; d[3] = vb[i][3]; }
    LDS_WAIT(); asm volatile("" ::: "memory");
#pragma unroll
    for (int j = 0; j < 4; ++j) { const int n = (lane >> 3) + 8 * j; const LAS float* sp = scr + (8 * c) * 33 + n;
        u32x4 o; o.x = pk2(sp[0 * 33], sp[1 * 33]); o.y = pk2(sp[2 * 33], sp[3 * 33]); o.z = pk2(sp[4 * 33], sp[5 * 33]); o.w = pk2(sp[6 * 33], sp[7 * 33]);
        *(u32x4*)(dstB + (size_t)n * dldB + 8 * c) = o; }
    LDS_WAIT(); asm volatile("" ::: "memory");
}
struct In {
    const float *x, *c, *ada_w, *ada_b, *w_in, *lam_re, *lam_im, *log_step, *b_re, *b_im, *c_re, *c_im, *ssm_d, *glu_w, *cmp_pos, *cmp_w1, *cmp_w2, *rel_bias, *w_out,
        *ln1_g, *ln1_b, *router_w, *router_bias, *w_gate, *w_up, *w_down, *sh_gate, *sh_up, *sh_down, *ln2_g, *ln2_b;
};
static_assert(sizeof(In) == 31 * sizeof(void*), "In");

__device__ __forceinline__ void p0_small_weights(const In& in, unsigned char* ws, LAS float* scr, int gw, int NGW, int lane) {
    constexpr int I_WIN = 168 * 16, I_GLU = 64 * 8, I_WOUT = 32 * 16, I_ROUT = 8 * 16, I_SHGU = 16 * 16, I_SHD = 32 * 4, I_CW1 = 2 * 8 * 32, I_CW2 = 2 * 2 * 4;
    constexpr int NITEMS = I_WIN + I_GLU + I_WOUT + I_ROUT + I_SHGU + I_SHD + I_CW1 + I_CW2;
    for (int it = gw; it < NITEMS; it += NGW) {
        int r = it;
        if (r < I_WIN) { const int db = r / 16, kb = r % 16, n0 = 32 * db; int src, nv = 32;
            if (n0 < 3072) src = n0; else if (n0 < 5120) src = n0 + 48; else if (n0 < 5152) src = n0 - 2048; else if (n0 == 5152) { src = 3104; nv = 16; } else { src = 0; nv = 0; }
            transpose_item(in.w_in + (size_t)(64 * kb) * 5168 + src, 5168, nv, (bf16_t*)(ws + WS_WIN) + (size_t)n0 * 1024 + 64 * kb, 1024, scr, lane); continue; } r -= I_WIN;
        if (r < I_GLU) { const int db = r / 8, kb = r % 8, n0 = 32 * db, pn = n0 >> 8, half = (n0 >> 7) & 1, j = n0 & 127;
            transpose_item(in.glu_w + (size_t)(64 * kb) * 2048 + half * 1024 + pn * 128 + j, 2048, 32, (bf16_t*)(ws + WS_GLU) + (size_t)n0 * 512 + 64 * kb, 512, scr, lane); continue; } r -= I_GLU;
        if (r < I_WOUT) { const int db = r / 16, kb = r % 16;
            transpose_item(in.w_out + (size_t)(64 * kb) * 1024 + 32 * db, 1024, 32, (bf16_t*)(ws + WS_WOUT) + (size_t)(32 * db) * 1024 + 64 * kb, 1024, scr, lane); continue; } r -= I_WOUT;
        if (r < I_ROUT) { const int db = r / 16, kb = r % 16;
            transpose_item(in.router_w + (size_t)(64 * kb) * 256 + 32 * db, 256, 32, (bf16_t*)(ws + WS_ROUT) + (size_t)(32 * db) * 1024 + 64 * kb, 1024, scr, lane); continue; } r -= I_ROUT;
        if (r < I_SHGU) { const int db = r / 16, kb = r % 16, n0 = 32 * db, pn = n0 >> 8, half = (n0 >> 7) & 1, j = n0 & 127;
            transpose_item((half ? in.sh_up : in.sh_gate) + (size_t)(64 * kb) * 256 + pn * 128 + j, 256, 32, (bf16_t*)(ws + WS_SHGU) + (size_t)n0 * 1024 + 64 * kb, 1024, scr, lane); continue; } r -= I_SHGU;
        if (r < I_SHD) { const int db = r / 4, kb = r % 4;
            transpose_item(in.sh_down + (size_t)(64 * kb) * 1024 + 32 * db, 1024, 32, (bf16_t*)(ws + WS_SHD) + (size_t)(32 * db) * 256 + 64 * kb, 256, scr, lane); continue; } r -= I_SHD;
        if (r < I_CW1) { const int ts = r / 256, rr = r % 256, db = rr / 32, kb = rr % 32;
            transpose_item(in.cmp_w1 + (size_t)ts * 2048 * 256 + (size_t)(64 * kb) * 256 + 32 * db, 256, 32, (bf16_t*)(ws + WS_CW1) + (size_t)ts * 256 * 2048 + (size_t)(32 * db) * 2048 + 64 * kb, 2048, scr, lane); continue; } r -= I_CW1;
        { const int ts = r / 8, rr = r % 8, db = rr / 4, kb = rr % 4;
            transpose_item(in.cmp_w2 + (size_t)ts * 256 * 64 + (size_t)(64 * kb) * 64 + 32 * db, 64, 32, (bf16_t*)(ws + WS_CW2) + (size_t)ts * 256 * 256 + (size_t)(32 * db) * 256 + 64 * kb, 256, scr, lane); }
    }
    for (int i = gw * 64 + lane; i < 2 * 192 * 32; i += NGW * 64) { const int ts = i / (192 * 32), rr = i % (192 * 32); *(u32x4*)(ws + WS_CW2 + (size_t)ts * 256 * 512 + (size_t)64 * 512 + (size_t)rr * 16) = (u32x4){0u, 0u, 0u, 0u}; }
}
struct ConvItem { const float* src; size_t ld; bf16_t* dst; size_t dld; };
__device__ __forceinline__ void convert_expert_weights(const In& in, unsigned char* ws, LAS float* scr, int gw, int NGW, int lane, int part) {
    constexpr int I_GU = 256, I_D = 128;
    bool have = false; ConvItem pa{nullptr, 0, nullptr, 0};
    for (int it = gw; it < NEXP * (I_GU + I_D); it += NGW) {
        const int e = it / (I_GU + I_D), r = it % (I_GU + I_D);
        { const bool mid = e >= 63 && e <= 190; const bool early = r >= I_GU || !mid; if (early != (part == 0)) continue; }
        ConvItem d;
        if (r < I_GU) { const int db = r / 16, kb = r % 16, n0 = 32 * db, pn = n0 >> 8, half = (n0 >> 7) & 1, j = n0 & 127;
            d.src = (half ? in.w_up : in.w_gate) + (size_t)e * 1024 * 256 + (size_t)(64 * kb) * 256 + pn * 128 + j; d.ld = 256; d.dst = (bf16_t*)(ws + WS_WGU) + ((size_t)e * 512 + n0) * 1024 + 64 * kb; d.dld = 1024; }
        else { const int rr = r - I_GU, db = rr / 4, kb = rr % 4;
            d.src = in.w_down + (size_t)e * 256 * 1024 + (size_t)(64 * kb) * 1024 + 32 * db; d.ld = 1024; d.dst = (bf16_t*)(ws + WS_WD) + ((size_t)e * 1024 + 32 * db) * 256 + 64 * kb; d.dld = 256; }
        if (!have) { pa = d; have = true; }
        else { transpose_item2(pa.src, pa.ld, pa.dst, pa.dld, d.src, d.ld, d.dst, d.dld, scr, lane); have = false; }
    }
    if (have) transpose_item(pa.src, pa.ld, 32, pa.dst, pa.dld, scr, lane);
}

__device__ __forceinline__ void p0_mod(const In& in, unsigned char* ws, LAS unsigned char* lds, int tid) {
    LAS float* cond = (LAS float*)lds;
    LAS float* part = (LAS float*)(lds + 32768);
    for (int i = tid; i < 8192; i += NTHREADS) cond[i] = siluf_(in.c[i]);
    __syncthreads();
    const int col = tid % 24, ks = tid / 24, e = (int)blockIdx.x * 24 + col;
    if (tid < 504) {
        float a[8];
#pragma unroll
        for (int b = 0; b < 8; ++b) a[b] = 0.f;
        for (int k = ks; k < 1024; k += 21) { const float w = in.ada_w[(size_t)k * 6144 + e];
#pragma unroll
            for (int b = 0; b < 8; ++b) a[b] += cond[b * 1024 + k] * w; }
#pragma unroll
        for (int b = 0; b < 8; ++b) part[(ks * 24 + col) * 8 + b] = a[b];
    }
    __syncthreads();
    if (tid < 192) { const int c2 = tid % 24, b = tid / 24; float s = 0.f; for (int k = 0; k < 21; ++k) s += part[(k * 24 + c2) * 8 + b];
        const int e2 = (int)blockIdx.x * 24 + c2; ((float*)(ws + WS_MOD))[b * 6144 + e2] = s + in.ada_b[e2]; }
    __syncthreads();
}
__device__ __forceinline__ void p0_tables(const In& in, unsigned char* ws, LAS unsigned char* lds, int tid) {
    const int w = (int)blockIdx.x;
    if (w < 16) {
        const int ts = w >> 3, kq = w & 7, c = tid & 255, kh = tid >> 8; float s = 0.f;
        const float* pos = in.cmp_pos + ts * 2048; const float* w1 = in.cmp_w1 + (size_t)ts * 2048 * 256;
        for (int k = kq * 256 + kh * 128; k < kq * 256 + kh * 128 + 128; ++k) s += pos[k] * w1[(size_t)k * 256 + c];
        ((float*)(ws + WS_CTL + 131072))[((ts * 8 + kq) * 2 + kh) * 256 + c] = s;
    } else if (w == 16) {
        for (int i = tid; i < 16 * 132; i += NTHREADS) { const int h = i / 132, dd = i % 132; int bk;
            if (dd < 16) bk = dd; else { const int v = 16 + (int)(__logf((float)dd * (1.0f / 16.0f)) / 2.0794415416798357f * 16.0f); bk = v < 31 ? v : 31; }
            if (dd >= 128) bk = 31;
            ((float*)(ws + WS_TAB + TAB_LUT))[i] = in.rel_bias[bk * 16 + h] * 1.4426950408889634f; }
    } else if (w >= 32 && w < 64) {
        const int g = w - 32;
        LAS float* bbr = (LAS float*)lds; LAS float* bbi = bbr + 1024;
        if (tid < 64) { const int p = tid; const float lr = in.lam_re[g * 64 + p], li = in.lam_im[g * 64 + p], dt = expf(in.log_step[g]);
            const float mag = expf(lr * dt), ar = mag * cosf(li * dt), ai = mag * sinf(li * dt), den = lr * lr + li * li;
            const float kr = ((ar - 1.0f) * lr + ai * li) / den, ki = (ai * lr - (ar - 1.0f) * li) / den;
            for (int c = 0; c < 16; ++c) { const float br = in.b_re[(g * 64 + p) * 16 + c], bi = in.b_im[(g * 64 + p) * 16 + c]; bbr[p * 16 + c] = kr * br - ki * bi; bbi[p * 16 + c] = kr * bi + ki * br; }
            float* A = (float*)(ws + WS_S5T + S5_A) + (g * 64 + p) * 2; A[0] = ar; A[1] = ai;
            float xr = ar, xi = ai; for (int s = 0; s < 10; ++s) { const float nr = xr * xr - xi * xi, ni = 2.0f * xr * xi; xr = nr; xi = ni; }
            float* AC = (float*)(ws + WS_S5T + S5_AC) + (g * 64 + p) * 2; AC[0] = xr; AC[1] = xi; }
        __syncthreads();
        { const int f = tid >> 6, lane = tid & 63, pt = f >> 1, ri = f & 1, p = 16 * pt + (lane & 15), q = lane >> 4;
            bf16_t* dst = (bf16_t*)(ws + WS_S5T + S5_AFR) + ((size_t)(g * 8 + f) * 64 + lane) * 8;
            for (int j = 0; j < 8; ++j) { const float v = q < 2 ? (ri ? bbi : bbr)[p * 16 + 8 * q + j] : 0.f; dst[j] = (bf16_t)f2bf(v); } }
        if (tid < 256) { const int s = tid >> 6, lane = tid & 63, c = lane & 15, q = lane >> 4;
            bf16_t* dst = (bf16_t*)(ws + WS_S5T + S5_CFR) + ((size_t)(g * 4 + s) * 64 + lane) * 8;
            for (int j = 0; j < 8; ++j) { const int k = 32 * s + 8 * q + j, p = k >> 1; const float v = (k & 1) ? -in.c_im[(g * 16 + c) * 64 + p] : in.c_re[(g * 16 + c) * 64 + p]; dst[j] = (bf16_t)f2bf(v); } }
        __syncthreads();
    }
}

struct RowV { f32x4 v[4]; };
__device__ __forceinline__ RowV row_load(const float* p, int lane) { RowV r; const f32x4* q = (const f32x4*)p + lane;
#pragma unroll
    for (int j = 0; j < 4; ++j) r.v[j] = q[64 * j]; return r; }
__device__ __forceinline__ RowV row_load_bf16(const bf16_t* p, int lane) { RowV r; const u32x2* q = (const u32x2*)p + lane;
#pragma unroll
    for (int j = 0; j < 4; ++j) { const u32x2 w = q[64 * j]; r.v[j] = (f32x4){bflo(w.x), bfhi(w.x), bflo(w.y), bfhi(w.y)}; } return r; }
__device__ __forceinline__ void row_norm(RowV& r) {
    float s = 0.f;
#pragma unroll
    for (int j = 0; j < 4; ++j) s += (r.v[j].x + r.v[j].y) + (r.v[j].z + r.v[j].w);
    const float mean = wave_sum(s) * (1.f / DM); float s2 = 0.f;
#pragma unroll
    for (int j = 0; j < 4; ++j) { r.v[j] = r.v[j] - mean; s2 += (r.v[j].x * r.v[j].x + r.v[j].y * r.v[j].y) + (r.v[j].z * r.v[j].z + r.v[j].w * r.v[j].w); }
    const float rstd = 1.f / sqrtf(wave_sum(s2) * (1.f / DM) + LN_EPS);
#pragma unroll
    for (int j = 0; j < 4; ++j) r.v[j] = r.v[j] * rstd;
}
__device__ __forceinline__ void row_norm_stats(RowV& r, float& mean_o, float& rstd_o) {
    float s = 0.f;
#pragma unroll
    for (int j = 0; j < 4; ++j) s += (r.v[j].x + r.v[j].y) + (r.v[j].z + r.v[j].w);
    const float mean = wave_sum(s) * (1.f / DM); float s2 = 0.f;
#pragma unroll
    for (int j = 0; j < 4; ++j) { r.v[j] = r.v[j] - mean; s2 += (r.v[j].x * r.v[j].x + r.v[j].y * r.v[j].y) + (r.v[j].z * r.v[j].z + r.v[j].w * r.v[j].w); }
    const float rstd = 1.f / sqrtf(wave_sum(s2) * (1.f / DM) + LN_EPS);
#pragma unroll
    for (int j = 0; j < 4; ++j) r.v[j] = r.v[j] * rstd;
    mean_o = mean; rstd_o = rstd;
}
__device__ __forceinline__ void row_store_bf16(bf16_t* p, const RowV& r, int lane) { u32x2* o = (u32x2*)p + lane;
#pragma unroll
    for (int j = 0; j < 4; ++j) { u32x2 w; w.x = pk2(r.v[j].x, r.v[j].y); w.y = pk2(r.v[j].z, r.v[j].w); o[64 * j] = w; } }
__device__ __forceinline__ void ph_h1(const In& in, unsigned char* ws, int gw, int NGW, int lane) {
    const float* mod = (const float*)(ws + WS_MOD);
    for (int row = gw; row < MTOK; row += NGW) { const int b = row >> 13;
        RowV r = row_load(in.x + (size_t)row * DM, lane); row_norm(r);
        const RowV sh = row_load(mod + b * 6144, lane), sc = row_load(mod + b * 6144 + 1024, lane);
#pragma unroll
        for (int j = 0; j < 4; ++j) r.v[j] = r.v[j] * (sc.v[j] + 1.0f) + sh.v[j];
        row_store_bf16((bf16_t*)(ws + WS_H1) + (size_t)row * DM, r, lane); }
}
__device__ __forceinline__ void ph_ln1(const In& in, unsigned char* ws, float* r1, int gw, int NGW, int lane) {
    const float* mod = (const float*)(ws + WS_MOD);
    const RowV g = row_load(in.ln1_g, lane), bb = row_load(in.ln1_b, lane);
    for (int row = gw; row < MTOK; row += NGW) { const int b = row >> 13;
        RowV r = row_load_bf16((const bf16_t*)(r1 + (size_t)row * DM), lane); float mean, rstd; row_norm_stats(r, mean, rstd);
        if (lane == 0) *(f32x2*)((float*)(ws + WS_LNST) + (size_t)row * 2) = (f32x2){mean, rstd};
#pragma unroll
        for (int j = 0; j < 4; ++j) r.v[j] = r.v[j] * g.v[j] + bb.v[j];
        row_norm(r);
        const RowV sh = row_load(mod + b * 6144 + 3072, lane), sc = row_load(mod + b * 6144 + 4096, lane);
#pragma unroll
        for (int j = 0; j < 4; ++j) r.v[j] = r.v[j] * (sc.v[j] + 1.0f) + sh.v[j];
        row_store_bf16((bf16_t*)(ws + WS_H2) + (size_t)row * DM, r, lane); }
}
__device__ __forceinline__ void final_row(const In& in, unsigned char* ws, float* out, int tok, int chunk, const RowV& g, const RowV& bb, const RowV& g1, const RowV& b1, int lane) {
    const float* mod = (const float*)(ws + WS_MOD); const int b = tok >> 13;
    RowV v = row_load_bf16((const bf16_t*)(out + (size_t)tok * DM), lane); const RowV g2 = row_load(mod + b * 6144 + 5120, lane);
    const f32x2 stt = *(const f32x2*)((const float*)(ws + WS_LNST) + (size_t)tok * 2);
    const unsigned* sp = (const unsigned*)(ws + WS_OUTS + (size_t)(tok - chunk * CHUNK_TOK) * 8 * DM) + lane;
    const unsigned* shp = (const unsigned*)(ws + WS_SHOUT + (size_t)tok * DM) + lane;
    f32x4 acc[4];
#pragma unroll
    for (int j = 0; j < 4; ++j) { const int w = (int)shp[64 * j]; const f32x2 lo = __builtin_amdgcn_cvt_pk_f32_fp8(w, false), hi = __builtin_amdgcn_cvt_pk_f32_fp8(w, true); acc[j] = (f32x4){lo.x, lo.y, hi.x, hi.y}; }
#pragma unroll
    for (int k = 0; k < 8; ++k)
#pragma unroll
        for (int j = 0; j < 4; ++j) { const int w = (int)sp[k * 256 + 64 * j]; const f32x2 lo = __builtin_amdgcn_cvt_pk_f32_fp8(w, false), hi = __builtin_amdgcn_cvt_pk_f32_fp8(w, true);
            acc[j] = acc[j] + (f32x4){lo.x, lo.y, hi.x, hi.y}; }
#pragma unroll
    for (int j = 0; j < 4; ++j) { const f32x4 x1 = (v.v[j] - stt.x) * stt.y * g1.v[j] + b1.v[j]; v.v[j] = x1 * DN_ALPHA + g2.v[j] * (acc[j] * (1.0f / OUTS_SCALE)); }
    row_norm(v);
    f32x4* o = (f32x4*)(out + (size_t)tok * DM) + lane;
#pragma unroll
    for (int j = 0; j < 4; ++j) o[64 * j] = v.v[j] * g.v[j] + bb.v[j];
}
__device__ __forceinline__ void final_chunk(const In& in, unsigned char* ws, float* out, unsigned* ticket, int chunk, volatile LAS unsigned* bcast, int tid, int wave, int lane) {
    int ll = lane; asm volatile("" : "+v"(ll));
    const RowV g = row_load(in.ln2_g, ll), bb = row_load(in.ln2_b, ll), g1 = row_load(in.ln1_g, ll), b1 = row_load(in.ln1_b, ll);
    for (;;) {
        __syncthreads();
        if (tid == 0) bcast[0] = __hip_atomic_fetch_add(ticket, 64u, RLX_AGENT);
        __syncthreads();
        const unsigned base = bcast[0];
        if (base >= (unsigned)chunk_ntok(chunk)) break;
        for (int i = 0; i < 8; ++i) final_row(in, ws, out, chunk * CHUNK_TOK + (int)base + wave * 8 + i, chunk, g, bb, g1, b1, lane);
    }
}
constexpr int S5_LDS_PER_WAVE = 4352;
template <bool FULL>
__device__ __forceinline__ void s5_task(const In& in, unsigned char* ws, LAS unsigned char* wlds, int b, int g, int ch, int lane) {
    const int col = lane & 15, q = lane >> 4;
    LAS unsigned* BU = (LAS unsigned*)wlds;
    LAS unsigned char* XB = wlds;
    bf16x8 afr[8], cfr[4];
#pragma unroll
    for (int f = 0; f < 8; ++f) afr[f] = *(const bf16x8*)((const bf16_t*)(ws + WS_S5T + S5_AFR) + ((size_t)(g * 8 + f) * 64 + lane) * 8);
    if (FULL) {
#pragma unroll
        for (int s = 0; s < 4; ++s) cfr[s] = *(const bf16x8*)((const bf16_t*)(ws + WS_S5T + S5_CFR) + ((size_t)(g * 4 + s) * 64 + lane) * 8);
    }
    const float ar = ((const float*)(ws + WS_S5T + S5_A))[(g * 64 + lane) * 2], ai = ((const float*)(ws + WS_S5T + S5_A))[(g * 64 + lane) * 2 + 1];
    float xr = 0.f, xi = 0.f;
    float* st = (float*)(ws + WS_S5ST);
    if (FULL) {
        const float cr_ = ((const float*)(ws + WS_S5T + S5_AC))[(g * 64 + lane) * 2], ci_ = ((const float*)(ws + WS_S5T + S5_AC))[(g * 64 + lane) * 2 + 1];
        for (int c2 = 0; c2 < ch; ++c2) { const float sr = st[((size_t)((b * 32 + g) * 8 + c2) * 64 + lane) * 2], si = st[((size_t)((b * 32 + g) * 8 + c2) * 64 + lane) * 2 + 1];
            const float nr = cr_ * xr - ci_ * xi + sr, ni = cr_ * xi + ci_ * xr + si; xr = nr; xi = ni; }
    }
    const bf16_t* U = (const bf16_t*)(ws + WS_U);
    f32x4 dsk = (f32x4){0.f, 0.f, 0.f, 0.f};
    if (FULL) dsk = *(const f32x4*)(in.ssm_d + g * 16 + 4 * q);
    const size_t row00 = (size_t)b * SEQ + (size_t)ch * 1024;
    for (int sb = 0; sb < 64; ++sb) {
        const size_t row0 = row00 + 16 * sb;
        bf16x8 ufr = (bf16x8){0, 0, 0, 0, 0, 0, 0, 0};
        if (q < 2) ufr = *(const bf16x8*)(U + (row0 + col) * 512 + g * 16 + 8 * q);
#pragma unroll
        for (int pt = 0; pt < 4; ++pt) {
            const f32x4 dr = __builtin_amdgcn_mfma_f32_16x16x32_bf16(afr[2 * pt], ufr, (f32x4){0.f, 0.f, 0.f, 0.f}, 0, 0, 0);
            const f32x4 di = __builtin_amdgcn_mfma_f32_16x16x32_bf16(afr[2 * pt + 1], ufr, (f32x4){0.f, 0.f, 0.f, 0.f}, 0, 0, 0);
            u32x4 w; w.x = pk2(dr[0], di[0]); w.y = pk2(dr[1], di[1]); w.z = pk2(dr[2], di[2]); w.w = pk2(dr[3], di[3]);
            *(LAS u32x4*)(BU + col * 68 + 16 * pt + 4 * q) = w; }
        asm volatile("s_waitcnt lgkmcnt(0)" ::: "memory");
#pragma unroll
        for (int t = 0; t < 16; ++t) { const unsigned bw = BU[t * 68 + lane]; const float br = bflo(bw), bi = bfhi(bw);
            const float nr = ar * xr - ai * xi + br, ni = ar * xi + ai * xr + bi; xr = nr; xi = ni;
            if (FULL) *(LAS unsigned*)(XB + t * 272 + 4 * lane) = pk2(xr, xi); }
        asm volatile("s_waitcnt lgkmcnt(0)" ::: "memory");
        if (FULL) {
            f32x4 y = (f32x4){0.f, 0.f, 0.f, 0.f};
#pragma unroll
            for (int s = 0; s < 4; ++s) { const bf16x8 xf = *(const LAS bf16x8*)(XB + col * 272 + (32 * s + 8 * q) * 2); y = __builtin_amdgcn_mfma_f32_16x16x32_bf16(cfr[s], xf, y, 0, 0, 0); }
            const u32x2 uw = *(const u32x2*)(U + (row0 + col) * 512 + g * 16 + 4 * q);
            const f32x4 uv = (f32x4){bflo(uw.x), bfhi(uw.x), bflo(uw.y), bfhi(uw.y)};
            y = y + dsk * uv;
            u32x2 o; o.x = pk2(gelu_tanh(y[0]), gelu_tanh(y[1])); o.y = pk2(gelu_tanh(y[2]), gelu_tanh(y[3]));
            *(u32x2*)((bf16_t*)(ws + WS_Z) + (row0 + col) * 512 + g * 16 + 4 * q) = o;
            asm volatile("s_waitcnt lgkmcnt(0)" ::: "memory");
        }
    }
    if (!FULL) { st[((size_t)((b * 32 + g) * 8 + ch) * 64 + lane) * 2] = xr; st[((size_t)((b * 32 + g) * 8 + ch) * 64 + lane) * 2 + 1] = xi; }
}

constexpr int NSA_KB = 0, NSA_VB = 32768, NSA_IMP = 65536, NSA_RES = 65536;
static_assert(NSA_IMP + 67584 <= MISC_OFF && NSA_RES + 65536 <= MISC_OFF, "attention LDS map");
__device__ __forceinline__ bf16x8 pack8(const f32x4& a, const f32x4& b) {
    u32x4 w; w.x = pk2(a[0], a[1]); w.y = pk2(a[2], a[3]); w.z = pk2(b[0], b[1]); w.w = pk2(b[2], b[3]); return __builtin_bit_cast(bf16x8, w);
}
struct Softmax { float m; f32x4 l; };
typedef unsigned u32x2s __attribute__((ext_vector_type(2)));
__device__ __forceinline__ float fmax_x16(float x) { return fmaxf(x, __shfl_xor(x, 16)); }
__device__ __forceinline__ float fmax_x32(float x) { return fmaxf(x, __shfl_xor(x, 32)); }
__device__ __forceinline__ float fadd_x16(float x) { return x + __shfl_xor(x, 16); }
__device__ __forceinline__ float fadd_x32(float x) { return x + __shfl_xor(x, 32); }
__device__ __forceinline__ unsigned or_x16(unsigned u) { return u | __shfl_xor(u, 16); }
__device__ __forceinline__ unsigned or_x32(unsigned u) { return u | __shfl_xor(u, 32); }
__device__ __forceinline__ float dpp_x1(float x) { return __builtin_bit_cast(float, __builtin_amdgcn_update_dpp(0, __builtin_bit_cast(int, x), 0xB1, 0xF, 0xF, true)); }
__device__ __forceinline__ float dpp_x2(float x) { return __builtin_bit_cast(float, __builtin_amdgcn_update_dpp(0, __builtin_bit_cast(int, x), 0x4E, 0xF, 0xF, true)); }
__device__ __forceinline__ int dpp_x1i(int x) { return __builtin_amdgcn_update_dpp(0, x, 0xB1, 0xF, 0xF, true); }
__device__ __forceinline__ int dpp_x2i(int x) { return __builtin_amdgcn_update_dpp(0, x, 0x4E, 0xF, 0xF, true); }
__device__ __forceinline__ float ex2(float x) { return __builtin_amdgcn_exp2f(x); }
__device__ __forceinline__ float max16(const f32x4 (&S)[4]) {
    float a = fmaxf(fmaxf(S[0][0], S[0][1]), S[0][2]); a = fmaxf(fmaxf(a, S[0][3]), S[1][0]); a = fmaxf(fmaxf(a, S[1][1]), S[1][2]);
    float b = fmaxf(fmaxf(S[2][0], S[2][1]), S[2][2]); b = fmaxf(fmaxf(b, S[2][3]), S[3][0]); b = fmaxf(fmaxf(b, S[3][1]), S[3][2]);
    return fmaxf(fmaxf(a, S[1][3]), fmaxf(b, S[3][3]));
}
#define ONES8 ((bf16x8){(bf16_t)0x3F80, (bf16_t)0x3F80, (bf16_t)0x3F80, (bf16_t)0x3F80, (bf16_t)0x3F80, (bf16_t)0x3F80, (bf16_t)0x3F80, (bf16_t)0x3F80})
__device__ __forceinline__ void best_pair(float& bv, int& bj, float ov, int oj) { const bool take = (ov > bv) | ((ov == bv) & (oj < bj)); bv = take ? ov : bv; bj = take ? oj : bj; }
__device__ __forceinline__ void best_x16(float& bv, int& bj) { const float ov = __shfl_xor(bv, 16); const int oj = __shfl_xor(bj, 16); best_pair(bv, bj, ov, oj); }
__device__ __forceinline__ void best_x32(float& bv, int& bj) { const float ov = __shfl_xor(bv, 32); const int oj = __shfl_xor(bj, 32); best_pair(bv, bj, ov, oj); }
struct Stage { u32x4 k, v; };
__device__ __forceinline__ void stage_load(Stage& s, const unsigned char* kg, size_t kstride, const unsigned char* vg, size_t vstride, int tid, bool hasv) {
    const int row = tid >> 3, ch = tid & 7;
    s.k = *(const u32x4*)(kg + (size_t)row * kstride + ch * 16);
    if (hasv) s.v = *(const u32x4*)(vg + (size_t)row * vstride + ch * 16);
}
__device__ __forceinline__ void stage_store(const Stage& s, LAS unsigned char* lds, int buf, int tid, bool hasv) {
    const int row = tid >> 3, ch = tid & 7, off = row * 128 + ((ch ^ (row & 7)) << 4);
    *(LAS u32x4*)(lds + NSA_KB + buf * 8192 + off) = s.k;
    if (hasv) *(LAS u32x4*)(lds + NSA_VB + buf * 8192 + off) = s.v;
}
__device__ __forceinline__ bf16x8 lds_frag(const LAS unsigned char* base, int row, int ch) { return *(const LAS bf16x8*)(base + row * 128 + ((ch ^ (row & 7)) << 4)); }

__device__ __forceinline__ void select_blocks(const LAS float* impw, int tl, int r, int q, int cur, unsigned (&w)[4]) {
    w[0] = w[1] = w[2] = w[3] = 0u;
    if (cur < 16) { w[0] = (2u << cur) - 1u; return; }
    const int s16 = r * 4 + q;
    float cand[8];
#pragma unroll
    for (int k = 0; k < 8; ++k) { const int j = s16 + 16 * k; cand[k] = (j >= 1 && j <= cur - 2) ? impw[tl * 264 + j] + impw[tl * 264 + 132 + j] : -1.0f; }
    unsigned chosen = 0u;
    for (int it = 0; it < 13; ++it) {
        float bv = -2.0f; int bj = 1 << 20;
#pragma unroll
        for (int k = 0; k < 8; ++k) { const bool ok = !((chosen >> k) & 1u) && cand[k] > bv; bv = ok ? cand[k] : bv; bj = ok ? s16 + 16 * k : bj; }
        best_pair(bv, bj, dpp_x1(bv), dpp_x1i(bj)); best_pair(bv, bj, dpp_x2(bv), dpp_x2i(bj)); best_x16(bv, bj); best_x32(bv, bj);
        if ((bj & 15) == s16) chosen |= 1u << (bj >> 4);
    }
#pragma unroll
    for (int k = 0; k < 8; ++k) { const unsigned bit = ((chosen >> k) & 1u) << (s16 + 16 * (k & 1)); w[k >> 1] |= bit; }
#pragma unroll
    for (int x = 0; x < 4; ++x) { unsigned v = w[x]; v |= (unsigned)dpp_x1i((int)v); v |= (unsigned)dpp_x2i((int)v); v = or_x16(v); v = or_x32(v); w[x] = v; }
    w[0] |= 1u;
#pragma unroll
    for (int x = 0; x < 4; ++x) { if (((cur - 1) >> 5) == x) w[x] |= 1u << ((cur - 1) & 31); if ((cur >> 5) == x) w[x] |= 1u << (cur & 31); }
}

__device__ __forceinline__ float dpp_r4(float x) { return __builtin_bit_cast(float, __builtin_amdgcn_update_dpp(0, __builtin_bit_cast(int, x), 0x124, 0xF, 0xF, true)); }
__device__ __forceinline__ float dpp_r8(float x) { return __builtin_bit_cast(float, __builtin_amdgcn_update_dpp(0, __builtin_bit_cast(int, x), 0x128, 0xF, 0xF, true)); }
__device__ __forceinline__ int dpp_r4i(int x) { return __builtin_amdgcn_update_dpp(0, x, 0x124, 0xF, 0xF, true); }
__device__ __forceinline__ int dpp_r8i(int x) { return __builtin_amdgcn_update_dpp(0, x, 0x128, 0xF, 0xF, true); }
__device__ __forceinline__ void select_blocks8(const LAS float* impw, LAS unsigned* mk, int lane, int cur, unsigned (&u)[2][4]) {
    const int i = lane & 15, k = lane >> 4;
    unsigned m4[2][4];
    if (cur < 16) {
#pragma unroll
        for (int c = 0; c < 2; ++c) { m4[c][0] = (2u << cur) - 1u; m4[c][1] = 0u; m4[c][2] = 0u; m4[c][3] = 0u; }
    } else {
        float cand[2][8]; unsigned chosen[2] = {0u, 0u};
#pragma unroll
        for (int c = 0; c < 2; ++c)
#pragma unroll
            for (int m = 0; m < 8; ++m) { const int j = i + 16 * m; const LAS float* p = impw + (4 * c + k) * 264; const float va = p[j], vb2 = p[132 + j];
                cand[c][m] = ((j >= 1) & (j <= cur - 2)) ? va + vb2 : -1.0f; }
        for (int it = 0; it < 13; ++it) {
#pragma unroll
            for (int c = 0; c < 2; ++c) {
                float bv = -2.0f; int bj = 1 << 20;
#pragma unroll
                for (int m = 0; m < 8; ++m) { const bool ok = !((chosen[c] >> m) & 1u) && cand[c][m] > bv; bv = ok ? cand[c][m] : bv; bj = ok ? i + 16 * m : bj; }
                best_pair(bv, bj, dpp_r8(bv), dpp_r8i(bj)); best_pair(bv, bj, dpp_r4(bv), dpp_r4i(bj)); best_pair(bv, bj, dpp_x2(bv), dpp_x2i(bj)); best_pair(bv, bj, dpp_x1(bv), dpp_x1i(bj));
                if ((bj & 15) == i) chosen[c] |= 1u << (bj >> 4);
            }
        }
        const int c1 = cur - 1;
        const unsigned long long flo = 1ull | (c1 < 64 ? 1ull << c1 : 0ull) | (cur < 64 ? 1ull << cur : 0ull), fhi = (c1 >= 64 ? 1ull << (c1 - 64) : 0ull) | (cur >= 64 ? 1ull << (cur - 64) : 0ull);
#pragma unroll
        for (int c = 0; c < 2; ++c) {
#pragma unroll
            for (int x = 0; x < 4; ++x) m4[c][x] = 0u;
#pragma unroll
            for (int m = 0; m < 8; ++m) m4[c][m >> 1] |= ((chosen[c] >> m) & 1u) << (i + 16 * (m & 1));
#pragma unroll
            for (int x = 0; x < 4; ++x) { unsigned v = m4[c][x]; v |= (unsigned)dpp_r8i((int)v); v |= (unsigned)dpp_r4i((int)v); v |= (unsigned)dpp_x2i((int)v); v |= (unsigned)dpp_x1i((int)v); m4[c][x] = v; }
            m4[c][0] |= (unsigned)flo; m4[c][1] |= (unsigned)(flo >> 32); m4[c][2] |= (unsigned)fhi; m4[c][3] |= (unsigned)(fhi >> 32);
        }
    }
#pragma unroll
    for (int c = 0; c < 2; ++c) {
        if (i == 0) *(LAS u32x4*)(mk + (4 * c + k) * 4) = (u32x4){m4[c][0], m4[c][1], m4[c][2], m4[c][3]};
#pragma unroll
        for (int x = 0; x < 4; ++x) { unsigned v = m4[c][x]; v = or_x16(v); v = or_x32(v); u[c][x] = __builtin_amdgcn_readfirstlane(v); }
    }
}

template <int MODE, bool SELMASK>
__device__ __forceinline__ void attn_block(const LAS unsigned char* kb, const LAS unsigned char* vb, const bf16x8 (&qf)[2][2], int col, int q, const int (&tq)[2], int key0, const LAS float* nbq, float bias_far,
                                           bool sel0, bool sel1, Softmax (&st)[2], f32x4 (&O)[2][4]) {
    const f32x4 z4 = (f32x4){0.f, 0.f, 0.f, 0.f};
    const float NEG = -__builtin_inff();
    f32x4 S[2][4];
#pragma unroll
    for (int kt = 0; kt < 4; ++kt) { const bf16x8 k0 = lds_frag(kb, 16 * kt + col, q), k1 = lds_frag(kb, 16 * kt + col, 4 + q);
#pragma unroll
        for (int c = 0; c < 2; ++c) { S[c][kt] = __builtin_amdgcn_mfma_f32_16x16x32_bf16(k0, qf[c][0], z4, 0, 0, 0); S[c][kt] = __builtin_amdgcn_mfma_f32_16x16x32_bf16(k1, qf[c][1], S[c][kt], 0, 0, 0); } }
    float rowb[2] = {bias_far, bias_far}, cm[2];
#pragma unroll
    for (int c = 0; c < 2; ++c) {
        const bool sel = c == 0 ? sel0 : sel1;
        if (MODE == 0) { if (SELMASK) rowb[c] = sel ? bias_far : NEG; }
        else if (MODE == 1) { rowb[c] = (SELMASK && !sel) ? NEG : 0.f;
            const LAS float* bp = nbq - (tq[c] - key0);
#pragma unroll
            for (int kt = 0; kt < 4; ++kt) S[c][kt] = S[c][kt] + *(const LAS f32x4*)(bp + 16 * kt); }
        else {
#pragma unroll
            for (int kt = 0; kt < 4; ++kt)
#pragma unroll
                for (int e = 0; e < 4; ++e) { const int d = tq[c] - (key0 + 16 * kt + 4 * q + e); S[c][kt][e] = d < 512 ? S[c][kt][e] : NEG; } }
        cm[c] = max16(S[c]) + rowb[c];
    }
    if (__any(cm[0] > st[0].m || cm[1] > st[1].m)) {
#pragma unroll
        for (int c = 0; c < 2; ++c) { float x = fmax_x16(cm[c]); x = fmax_x32(x);
            const float mn = fmaxf(st[c].m, x), alpha = ex2(st[c].m - mn);
            st[c].m = mn; st[c].l = st[c].l * alpha;
#pragma unroll
            for (int dt = 0; dt < 4; ++dt) O[c][dt] = O[c][dt] * alpha; }
    }
    bf16x8 pf[2][2];
#pragma unroll
    for (int c = 0; c < 2; ++c) {
        const float off = rowb[c] - st[c].m;
#pragma unroll
        for (int kt = 0; kt < 4; ++kt) { f32x4 p = S[c][kt] + off;
#pragma unroll
            for (int e = 0; e < 4; ++e) p[e] = ex2(p[e]);
            S[c][kt] = p; }
        pf[c][0] = pack8(S[c][0], S[c][1]); pf[c][1] = pack8(S[c][2], S[c][3]);
        st[c].l = __builtin_amdgcn_mfma_f32_16x16x32_bf16(ONES8, pf[c][0], st[c].l, 0, 0, 0); st[c].l = __builtin_amdgcn_mfma_f32_16x16x32_bf16(ONES8, pf[c][1], st[c].l, 0, 0, 0);
    }
#pragma unroll
    for (int c32 = 0; c32 < 2; ++c32)
#pragma unroll
        for (int dt = 0; dt < 4; ++dt) { const bf16x8 vf = lds_frag(vb, 16 * dt + col, 4 * c32 + q);
            O[0][dt] = __builtin_amdgcn_mfma_f32_16x16x32_bf16(vf, pf[0][c32], O[0][dt], 0, 0, 0);
            O[1][dt] = __builtin_amdgcn_mfma_f32_16x16x32_bf16(vf, pf[1][c32], O[1][dt], 0, 0, 0); }
}

template <int C>
__device__ __forceinline__ void attn_block_far1(const LAS unsigned char* kb, const LAS unsigned char* vb, const bf16x8 (&qf)[2][2], int col, int q, float bias_far, bool sel, Softmax (&st)[2], f32x4 (&O)[2][4]) {
    const f32x4 z4 = (f32x4){0.f, 0.f, 0.f, 0.f};
    const float NEG = -__builtin_inff();
    f32x4 S[4];
#pragma unroll
    for (int kt = 0; kt < 4; ++kt) { const bf16x8 k0 = lds_frag(kb, 16 * kt + col, q), k1 = lds_frag(kb, 16 * kt + col, 4 + q);
        S[kt] = __builtin_amdgcn_mfma_f32_16x16x32_bf16(k0, qf[C][0], z4, 0, 0, 0); S[kt] = __builtin_amdgcn_mfma_f32_16x16x32_bf16(k1, qf[C][1], S[kt], 0, 0, 0); }
    const float rowb = sel ? bias_far : NEG;
    float cm = max16(S) + rowb;
    if (__any(cm > st[C].m)) { float x = fmax_x16(cm); x = fmax_x32(x);
        const float mn = fmaxf(st[C].m, x), alpha = ex2(st[C].m - mn);
        st[C].m = mn; st[C].l = st[C].l * alpha;
#pragma unroll
        for (int dt = 0; dt < 4; ++dt) O[C][dt] = O[C][dt] * alpha; }
    const float off = rowb - st[C].m;
#pragma unroll
    for (int kt = 0; kt < 4; ++kt) { f32x4 p = S[kt] + off;
#pragma unroll
        for (int e = 0; e < 4; ++e) p[e] = ex2(p[e]);
        S[kt] = p; }
    const bf16x8 pf0 = pack8(S[0], S[1]), pf1 = pack8(S[2], S[3]);
    st[C].l = __builtin_amdgcn_mfma_f32_16x16x32_bf16(ONES8, pf0, st[C].l, 0, 0, 0); st[C].l = __builtin_amdgcn_mfma_f32_16x16x32_bf16(ONES8, pf1, st[C].l, 0, 0, 0);
#pragma unroll
    for (int dt = 0; dt < 4; ++dt) { const bf16x8 vf0 = lds_frag(vb, 16 * dt + col, q), vf1 = lds_frag(vb, 16 * dt + col, 4 + q);
        O[C][dt] = __builtin_amdgcn_mfma_f32_16x16x32_bf16(vf0, pf0, O[C][dt], 0, 0, 0); O[C][dt] = __builtin_amdgcn_mfma_f32_16x16x32_bf16(vf1, pf1, O[C][dt], 0, 0, 0); }
}

template <bool SELMASK>
__device__ __forceinline__ void attn_far_fast(const LAS unsigned char* kb, const LAS unsigned char* vb, const bf16x8 (&qf)[2][2], int col, int q, float bias_far, bool sel0, bool sel1, Softmax (&st)[2], f32x4 (&O)[2][4]) {
    const f32x4 z4 = (f32x4){0.f, 0.f, 0.f, 0.f};
    const float NEG = -__builtin_inff();
    f32x4 S[2][4];
#pragma unroll
    for (int kt = 0; kt < 4; ++kt) { const bf16x8 k0 = lds_frag(kb, 16 * kt + col, q), k1 = lds_frag(kb, 16 * kt + col, 4 + q);
#pragma unroll
        for (int c = 0; c < 2; ++c) { S[c][kt] = __builtin_amdgcn_mfma_f32_16x16x32_bf16(k0, qf[c][0], z4, 0, 0, 0); S[c][kt] = __builtin_amdgcn_mfma_f32_16x16x32_bf16(k1, qf[c][1], S[c][kt], 0, 0, 0); } }
    bf16x8 pf[2][2];
#pragma unroll
    for (int c = 0; c < 2; ++c) {
        const bool sel = c == 0 ? sel0 : sel1;
        const float off = ((SELMASK && !sel) ? NEG : bias_far) - st[c].m;
#pragma unroll
        for (int kt = 0; kt < 4; ++kt) { f32x4 p = S[c][kt] + off;
#pragma unroll
            for (int e = 0; e < 4; ++e) p[e] = ex2(p[e]);
            S[c][kt] = p; }
        pf[c][0] = pack8(S[c][0], S[c][1]); pf[c][1] = pack8(S[c][2], S[c][3]);
        st[c].l = __builtin_amdgcn_mfma_f32_16x16x32_bf16(ONES8, pf[c][0], st[c].l, 0, 0, 0); st[c].l = __builtin_amdgcn_mfma_f32_16x16x32_bf16(ONES8, pf[c][1], st[c].l, 0, 0, 0);
    }
#pragma unroll
    for (int c32 = 0; c32 < 2; ++c32)
#pragma unroll
        for (int dt = 0; dt < 4; ++dt) { const bf16x8 vf = lds_frag(vb, 16 * dt + col, 4 * c32 + q);
            O[0][dt] = __builtin_amdgcn_mfma_f32_16x16x32_bf16(vf, pf[0][c32], O[0][dt], 0, 0, 0);
            O[1][dt] = __builtin_amdgcn_mfma_f32_16x16x32_bf16(vf, pf[1][c32], O[1][dt], 0, 0, 0); }
}
template <int C>
__device__ __forceinline__ void attn_far1_fast(const LAS unsigned char* kb, const LAS unsigned char* vb, const bf16x8 (&qf)[2][2], int col, int q, float bias_far, bool sel, Softmax (&st)[2], f32x4 (&O)[2][4]) {
    const f32x4 z4 = (f32x4){0.f, 0.f, 0.f, 0.f};
    const float NEG = -__builtin_inff();
    f32x4 S[4];
#pragma unroll
    for (int kt = 0; kt < 4; ++kt) { const bf16x8 k0 = lds_frag(kb, 16 * kt + col, q), k1 = lds_frag(kb, 16 * kt + col, 4 + q);
        S[kt] = __builtin_amdgcn_mfma_f32_16x16x32_bf16(k0, qf[C][0], z4, 0, 0, 0); S[kt] = __builtin_amdgcn_mfma_f32_16x16x32_bf16(k1, qf[C][1], S[kt], 0, 0, 0); }
    const float off = (sel ? bias_far : NEG) - st[C].m;
#pragma unroll
    for (int kt = 0; kt < 4; ++kt) { f32x4 p = S[kt] + off;
#pragma unroll
        for (int e = 0; e < 4; ++e) p[e] = ex2(p[e]);
        S[kt] = p; }
    const bf16x8 pf0 = pack8(S[0], S[1]), pf1 = pack8(S[2], S[3]);
    st[C].l = __builtin_amdgcn_mfma_f32_16x16x32_bf16(ONES8, pf0, st[C].l, 0, 0, 0); st[C].l = __builtin_amdgcn_mfma_f32_16x16x32_bf16(ONES8, pf1, st[C].l, 0, 0, 0);
#pragma unroll
    for (int dt = 0; dt < 4; ++dt) { const bf16x8 vf0 = lds_frag(vb, 16 * dt + col, q), vf1 = lds_frag(vb, 16 * dt + col, 4 + q);
        O[C][dt] = __builtin_amdgcn_mfma_f32_16x16x32_bf16(vf0, pf0, O[C][dt], 0, 0, 0); O[C][dt] = __builtin_amdgcn_mfma_f32_16x16x32_bf16(vf1, pf1, O[C][dt], 0, 0, 0); }
}
__device__ __forceinline__ bool attn_overflowed(const Softmax (&st)[2], const f32x4 (&O)[2][4]) {
    float a = 0.f;
#pragma unroll
    for (int c = 0; c < 2; ++c) { a += fabsf(st[c].l[0]);
#pragma unroll
        for (int dt = 0; dt < 4; ++dt) a += (fabsf(O[c][dt][0]) + fabsf(O[c][dt][1])) + (fabsf(O[c][dt][2]) + fabsf(O[c][dt][3])); }
    return !(a < 1e37f);
}

__device__ __forceinline__ void nsa_unit(unsigned char* ws, LAS unsigned char* lds, const LAS float* lut, int b, int g, int tau, int tid_in) {
    int tid = tid_in; asm volatile("" : "+v"(tid));
    const int lane = tid & 63, wave = __builtin_amdgcn_readfirstlane(tid >> 6);
    const int col = lane & 15, q = lane >> 4, tl = col >> 2, r = col & 3, h = g * 4 + r, t0 = 64 * tau, cur = tau;
    const f32x4 z4 = (f32x4){0.f, 0.f, 0.f, 0.f};
    const float NEG = -__builtin_inff();
    int tq[2]; bf16x8 qf[2][2];
#pragma unroll
    for (int c = 0; c < 2; ++c) { tq[c] = t0 + 8 * wave + 4 * c + tl; const size_t qrow = (size_t)b * SEQ + tq[c];
        const bf16_t* Qp = (const bf16_t*)(ws + WS_Q) + qrow * 1024 + h * 64 + 8 * q; qf[c][0] = *(const bf16x8*)Qp; qf[c][1] = *(const bf16x8*)(Qp + 32); }
#define NSA_GATE(c, k) (((const float*)(ws + WS_GATES))[((size_t)b * SEQ + tq[c]) * 48 + h * 3 + (k)])
    const LAS float* lrow = lut + h * 132;
    const float bias_far = lrow[128];
    const int dl = (4 - tl) & 3;
    const LAS float* nbq = (const LAS float*)(lds + NB_OFF) + (r * 4 + dl) * 264 + 196 - dl + 4 * q;
    LAS f32x4* resw = (LAS f32x4*)(lds + NSA_RES + wave * 8192) + lane;
    f32x4 Oc[2][4];
#pragma unroll
    for (int c = 0; c < 2; ++c)
#pragma unroll
        for (int dt = 0; dt < 4; ++dt) Oc[c][dt] = z4;
    LAS float* impw = (LAS float*)(lds + NSA_IMP) + wave * 2112;
    volatile LAS unsigned* ovf = (volatile LAS unsigned*)(lds + MISC_OFF) + 20;
    if (tid == 0) { ovf[0] = 0u; ovf[1] = 0u; }
    Stage stg;
    const int nvmax = (t0 + 63 >= 31) ? ((t0 + 63 - 31) >> 4) + 1 : 0;
    const int ncb = (nvmax + 63) >> 6;
    int nv[2];
#pragma unroll
    for (int c = 0; c < 2; ++c) nv[c] = tq[c] >= 31 ? ((tq[c] - 31) >> 4) + 1 : 0;
    const unsigned char* kcg = ws + WS_KC + ((size_t)(b * 512) * 4 + g) * 128;
    const unsigned char* vcg = ws + WS_VCT + ((size_t)((b * 4 + g) * 64)) * NCMP_PAD * 2;
    float M[2] = {-1e30f, -1e30f}, L[2] = {0.f, 0.f};
    if (ncb > 0) {
        const int nfar = (t0 - 159 >= 0) ? (((t0 - 159) >> 4) + 1) >> 6 : 0;
        stage_load(stg, kcg, 512, nullptr, 0, tid, false); stage_store(stg, lds, 0, tid, false); __syncthreads();
        for (int i = 0; i < ncb; ++i) {
            if (i + 1 < ncb) stage_load(stg, kcg + (size_t)(i + 1) * 64 * 512, 512, nullptr, 0, tid, false);
            else stage_load(stg, kcg, 512, vcg, NCMP_PAD * 2, tid, true);
            const LAS unsigned char* kb = lds + NSA_KB + (i & 1) * 8192;
            f32x4 S[2][4];
#pragma unroll
            for (int kt = 0; kt < 4; ++kt) { const bf16x8 kf0 = lds_frag(kb, 16 * kt + col, q), kf1 = lds_frag(kb, 16 * kt + col, 4 + q);
#pragma unroll
                for (int c = 0; c < 2; ++c) { S[c][kt] = __builtin_amdgcn_mfma_f32_16x16x32_bf16(kf0, qf[c][0], z4, 0, 0, 0); S[c][kt] = __builtin_amdgcn_mfma_f32_16x16x32_bf16(kf1, qf[c][1], S[c][kt], 0, 0, 0); } }
#pragma unroll
            for (int c = 0; c < 2; ++c) {
                float rowb = bias_far;
                if (i >= nfar) { rowb = 0.f;
                    const int tqlo = t0 + 8 * wave + 4 * c, tqhi = tqlo + 3;
#pragma unroll
                    for (int kt = 0; kt < 4; ++kt) { const int nlo = 64 * i + 16 * kt;
                        if (16 * (nlo + 15) + 31 + 128 <= tqlo) S[c][kt] = S[c][kt] + bias_far;
                        else if (16 * nlo + 31 > tqhi) S[c][kt] = (f32x4){NEG, NEG, NEG, NEG};
                        else {
#pragma unroll
                            for (int e = 0; e < 4; ++e) { const int n = nlo + 4 * q + e; int dist = tq[c] - (16 * n + 31); dist = dist < 0 ? 0 : (dist > 128 ? 128 : dist);
                                const float bv = lrow[dist]; const float sv = S[c][kt][e] + bv; S[c][kt][e] = n < nv[c] ? sv : NEG; } } } }
                const float tm = fmaxf(fmaxf(fmaxf(fmaxf(S[c][0][0], S[c][0][1]), fmaxf(S[c][0][2], S[c][0][3])), fmaxf(fmaxf(S[c][1][0], S[c][1][1]), fmaxf(S[c][1][2], S[c][1][3]))),
                                       fmaxf(fmaxf(fmaxf(S[c][2][0], S[c][2][1]), fmaxf(S[c][2][2], S[c][2][3])), fmaxf(fmaxf(S[c][3][0], S[c][3][1]), fmaxf(S[c][3][2], S[c][3][3])))) + rowb;
                const float mn = fmaxf(M[c], tm); L[c] *= ex2(M[c] - mn); M[c] = mn;
                const float off = rowb - mn; float sum = 0.f;
#pragma unroll
                for (int kt = 0; kt < 4; ++kt)
#pragma unroll
                    for (int e = 0; e < 4; ++e) sum += ex2(S[c][kt][e] + off);
                L[c] += sum;
            }
            if (i + 1 < ncb) stage_store(stg, lds, (i + 1) & 1, tid, false);
            __syncthreads();
        }
#pragma unroll
        for (int c = 0; c < 2; ++c) { float mo = fmax_x16(M[c]); mo = fmax_x32(mo); L[c] *= ex2(M[c] - mo); M[c] = mo; L[c] = fadd_x16(L[c]); L[c] = fadd_x32(L[c]); }
        float offN[2];
#pragma unroll
        for (int c = 0; c < 2; ++c) offN[c] = -M[c] - __builtin_amdgcn_logf(fmaxf(L[c], 1e-30f));
        f32x4 (&O)[2][4] = Oc;
        stage_store(stg, lds, 0, tid, true); __syncthreads();
        for (int i = 0; i < ncb; ++i) {
            if (i + 1 < ncb) stage_load(stg, kcg + (size_t)(i + 1) * 64 * 512, 512, vcg + (size_t)(i + 1) * 128, NCMP_PAD * 2, tid, true);
            const LAS unsigned char* kb = lds + NSA_KB + (i & 1) * 8192; const LAS unsigned char* vb = lds + NSA_VB + (i & 1) * 8192;
            f32x4 S[2][4];
#pragma unroll
            for (int kt = 0; kt < 4; ++kt) { const bf16x8 kf0 = lds_frag(kb, 16 * kt + col, q), kf1 = lds_frag(kb, 16 * kt + col, 4 + q);
#pragma unroll
                for (int c = 0; c < 2; ++c) { S[c][kt] = __builtin_amdgcn_mfma_f32_16x16x32_bf16(kf0, qf[c][0], z4, 0, 0, 0); S[c][kt] = __builtin_amdgcn_mfma_f32_16x16x32_bf16(kf1, qf[c][1], S[c][kt], 0, 0, 0); } }
#pragma unroll
            for (int c = 0; c < 2; ++c) {
                if (i >= nfar) {
                    const int tqlo = t0 + 8 * wave + 4 * c, tqhi = tqlo + 3; const float offF = bias_far + offN[c];
#pragma unroll
                    for (int kt = 0; kt < 4; ++kt) { const int nlo = 64 * i + 16 * kt;
                        if (16 * (nlo + 15) + 31 + 128 <= tqlo) {
#pragma unroll
                            for (int e = 0; e < 4; ++e) S[c][kt][e] = ex2(S[c][kt][e] + offF); }
                        else if (16 * nlo + 31 > tqhi) S[c][kt] = (f32x4){0.f, 0.f, 0.f, 0.f};
                        else {
#pragma unroll
                            for (int e = 0; e < 4; ++e) { const int n = nlo + 4 * q + e; int dist = tq[c] - (16 * n + 31); dist = dist < 0 ? 0 : (dist > 128 ? 128 : dist);
                                const float bv = lrow[dist]; const float pv = ex2(S[c][kt][e] + bv + offN[c]); S[c][kt][e] = n < nv[c] ? pv : 0.f; } } }
                } else { const float off = bias_far + offN[c];
#pragma unroll
                    for (int kt = 0; kt < 4; ++kt)
#pragma unroll
                        for (int e = 0; e < 4; ++e) S[c][kt][e] = ex2(S[c][kt][e] + off); }
#pragma unroll
                for (int kt = 0; kt < 4; ++kt) { float sA = (S[c][kt][0] + S[c][kt][1]) + (S[c][kt][2] + S[c][kt][3]), c3 = S[c][kt][3];
                    sA += dpp_x1(sA); sA += dpp_x2(sA); c3 += dpp_x1(c3); c3 += dpp_x2(c3);
                    if (r == 0) { const int jb = 4 * (4 * i + kt) + q; impw[(4 * c + tl) * 264 + jb] = sA; impw[(4 * c + tl) * 264 + 132 + jb + 1] = c3; } }
            }
            const bf16x8 pf00 = pack8(S[0][0], S[0][1]), pf01 = pack8(S[0][2], S[0][3]), pf10 = pack8(S[1][0], S[1][1]), pf11 = pack8(S[1][2], S[1][3]);
#pragma unroll
            for (int dt = 0; dt < 4; ++dt) { const bf16x8 vf0 = lds_frag(vb, 16 * dt + col, q), vf1 = lds_frag(vb, 16 * dt + col, 4 + q);
                O[0][dt] = __builtin_amdgcn_mfma_f32_16x16x32_bf16(vf0, pf00, O[0][dt], 0, 0, 0); O[1][dt] = __builtin_amdgcn_mfma_f32_16x16x32_bf16(vf0, pf10, O[1][dt], 0, 0, 0);
                O[0][dt] = __builtin_amdgcn_mfma_f32_16x16x32_bf16(vf1, pf01, O[0][dt], 0, 0, 0); O[1][dt] = __builtin_amdgcn_mfma_f32_16x16x32_bf16(vf1, pf11, O[1][dt], 0, 0, 0); }
            if (i + 1 < ncb) stage_store(stg, lds, (i + 1) & 1, tid, true);
            __syncthreads();
        }
    }
    unsigned u[2][4];
    Stage stg2;
    const unsigned char* kg_s = ws + WS_KS + ((size_t)b * SEQ * 256 + g * 64) * 2;
    const unsigned char* vg_s = ws + WS_VST + ((size_t)((b * 4 + g) * 64)) * SEQ * 2;
    stage_load(stg, kg_s, 512, vg_s, SEQ * 2, tid, true);
    if (1 <= cur) stage_load(stg2, kg_s + (size_t)64 * 512, 512, vg_s + 128, SEQ * 2, tid, true);
    asm volatile("s_waitcnt lgkmcnt(0)" ::: "memory");
    LAS unsigned* selw = (LAS unsigned*)(lds + TILES_OFF) + wave * 32;
    select_blocks8(impw, selw, lane, cur, u);
    __syncthreads();
#pragma unroll
    for (int c = 0; c < 2; ++c) { const float gc = NSA_GATE(c, 0);
#pragma unroll
        for (int dt = 0; dt < 4; ++dt) resw[(c * 4 + dt) * 64] = Oc[c][dt] * gc; }
    {
        f32x4 O[2][4]; Softmax st[2];
#pragma unroll
        for (int c = 0; c < 2; ++c) { st[c].m = -1e30f; st[c].l = z4;
#pragma unroll
            for (int dt = 0; dt < 4; ++dt) O[c][dt] = z4; }
        const unsigned char* kg = kg_s; const unsigned char* vg = vg_s;
        const unsigned char* kgw = ws + WS_KW + ((size_t)b * SEQ * 256 + g * 64) * 2;
        const unsigned char* vgw = ws + WS_VWT + ((size_t)((b * 4 + g) * 64)) * SEQ * 2;
        const int jlo_w = cur >= 8 ? cur - 8 : 0;
#define SLC_LOAD(ST, J) stage_load(ST, kg + (size_t)(J) * 64 * 512, 512, vg + (size_t)(J) * 128, SEQ * 2, tid, true)
#define SLC_STEP(SAFE, J, BUF) do { const int j_ = (J); \
            const unsigned uw0 = (j_ >> 5) == 0 ? u[0][0] : (j_ >> 5) == 1 ? u[0][1] : (j_ >> 5) == 2 ? u[0][2] : u[0][3]; \
            const unsigned uw1 = (j_ >> 5) == 0 ? u[1][0] : (j_ >> 5) == 1 ? u[1][1] : (j_ >> 5) == 2 ? u[1][2] : u[1][3]; \
            if (((uw0 | uw1) >> (j_ & 31)) & 1u) { \
                const bool sel0 = (cw0 >> (j_ & 31)) & 1u, sel1 = (cw1 >> (j_ & 31)) & 1u; \
                const LAS unsigned char* kb = lds + NSA_KB + (BUF) * 8192; const LAS unsigned char* vb = lds + NSA_VB + (BUF) * 8192; \
                if (j_ + 3 > cur) attn_block<1, true>(kb, vb, qf, col, q, tq, 64 * j_, nbq, bias_far, sel0, sel1, st, O); \
                else { const bool d0_ = (uw0 >> (j_ & 31)) & 1u, d1_ = (uw1 >> (j_ & 31)) & 1u; \
                    if (SAFE) { \
                        if (d0_ && d1_) attn_block<0, true>(kb, vb, qf, col, q, tq, 64 * j_, nbq, bias_far, sel0, sel1, st, O); \
                        else if (d0_) attn_block_far1<0>(kb, vb, qf, col, q, bias_far, sel0, st, O); \
                        else attn_block_far1<1>(kb, vb, qf, col, q, bias_far, sel1, st, O); \
                    } else if (j_ == 0) attn_block<0, true>(kb, vb, qf, col, q, tq, 0, nbq, bias_far, sel0, sel1, st, O); \
                    else if (d0_ && d1_) attn_far_fast<true>(kb, vb, qf, col, q, bias_far, sel0, sel1, st, O); \
                    else if (d0_) attn_far1_fast<0>(kb, vb, qf, col, q, bias_far, sel0, st, O); \
                    else attn_far1_fast<1>(kb, vb, qf, col, q, bias_far, sel1, st, O); } } } while (0)
#define SLC_LOOP(SAFE) do { \
        if (SAFE) { SLC_LOAD(stg, 0); if (1 <= cur) SLC_LOAD(stg2, 1); } \
        stage_store(stg, lds, 0, tid, true); if (1 <= cur) stage_store(stg2, lds, 1, tid, true); __syncthreads(); \
        unsigned cw0 = 0u, cw1 = 0u; \
        for (int j = 0; j <= cur; j += 2) { \
            if ((j & 31) == 0) { cw0 = selw[tl * 4 + (j >> 5)]; cw1 = selw[16 + tl * 4 + (j >> 5)]; } \
            if (j + 2 <= cur) SLC_LOAD(stg, j + 2); \
            else stage_load(stg, kgw + (size_t)jlo_w * 64 * 512, 512, vgw + (size_t)jlo_w * 128, SEQ * 2, tid, true);     \
            if (j + 3 <= cur) SLC_LOAD(stg2, j + 3); \
            SLC_STEP(SAFE, j, j & 3); \
            if (j + 1 <= cur) SLC_STEP(SAFE, j + 1, (j + 1) & 3); \
            if (j + 2 <= cur) stage_store(stg, lds, (j + 2) & 3, tid, true); \
            if (j + 3 <= cur) stage_store(stg2, lds, (j + 3) & 3, tid, true); \
            __syncthreads(); \
        } } while (0)
        SLC_LOOP(false);
        if (__any(attn_overflowed(st, O))) ovf[0] = 1u;
        __syncthreads();
        if (ovf[0] != 0u) {
#pragma unroll
            for (int c = 0; c < 2; ++c) { st[c].m = -1e30f; st[c].l = z4;
#pragma unroll
                for (int dt = 0; dt < 4; ++dt) O[c][dt] = z4; }
            SLC_LOOP(true);
        }
#undef SLC_LOOP
#undef SLC_LOAD
#undef SLC_STEP
#pragma unroll
        for (int c = 0; c < 2; ++c) { const float sc = NSA_GATE(c, 1) / fmaxf(st[c].l[0], 1e-30f);
#pragma unroll
            for (int dt = 0; dt < 4; ++dt) resw[(c * 4 + dt) * 64] = resw[(c * 4 + dt) * 64] + O[c][dt] * sc; }
    }
    {
        f32x4 O[2][4]; Softmax st[2];
#pragma unroll
        for (int c = 0; c < 2; ++c) { st[c].m = -1e30f; st[c].l = z4;
#pragma unroll
            for (int dt = 0; dt < 4; ++dt) O[c][dt] = z4; }
        const unsigned char* kg = ws + WS_KW + ((size_t)b * SEQ * 256 + g * 64) * 2;
        const unsigned char* vg = ws + WS_VWT + ((size_t)((b * 4 + g) * 64)) * SEQ * 2;
        const int jlo = cur >= 8 ? cur - 8 : 0;
#define WIN_LOOP(SAFE) do { \
        if (SAFE) stage_load(stg, kg + (size_t)jlo * 64 * 512, 512, vg + (size_t)jlo * 128, SEQ * 2, tid, true); \
        stage_store(stg, lds, 0, tid, true); __syncthreads(); \
        for (int j = jlo; j <= cur; ++j) { \
            const int bi = (j - jlo) & 1; \
            if (j + 1 <= cur) stage_load(stg, kg + (size_t)(j + 1) * 64 * 512, 512, vg + (size_t)(j + 1) * 128, SEQ * 2, tid, true); \
            const LAS unsigned char* kb = lds + NSA_KB + bi * 8192; const LAS unsigned char* vb = lds + NSA_VB + bi * 8192; \
            if (j + 3 > cur) attn_block<1, false>(kb, vb, qf, col, q, tq, 64 * j, nbq, bias_far, true, true, st, O); \
            else if (j + 8 == cur) attn_block<2, false>(kb, vb, qf, col, q, tq, 64 * j, nbq, bias_far, true, true, st, O); \
            else if ((SAFE) || j < jlo + 2) attn_block<0, false>(kb, vb, qf, col, q, tq, 64 * j, nbq, bias_far, true, true, st, O); \
            else attn_far_fast<false>(kb, vb, qf, col, q, bias_far, true, true, st, O); \
            if (j + 1 <= cur) stage_store(stg, lds, bi ^ 1, tid, true); \
            __syncthreads(); \
        } } while (0)
        WIN_LOOP(false);
        if (__any(attn_overflowed(st, O))) ovf[1] = 1u;
        __syncthreads();
        if (ovf[1] != 0u) {
#pragma unroll
            for (int c = 0; c < 2; ++c) { st[c].m = -1e30f; st[c].l = z4;
#pragma unroll
                for (int dt = 0; dt < 4; ++dt) O[c][dt] = z4; }
            WIN_LOOP(true);
        }
#undef WIN_LOOP
#pragma unroll
        for (int c = 0; c < 2; ++c) { const float sc = NSA_GATE(c, 2) / fmaxf(st[c].l[0], 1e-30f);
            bf16_t* yo = (bf16_t*)(ws + WS_YNSA) + ((size_t)b * SEQ + tq[c]) * 1024 + h * 64 + 4 * q;
#pragma unroll
            for (int dt = 0; dt < 4; ++dt) { const f32x4 rv = resw[(c * 4 + dt) * 64] + O[c][dt] * sc; u32x2 o; o.x = pk2(rv[0], rv[1]); o.y = pk2(rv[2], rv[3]); *(u32x2*)(yo + 16 * dt) = o; } }
    }
}

__device__ __forceinline__ float dpp_ror4(float x) { return __builtin_bit_cast(float, __builtin_amdgcn_update_dpp(0, __builtin_bit_cast(int, x), 0x124, 0xF, 0xF, true)); }
__device__ __forceinline__ float dpp_ror8(float x) { return __builtin_bit_cast(float, __builtin_amdgcn_update_dpp(0, __builtin_bit_cast(int, x), 0x128, 0xF, 0xF, true)); }
__device__ __forceinline__ int dpp_ror4i(int x) { return __builtin_amdgcn_update_dpp(0, x, 0x124, 0xF, 0xF, true); }
__device__ __forceinline__ int dpp_ror8i(int x) { return __builtin_amdgcn_update_dpp(0, x, 0x128, 0xF, 0xF, true); }
__device__ __forceinline__ void route_token(const In& in, unsigned char* ws, LAS unsigned* hist, LAS unsigned* eloc, LAS unsigned* sloc, int tok, int tloc, int lane) {
    const f32x4 lg = *((const f32x4*)((const float*)(ws + WS_LOGIT) + (size_t)tok * 256) + lane);
    const f32x4 rb = *((const f32x4*)in.router_bias + lane);
    float s[4], v[4];
#pragma unroll
    for (int i = 0; i < 4; ++i) { s[i] = sigmoidf_(lg[i]); v[i] = s[i] + rb[i]; }
    unsigned taken = 0u; float my_s = 0.f; int my_e = 0;
    for (int k = 0; k < TOPK; ++k) {
        float bv = -__builtin_inff(); int bi = 1 << 20;
#pragma unroll
        for (int i = 0; i < 4; ++i) { const bool ok = !((taken >> i) & 1u) && v[i] > bv; bv = ok ? v[i] : bv; bi = ok ? 4 * lane + i : bi; }
        best_pair(bv, bi, dpp_ror8(bv), dpp_ror8i(bi)); best_pair(bv, bi, dpp_ror4(bv), dpp_ror4i(bi)); best_pair(bv, bi, dpp_x2(bv), dpp_x2i(bi)); best_pair(bv, bi, dpp_x1(bv), dpp_x1i(bi));
        { const float ov = __shfl_xor(bv, 16); const int oi = __shfl_xor(bi, 16); best_pair(bv, bi, ov, oi); }
        { const float ov = __shfl_xor(bv, 32); const int oi = __shfl_xor(bi, 32); best_pair(bv, bi, ov, oi); }
        const bool mine = (bi >> 2) == lane;
        if (mine) taken |= 1u << (bi & 3);
        const float sw = (bi & 3) == 0 ? s[0] : (bi & 3) == 1 ? s[1] : (bi & 3) == 2 ? s[2] : s[3];
        const float bs = __shfl(sw, bi >> 2);
        if (lane == k) { my_s = bs; my_e = bi; }
    }
    float sum = lane < TOPK ? my_s : 0.f;
    sum += dpp_x1(sum); sum += dpp_x2(sum); sum += dpp_ror4(sum); sum += dpp_ror8(sum);
    if (lane < TOPK) {
        const unsigned slot = __hip_atomic_fetch_add(hist + my_e, 1u, __ATOMIC_RELAXED, __HIP_MEMORY_SCOPE_WORKGROUP);
        eloc[tloc * 8 + lane] = (unsigned)my_e; sloc[tloc * 8 + lane] = slot;
        ((int*)(ws + WS_ASGE))[tok * 8 + lane] = my_e; ((float*)(ws + WS_ASGW))[tok * 8 + lane] = my_s / sum * 2.5f;
    }
}

#ifndef DBG_MODE
#define DBG_MODE 0
#endif
struct Args { In in; float* out; unsigned char* ws; int ph_lo, ph_hi; };
static_assert(sizeof(Args) == 31 * 8 + 8 + 8 + 8, "Args has no padding");

#define CAS __attribute__((address_space(4)))
struct PhaseArgs { In in; float* out; unsigned char* ws; };
__device__ __forceinline__ PhaseArgs load_args() {
    const CAS unsigned char* kp = (const CAS unsigned char*)__builtin_amdgcn_kernarg_segment_ptr(); asm volatile("" : "+s"(kp));
    const float* const CAS* pp = (const float* const CAS*)kp; PhaseArgs r; const float** rp = (const float**)&r.in;
#pragma unroll
    for (int i = 0; i < 31; ++i) rp[i] = pp[i];
    r.out = (float*)pp[31]; r.ws = (unsigned char*)pp[32]; return r;
}
#define PHASE_ARGS() const PhaseArgs pa_ = load_args(); const In& in = pa_.in; float* const out = pa_.out; unsigned char* const ws = pa_.ws; (void)in; (void)out; (void)ws
__global__ void __launch_bounds__(NTHREADS, 2) fwd_kernel(Args args) {
    extern __shared__ __attribute__((aligned(16))) unsigned char lds_raw[];
    LAS unsigned char* lds = (LAS unsigned char*)lds_raw;
    volatile LAS unsigned* MISC = (volatile LAS unsigned*)(lds + MISC_OFF);
    const int tid = threadIdx.x, lane = tid & 63, wave = __builtin_amdgcn_readfirstlane(tid >> 6);
    const int G = gridDim.x, gw = (int)blockIdx.x * NWAVES + wave, NGW = G * NWAVES;
    unsigned* ctl = (unsigned*)(args.ws + WS_CTL);
    for (int u = tid; u < 256; u += NTHREADS) ((LAS unsigned*)(lds + MISC_OFF))[u] = 0u;
    __syncthreads();
    XcdBarrier bar = xcd_barrier_post(ctl + CW_BAR, MISC + 8);
    const int lo = args.ph_lo, hi = args.ph_hi;
#define IN(k) (lo <= (k) && (k) < hi)
#define SEAM(k) do { if (IN(k) && IN((k) + 1)) xcd_barrier(bar); } while (0)
    LAS float* lut = (LAS float*)(lds + LUT_OFF);
    LAS int* tstart = (LAS int*)(lds + TILES_OFF);

    if (IN(0)) {
        PHASE_ARGS();
        p0_mod(in, ws, lds, tid);
        p0_tables(in, ws, lds, tid);
        if (blockIdx.x >= 64) p0_small_weights(in, ws, (LAS float*)(lds + wave * 8448), gw - 64 * NWAVES, NGW - 64 * NWAVES, lane);
    }
    SEAM(0);
    if (IN(1)) { PHASE_ARGS();
        if (blockIdx.x == 0) {
            const float* part = (const float*)(ws + WS_CTL + 131072);
            const int ts = tid >> 8, c = tid & 255; float sb = 0.f;
            for (int pz = 0; pz < 16; ++pz) sb += part[(ts * 16 + pz) * 256 + c];
            ((float*)(ws + WS_CTL + 65536))[ts * 256 + c] = sb; }
        ph_h1(in, ws, gw, NGW, lane); }
    SEAM(1);
    if (IN(2)) {
        PHASE_ARGS();
        SchedDense S = make_dense((const char*)ws, WS_H1, 2048, (const char*)(ws + WS_WIN), MTOK, NPROJ, 1024);
        EpiProj E{ws};
        pg8::gemm_phase<EpiProj, SchedDense>(lds, S, E);
    }
    SEAM(2);
    if (IN(3)) {
        PHASE_ARGS();
        { SchedCmp1 S; S.abase = (const char*)ws; S.a_kstep = 512; S.K = 2048; S.Bt = (const char*)(ws + WS_CW1); S.ord.init(64, 2, G, (int)blockIdx.x);
          EpiCmp1 E{ws}; pg8::gemm_phase<EpiCmp1, SchedCmp1>(lds, S, E); }
        __syncthreads();
        s5_task<false>(in, ws, lds + wave * S5_LDS_PER_WAVE, gw >> 8, (gw >> 3) & 31, gw & 7, lane);
    }
    SEAM(3);
    if (IN(4)) {
        PHASE_ARGS();
        { SchedCmp2 S; S.abase = (const char*)ws; S.a_kstep = 128; S.K = 256; S.Bt = (const char*)(ws + WS_CW2); S.ord.init(64, 2, G, (int)blockIdx.x);
          EpiCmp2 E{ws}; pg8::gemm_phase<EpiCmp2, SchedCmp2>(lds, S, E); }
        __syncthreads();
        s5_task<true>(in, ws, lds + wave * S5_LDS_PER_WAVE, gw >> 8, (gw >> 3) & 31, gw & 7, lane);
    }
    SEAM(4);
    if (IN(5)) {
        PHASE_ARGS();
        for (int i = tid; i < 16 * 132; i += NTHREADS) lut[i] = ((const float*)(ws + WS_TAB + TAB_LUT))[i];
        __syncthreads();
        if ((tid >> 6) >= 4) __builtin_amdgcn_s_setprio(2);
        for (int i = 0; i < 16; ++i) { const int bg = 8 * (i >> 2) + ((int)blockIdx.x & 7), wi = (int)blockIdx.x >> 3, k = i & 3;
            const int tau = k == 0 ? wi : k == 1 ? 63 - wi : k == 2 ? 64 + wi : 127 - wi;
            if (k == 0) {
                __syncthreads();
                LAS float* nbt = (LAS float*)(lds + NB_OFF);
                for (int x = tid; x < 16 * 264; x += NTHREADS) { const int rr = x / 1056, sh = (x / 264) & 3, z = x % 264, d = 196 - z - sh;
                    nbt[x] = d < 0 ? -__builtin_inff() : lut[((bg & 3) * 4 + rr) * 132 + (d > 128 ? 128 : d)]; }
                __syncthreads();
            }
            nsa_unit(ws, lds, lut, bg >> 2, bg & 3, tau, tid); }
        __builtin_amdgcn_s_setprio(0);
    }
    SEAM(5);
    if (IN(6)) {
        PHASE_ARGS();
        SchedDense S = make_dense((const char*)ws, WS_Z, 1024, (const char*)(ws + WS_GLU), MTOK, 2048, 512);
        EpiGlu E{ws}; pg8::gemm_phase<EpiGlu, SchedDense>(lds, S, E);
    }
    SEAM(6);
    if (IN(7)) {
        PHASE_ARGS();
        SchedDense S = make_dense((const char*)ws, WS_MERGED, 2048, (const char*)(ws + WS_WOUT), MTOK, 1024, 1024);
        EpiWout E{in.x, out, (const float*)(ws + WS_MOD) + 2048};
        static_assert(WS_WD >= WS_KS && WS_WD + 128 * MiB <= WS_MG + 256 * MiB && WS_WGU + 63 * MiB <= WS_Q && WS_WGU + 191 * MiB >= WS_Q + 128 * MiB, "early conversion targets must not overlap MERGED (live in this phase)");
        if (blockIdx.x & 1) { convert_expert_weights(in, ws, (LAS float*)(lds + wave * 8448), gw, NGW, lane, 0); __syncthreads(); }
        pg8::gemm_phase<EpiWout, SchedDense>(lds, S, E);
        if (!(blockIdx.x & 1)) { __syncthreads(); convert_expert_weights(in, ws, (LAS float*)(lds + wave * 8448), gw, NGW, lane, 0); }
    }
    SEAM(7);
    if (IN(8)) {
        PHASE_ARGS();
        ph_ln1(in, ws, out, gw, NGW, lane);
        for (int i = gw * 64 + lane; i < 128; i += NGW * 64) ((u32x4*)((bf16_t*)(ws + WS_H2) + (size_t)MTOK * DM))[i] = (u32x4){0u, 0u, 0u, 0u};
        for (int i = gw * 64 + lane; i < NCHUNK * CHUNK_ROWS; i += NGW * 64) { ((int*)(ws + WS_ROWASG))[i] = -1; ((float*)(ws + WS_ROWW))[i] = 0.f; }
        convert_expert_weights(in, ws, (LAS float*)(lds + wave * 8448), gw, NGW, lane, 1);
    }
    SEAM(8);
    if (IN(9)) {
        PHASE_ARGS();
        { SchedDense S = make_dense((const char*)ws, WS_H2, 2048, (const char*)(ws + WS_ROUT), MTOK, 256, 1024);
          EpiF32 E{(float*)(ws + WS_LOGIT), 256}; pg8::gemm_phase<EpiF32, SchedDense>(lds, S, E); }
        { SchedDense S = make_dense((const char*)ws, WS_H2, 2048, (const char*)(ws + WS_SHGU), MTOK, 512, 1024);
          EpiSwiglu E{(bf16_t*)(ws + WS_HSH)}; pg8::gemm_phase<EpiSwiglu, SchedDense>(lds, S, E); }
    }
    SEAM(9);
    if (IN(10)) {
        PHASE_ARGS();
        {
            LAS unsigned* hist = (LAS unsigned*)lds; LAS unsigned* gbase = hist + 256; LAS unsigned* eloc = hist + 512; LAS unsigned* sloc = hist + 2560;
            const int tok0 = (int)blockIdx.x * 256;
            if (tid < 256) hist[tid] = 0u;
            __syncthreads();
            for (int k = 0; k < 32; ++k) route_token(in, ws, hist, eloc, sloc, tok0 + wave * 32 + k, wave * 32 + k, lane);
            __syncthreads();
            if (tid < 256) { const unsigned h = hist[tid]; gbase[tid] = h ? __hip_atomic_fetch_add(ctl + CW_CNT + chunk_of_tok(tok0) * 256 + tid, h, RLX_AGENT) : 0u; }
            __syncthreads();
            for (int i = tid; i < 2048; i += NTHREADS) ((int*)(ws + WS_ASGS))[tok0 * 8 + i] = (int)(sloc[i] + gbase[eloc[i]]);
            __syncthreads();
        }
        SchedDense S = make_dense((const char*)ws, WS_HSH, 512, (const char*)(ws + WS_SHD), MTOK, 1024, 256);
        EpiShDown E{(unsigned char*)(ws + WS_SHOUT)}; pg8::gemm_phase<EpiShDown, SchedDense>(lds, S, E);
    }
    SEAM(10);
    if (IN(11) || IN(12)) {
        for (int i = tid; i < NCHUNK * 256; i += NTHREADS) { const unsigned c = __hip_atomic_load(ctl + CW_CNT + i, RLX_AGENT); tstart[(i >> 8) * 260 + (i & 255) + 1] = (int)((c + 255u) >> 8); }
        if (tid < NCHUNK) tstart[tid * 260] = 0;
        __syncthreads();
        if (tid < NCHUNK) { int sacc = 0; for (int e = 1; e <= 256; ++e) { sacc += tstart[tid * 260 + e]; tstart[tid * 260 + e] = sacc; } }
        __syncthreads();
    }
    if (IN(11)) {
        PHASE_ARGS();
        for (int a = gw * 64 + lane; a < MTOK * TOPK; a += NGW * 64) { const int e = ((const int*)(ws + WS_ASGE))[a], ch = chunk_of_tok(a >> 3); const int pos = ch * CHUNK_ROWS + 256 * tstart[ch * 260 + e] + ((const int*)(ws + WS_ASGS))[a];
            ((int*)(ws + WS_ROWASG))[pos] = a; ((float*)(ws + WS_ROWW))[pos] = ((const float*)(ws + WS_ASGW))[a]; }
    }
    SEAM(11);
    if (IN(12)) {
        PHASE_ARGS();
        for (int ch = 0; ch < NCHUNK; ++ch) {
            { SchedMoeGU S; S.abase = (const char*)ws; S.a_kstep = 128; S.K = 1024; S.tstart = tstart + ch * 260; S.rowasg = (const int*)(ws + WS_ROWASG) + ch * CHUNK_ROWS; S.W = (const char*)(ws + WS_WGU); S.G = G; S.c = (int)blockIdx.x;
              EpiSwiglu E{(bf16_t*)(ws + WS_HID)}; pg8::gemm_phase<EpiSwiglu, SchedMoeGU>(lds, S, E); }
            if (ch > 0) final_chunk(in, ws, out, ctl + CW_FCTR + 64 * (ch - 1), ch - 1, MISC + 16, tid, wave, lane);
            xcd_barrier(bar);
            { SchedMoeD S; S.abase = (const char*)ws; S.a_kstep = 128; S.K = 256; S.tstart = tstart + ch * 260; S.W = (const char*)(ws + WS_WD); S.G = G; S.c = (int)blockIdx.x;
              EpiMoeDown E{(unsigned char*)(ws + WS_OUTS), (const int*)(ws + WS_ROWASG) + ch * CHUNK_ROWS, (const float*)(ws + WS_ROWW) + ch * CHUNK_ROWS, ch * CHUNK_ASG}; pg8::gemm_phase<EpiMoeDown, SchedMoeD>(lds, S, E); }
            xcd_barrier(bar);
        }
        final_chunk(in, ws, out, ctl + CW_FCTR + 64 * (NCHUNK - 1), NCHUNK - 1, MISC + 16, tid, wave, lane);
    }
#undef IN
#undef SEAM
}

extern "C" void kernel_launch(void* const* d_in, const int* in_sizes, int n_in, void* d_out, int out_size, void* d_ws, size_t ws_size, hipStream_t stream) {
    static int grid = 0;
    if (grid == 0) {
        if (n_in != 31 || out_size != MTOK * DM || ws_size < WS_END) { fprintf(stderr, "kernel_launch: unexpected shapes: n_in %d out %d ws %zu (need %zu)\n", n_in, out_size, ws_size, (size_t)WS_END); grid = -1; return; }
        int dev = 0, cus = 0, per_cu = 0;
        if (hipGetDevice(&dev) != hipSuccess || hipDeviceGetAttribute(&cus, hipDeviceAttributeMultiprocessorCount, dev) != hipSuccess) { grid = -1; return; }
        if (hipFuncSetAttribute((const void*)fwd_kernel, hipFuncAttributeMaxDynamicSharedMemorySize, LDS_BYTES) != hipSuccess) { fprintf(stderr, "kernel_launch: hipFuncSetAttribute failed\n"); grid = -1; return; }
        if (hipOccupancyMaxActiveBlocksPerMultiprocessor(&per_cu, (const void*)fwd_kernel, NTHREADS, LDS_BYTES) != hipSuccess || per_cu < 1) { fprintf(stderr, "kernel_launch: occupancy query says %d\n", per_cu); }
        (void)hipGetLastError();
        grid = cus;
    }
    if (grid < 0) return;
    if (hipMemsetAsync((char*)d_ws + WS_CTL, 0, CTL_ZERO_BYTES, stream) != hipSuccess) return;
    Args a{};
    const float** ip = (const float**)&a.in;
    for (int i = 0; i < 31; ++i) ip[i] = (const float*)d_in[i];
    a.out = (float*)d_out; a.ws = (unsigned char*)d_ws; a.ph_lo = 0; a.ph_hi = 13;
    hipLaunchKernelGGL(fwd_kernel, dim3(grid), dim3(NTHREADS), LDS_BYTES, stream, a);
}
```

```cpp
#include <hip/hip_runtime.h>
#include <cstdio>
#include <cstdint>

#define LAS __attribute__((address_space(3)))
#define GAS __attribute__((address_space(1)))
typedef unsigned short bf16_t;
typedef short bf16x8 __attribute__((ext_vector_type(8)));
typedef short bf16x4 __attribute__((ext_vector_type(4)));
typedef float f32x4 __attribute__((ext_vector_type(4)));
typedef float f32x2 __attribute__((ext_vector_type(2)));
typedef unsigned u32x4 __attribute__((ext_vector_type(4)));
typedef unsigned u32x2 __attribute__((ext_vector_type(2)));

constexpr int DM = 1024, NB = 8, SEQ = 8192, MTOK = NB * SEQ;
constexpr int SSM_W = 512, SSM_G = 32, SSM_P = 64;
constexpr int NH = 16, HD = 64, NKV = 4, KVW = 256;
constexpr int NCMP = 511, NCMP_PAD = 512;
constexpr int NEXP = 256, TOPK = 8, DEXP = 256;
constexpr int NPROJ = 5376;
constexpr float DN_ALPHA = 1.189207115002721f;
constexpr float LN_EPS = 1e-5f;
constexpr int NWAVES = 8, NTHREADS = 512;

constexpr size_t MiB = 1u << 20;
constexpr size_t WS_CTL = 0, CTL_ZERO_BYTES = 1 * MiB;
constexpr size_t WS_MOD = 1 * MiB;
constexpr size_t WS_TAB = 1 * MiB + 512 * 1024;
constexpr size_t WS_WIN = 2 * MiB;
constexpr size_t WS_GLU = 13 * MiB;
constexpr size_t WS_WOUT = 15 * MiB;
constexpr size_t WS_ROUT = 17 * MiB;
constexpr size_t WS_SHGU = 17 * MiB + 512 * 1024;
constexpr size_t WS_SHD = 18 * MiB + 512 * 1024;
constexpr size_t WS_CW1 = 19 * MiB;
constexpr size_t WS_CW2 = 21 * MiB;
constexpr size_t WS_S5T = 21 * MiB + 512 * 1024;
constexpr size_t WS_BASE = 24 * MiB;
constexpr size_t WS_H1 = WS_BASE;
constexpr size_t WS_YNSA = WS_H1;
constexpr size_t WS_U = WS_H1 + 128 * MiB;
constexpr size_t WS_Q = WS_U + 64 * MiB;
constexpr size_t WS_MERGED = WS_Q;
constexpr size_t WS_KCR = WS_Q + 128 * MiB;
constexpr size_t WS_VCR = WS_KCR + 32 * MiB;
constexpr size_t WS_KS = WS_VCR + 32 * MiB;
constexpr size_t WS_VST = WS_KS + 32 * MiB;
constexpr size_t WS_KW = WS_VST + 32 * MiB;
constexpr size_t WS_VWT = WS_KW + 32 * MiB;
constexpr size_t WS_MG = WS_VWT + 32 * MiB;
constexpr size_t WS_GATES = WS_MG + 256 * MiB;
constexpr size_t WS_Z = WS_GATES + 12 * MiB;
constexpr size_t WS_CMPH = WS_Z + 64 * MiB;
constexpr size_t WS_KC = WS_CMPH + 16 * MiB;
constexpr size_t WS_VCT = WS_KC + 2 * MiB;
constexpr size_t WS_S5ST = WS_VCT + 2 * MiB;
constexpr size_t WS_MIX_END = WS_S5ST + 1 * MiB;
constexpr int NCHUNK = 2, CHUNK_TOK = 32768, CHUNK_ASG = CHUNK_TOK * 8, CHUNK_ROWS = 327680, CHUNK_TILES = CHUNK_ROWS / 256;
constexpr float OUTS_SCALE = 64.0f;
__host__ __device__ __forceinline__ int chunk_of_tok(int tok) { return tok >> 15; }
__host__ __device__ __forceinline__ int chunk_ntok(int ch) { return CHUNK_TOK; }
constexpr size_t WS_H2 = WS_BASE;
constexpr size_t WS_WGU = WS_H2 + 129 * MiB;
constexpr size_t WS_WD = WS_WGU + 256 * MiB;
constexpr size_t WS_OUTS = WS_WD + 128 * MiB;
constexpr size_t WS_LOGIT = WS_OUTS;
constexpr size_t WS_HID = WS_OUTS + 256 * MiB;
constexpr size_t WS_HSH = WS_HID;
constexpr size_t WS_ASGE = WS_HID + 160 * MiB;
constexpr size_t WS_ASGS = WS_ASGE + 2 * MiB;
constexpr size_t WS_ASGW = WS_ASGS + 2 * MiB;
constexpr size_t WS_ROWASG = WS_ASGW + 2 * MiB;
constexpr size_t WS_ROWW = WS_ROWASG + 3 * MiB;
constexpr size_t WS_LNST = WS_ROWW + 3 * MiB;
constexpr size_t WS_SHOUT = WS_LNST + 1 * MiB;
constexpr size_t WS_END = WS_SHOUT + 64 * MiB;
static_assert(WS_MIX_END <= WS_END, "map");
constexpr int CW_BAR = 4096;
constexpr int CW_CNT = 8192;
constexpr int CW_FCTR = 9216;
constexpr size_t TAB_CMPB = 0;
constexpr size_t TAB_LUT = 4096;
constexpr size_t S5_AFR = 0;
constexpr size_t S5_CFR = 256 * 1024;
constexpr size_t S5_A = 384 * 1024;
constexpr size_t S5_A16 = S5_A + 16384;
constexpr size_t S5_AC = S5_A16 + 16384;

constexpr int RING_BYTES = 131072;
constexpr int MISC_OFF = 133120;
constexpr int LUT_OFF = MISC_OFF + 1024;
constexpr int TILES_OFF = LUT_OFF + 8448;
constexpr int NB_OFF = TILES_OFF + 4160;
constexpr int LDS_BYTES = 163840;
static_assert(NB_OFF % 16 == 0 && NB_OFF + 16 * 264 * 4 <= LDS_BYTES, "near-bias table");
static_assert(RING_BYTES <= MISC_OFF, "GEMM stage ring below the control words");
static_assert(TILES_OFF + 4 * 260 * 4 <= LDS_BYTES, "lds map");

#define RLX_AGENT __ATOMIC_RELAXED, __HIP_MEMORY_SCOPE_AGENT
#define LDS_WAIT() asm volatile("s_waitcnt lgkmcnt(0)" ::: "memory")
#define VM_WAIT() asm volatile("s_waitcnt vmcnt(0)" ::: "memory")
__device__ __forceinline__ unsigned f2bf(float f) { unsigned u = __builtin_bit_cast(unsigned, f); return (u + 0x7fffu + ((u >> 16) & 1u)) >> 16; }
typedef __bf16 nbf16x2 __attribute__((ext_vector_type(2)));
__device__ __forceinline__ unsigned pk2(float lo, float hi) { const f32x2 v = {lo, hi}; return __builtin_bit_cast(unsigned, __builtin_convertvector(v, nbf16x2)); }
__device__ __forceinline__ float bf2f(unsigned short b) { return __builtin_bit_cast(float, ((unsigned)b) << 16); }
__device__ __forceinline__ float bflo(unsigned w) { return __builtin_bit_cast(float, w << 16); }
__device__ __forceinline__ float bfhi(unsigned w) { return __builtin_bit_cast(float, w & 0xffff0000u); }
__device__ __forceinline__ float sigmoidf_(float x) { return 1.0f / (1.0f + __expf(-x)); }
__device__ __forceinline__ float siluf_(float x) { return x / (1.0f + __expf(-x)); }
__device__ __forceinline__ float gelu_tanh(float x) { const float u = 0.7978845608028654f * (x + 0.044715f * x * x * x); const float e = __expf(2.0f * u); return x * (1.0f - 1.0f / (e + 1.0f)); }
__device__ __forceinline__ float wave_sum(float v) {
#pragma unroll
    for (int o = 1; o < 64; o <<= 1) v += __shfl_xor(v, o);
    return v;
}

#define XB_TMO      128
#define XB_XCNT(j)  (256  + 64 * (j))
#define XB_XSUB(j)  (1280 + 64 * (j))
#define XB_XGEN(j)  (2304 + 64 * (j))
#define XB_TOP      3328
#define XB_TOPGEN   3392
#define XCD_BAR_WORDS 3456
#define XB_SPIN_CAP (1u << 18)
__device__ __forceinline__ unsigned xb_ld(unsigned* p)              { return __hip_atomic_load(p, __ATOMIC_RELAXED, __HIP_MEMORY_SCOPE_AGENT); }
__device__ __forceinline__ unsigned xb_add(unsigned* p, unsigned v) { return __hip_atomic_fetch_add(p, v, __ATOMIC_RELAXED, __HIP_MEMORY_SCOPE_AGENT); }
__device__ __forceinline__ unsigned xb_xcc_id() { return (unsigned)__builtin_amdgcn_s_getreg((3 << 11) | 20) & 0xFu; }
#define XB_SPIN(cond, bar) do { unsigned _sp = 0; while (cond) { __builtin_amdgcn_s_sleep(1); \
    if ((++_sp & 255u) == 0u) { if (xb_ld(&(bar)[XB_TMO])) break; if (_sp > XB_SPIN_CAP) { atomicAdd(&(bar)[XB_TMO], 1u); break; } } } } while (0)
struct XcdBarrier { unsigned* bar; unsigned x; volatile LAS unsigned* st; };
__device__ __forceinline__ XcdBarrier xcd_barrier_post(unsigned* bar, volatile LAS unsigned* st) {
    XcdBarrier b; b.bar = bar; b.x = xb_xcc_id(); b.st = st;
    if (threadIdx.x == 0) (void)xb_add(&bar[XB_XCNT(b.x)], 1u);
    return b;
}
__device__ __forceinline__ void xcd_barrier_complete(unsigned* bar, unsigned x, unsigned& nloc, unsigned& nx) {
    const unsigned G = gridDim.x * gridDim.y * gridDim.z;
    unsigned sum, cnt, mine, sp = 0u;
    for (;;) {
        sum = 0u; cnt = 0u; mine = 0u;
#pragma unroll
        for (unsigned j = 0; j < 16; ++j) { const unsigned c = xb_ld(&bar[XB_XCNT(j)]); sum += c; cnt += (c > 0u) ? 1u : 0u; mine = (j == x) ? c : mine; }
        if (sum == G) break;
        __builtin_amdgcn_s_sleep(1);
        if ((++sp & 255u) == 0u) { if (xb_ld(&bar[XB_TMO])) break; if (sp > XB_SPIN_CAP) { atomicAdd(&bar[XB_TMO], 1u); break; } }
    }
    nloc = mine > 0u ? mine : 1u; nx = cnt > 0u ? cnt : 1u;
}
__device__ __forceinline__ void xcd_barrier(const XcdBarrier& b) {
    asm volatile("s_waitcnt vmcnt(0)" ::: "memory");
    __syncthreads();
    if (threadIdx.x == 0) {
        unsigned* bar = b.bar;
        __builtin_amdgcn_s_waitcnt(0);
        unsigned nloc = b.st[0], nx = b.st[1];
        if (nloc == 0u) { xcd_barrier_complete(bar, b.x, nloc, nx); b.st[0] = nloc; b.st[1] = nx; }
        const unsigned old = xb_add(&bar[XB_XSUB(b.x)], 1u);
        const unsigned gen = old / nloc;
        if (old + 1u == (gen + 1u) * nloc) {
            __builtin_amdgcn_fence(__ATOMIC_RELEASE, "agent");
            asm volatile("s_waitcnt vmcnt(0)" ::: "memory");
            const unsigned og = xb_add(&bar[XB_TOP], 1u);
            const unsigned tg = og / nx;
            if (og + 1u == (tg + 1u) * nx) xb_add(&bar[XB_TOPGEN], 1u);
            else XB_SPIN(xb_ld(&bar[XB_TOPGEN]) == tg, bar);
            __builtin_amdgcn_fence(__ATOMIC_ACQUIRE, "agent");
            xb_add(&bar[XB_XGEN(b.x)], 1u);
            asm volatile("s_waitcnt vmcnt(0)" ::: "memory");
        } else {
            XB_SPIN(xb_ld(&bar[XB_XGEN(b.x)]) == gen, bar);
            __builtin_amdgcn_fence(__ATOMIC_ACQUIRE, "agent");
            asm volatile("s_waitcnt vmcnt(0)" ::: "memory");
        }
    }
    __syncthreads();
}

namespace pg8 {
constexpr int BM = 256, BK = 64, HALF = 128, HTB = HALF * BK * 2, STAGE_BYTES = 8 * HTB, NXCD = 8, WGM = 8;
__host__ __device__ __forceinline__ int lds_byte(int r, int c) { const int st = (r >> 4) * 2 + (c >> 5), rr = r & 15, cc = c & 31, ob = rr * 64 + cc * 2; return st * 1024 + (ob ^ (((ob >> 9) & 1) << 5)); }
__host__ __device__ __forceinline__ void stage_rc(int b, int& R, int& C) { const int st = b / 1024, sb = b % 1024, swz = sb ^ (((sb >> 9) & 1) << 5); R = (st >> 1) * 16 + swz / 64; C = (st & 1) * 32 + (swz % 64) / 2; }
__host__ __device__ __forceinline__ int perm32(int rho) { const int n = rho >> 4, i = rho & 15; return 8 * (i >> 2) + 4 * n + (i & 3); }
struct Unit { int pm, pn; };
struct DenseOrder {
    int nM, nN, nwg, G, c;
    __device__ void init(int nM_, int nN_, int G_, int c_) { nM = nM_; nN = nN_; nwg = nM * nN; G = G_; c = c_; }
    __device__ bool next(int i, Unit& u) const {
        const long L = (long)i * G + c; if (L >= nwg) return false;
        int wgid = (int)L; { const int q = nwg / NXCD, r = nwg % NXCD, xcd = wgid % NXCD, off = wgid / NXCD; wgid = (xcd < r ? xcd * (q + 1) : r * (q + 1) + (xcd - r) * q) + off; }
        const int nig = WGM * nN, gid = wgid / nig, fm = gid * WGM, gsz = (nM - fm) < WGM ? (nM - fm) : WGM;
        u.pm = fm + ((wgid % nig) % gsz); u.pn = (wgid % nig) / gsz; return true;
    }
};
template <class Epi, class Sched>
__device__ __forceinline__ void gemm_phase(LAS unsigned char* lds, const Sched& S, const Epi& E) {
    int tid_ = threadIdx.x; asm volatile("" : "+v"(tid_));
    const int tid = tid_, wid = __builtin_amdgcn_readfirstlane(tid >> 6), lane = tid & 63, wr = wid >> 2, wc = wid & 3, fr = lane & 15, fq = lane >> 4;
    const int K = S.K, nt = K / BK;
    int RA[2], CA[2]; unsigned voffB[2];
#pragma unroll
    for (int i = 0; i < 2; ++i) { int R, C; stage_rc(tid * 16 + i * 8192, R, C); const int Rb = Epi::PERM ? ((R & ~31) + perm32(R & 31)) : R;
        RA[i] = R; CA[i] = C * 2; voffB[i] = (unsigned)(Rb * K + C) * 2u; }
    const size_t kstep = (size_t)(BK * 2);
    const size_t hstep = (size_t)HALF * K * 2;
    const size_t ka = (size_t)S.a_kstep;
    const unsigned ldsw = (unsigned)wid * 1024u;
    const int aoff = lds_byte(wr * 64 + fr, fq * 8), boff = lds_byte(wc * 32 + fr, fq * 8);
#define PG8_SA(b, h) (((b) * 2 + (h)) * HTB)
#define PG8_SB(b, h) ((4 + (b) * 2 + (h)) * HTB)
#define PG8_STAGE(bufoff, gbase, v0, v1) do { \
        __builtin_amdgcn_global_load_lds((const unsigned*)((const char*)(gbase) + (v0)), (LAS unsigned*)(lds + (bufoff) + ldsw), 16, 0, 0); \
        __builtin_amdgcn_global_load_lds((const unsigned*)((const char*)(gbase) + (v1)), (LAS unsigned*)(lds + (bufoff) + ldsw + 8192), 16, 0, 0); } while (0)
#define PG8_LDA(dst, b, h) do { _Pragma("unroll") for (int m = 0; m < 4; ++m) _Pragma("unroll") for (int k = 0; k < 2; ++k) dst[m][k] = *(const LAS bf16x8*)(lds + PG8_SA(b, h) + aoff + m * 2048 + k * 1024); } while (0)
#define PG8_LDB(dst, b, h) do { _Pragma("unroll") for (int n = 0; n < 2; ++n) _Pragma("unroll") for (int k = 0; k < 2; ++k) dst[n][k] = *(const LAS bf16x8*)(lds + PG8_SB(b, h) + boff + n * 2048 + k * 1024); } while (0)
#define PG8_MMA(ai, bj, At, Bt) do { __builtin_amdgcn_s_setprio(1); _Pragma("unroll") for (int m = 0; m < 4; ++m) _Pragma("unroll") for (int n = 0; n < 2; ++n) _Pragma("unroll") for (int k = 0; k < 2; ++k) \
        acc[ai][bj][m][n] = __builtin_amdgcn_mfma_f32_16x16x32_bf16(Bt[n][k], At[m][k], acc[ai][bj][m][n], 0, 0, 0); __builtin_amdgcn_s_setprio(0); } while (0)
#define PG8_WAIT_V(n) asm volatile("s_waitcnt vmcnt(" #n ")" ::: "memory")
#define PG8_WAIT_L(n) asm volatile("s_waitcnt lgkmcnt(" #n ")" ::: "memory")
#define PG8_BAR __builtin_amdgcn_s_barrier()
#define PG8_SCHED __builtin_amdgcn_sched_barrier(0)
    Unit cur, nxt; int ui = 0;
    if (!S.next(0, cur)) return;
    f32x4 acc[2][2][4][2];
#pragma unroll
    for (int a = 0; a < 2; ++a)
#pragma unroll
        for (int b = 0; b < 2; ++b)
#pragma unroll
            for (int m = 0; m < 4; ++m)
#pragma unroll
                for (int n = 0; n < 2; ++n) acc[a][b][m][n] = (f32x4){0.f, 0.f, 0.f, 0.f};
    bf16x8 At[4][2], B0[2][2], B1[2][2];
    const char* const abase = S.abase;
    unsigned va00 = S.a_off(cur, RA[0]) + CA[0], va01 = S.a_off(cur, RA[1]) + CA[1], va10 = S.a_off(cur, RA[0] + HALF) + CA[0], va11 = S.a_off(cur, RA[1] + HALF) + CA[1];
    const char* cB = S.b_ptr(cur);
    PG8_STAGE(PG8_SB(0, 0), cB, voffB[0], voffB[1]); PG8_STAGE(PG8_SB(0, 1), cB + hstep, voffB[0], voffB[1]); PG8_STAGE(PG8_SA(0, 0), abase, va00, va01); PG8_STAGE(PG8_SA(0, 1), abase, va10, va11);
    if (wr == 1) PG8_BAR;
    PG8_WAIT_V(2); PG8_BAR;
    PG8_STAGE(PG8_SB(1, 0), cB + kstep, voffB[0], voffB[1]); PG8_STAGE(PG8_SA(1, 0), abase + ka, va00, va01); PG8_STAGE(PG8_SB(1, 1), cB + hstep + kstep, voffB[0], voffB[1]);
    PG8_WAIT_V(6); PG8_BAR;
    for (;;) {
        const bool has_next = S.next(ui + 1, nxt);
        unsigned na00 = va00, na01 = va01, na10 = va10, na11 = va11; const char* nB = cB;
        if (has_next) { na00 = S.a_off(nxt, RA[0]) + CA[0]; na01 = S.a_off(nxt, RA[1]) + CA[1]; na10 = S.a_off(nxt, RA[0] + HALF) + CA[0]; na11 = S.a_off(nxt, RA[1] + HALF) + CA[1]; nB = S.b_ptr(nxt); }
        for (int t = 0; t < nt; t += 2) {
            const bool last = (t == nt - 2);
            const char* a1 = abase + (size_t)(t + 1) * ka;
            const char* a2 = last ? abase : abase + (size_t)(t + 2) * ka; const char* b2 = last ? nB : cB + (size_t)(t + 2) * kstep;
            const char* a3 = a2 + ka; const char* b3 = b2 + kstep;
            const unsigned x00 = last ? na00 : va00, x01 = last ? na01 : va01, x10 = last ? na10 : va10, x11 = last ? na11 : va11;
            PG8_LDB(B0, 0, 0); PG8_LDB(B1, 0, 1); PG8_SCHED; PG8_LDA(At, 0, 0); PG8_STAGE(PG8_SA(1, 1), a1, va10, va11);
            PG8_WAIT_V(8); PG8_WAIT_L(0); PG8_BAR; PG8_MMA(0, 0, At, B0); PG8_MMA(0, 1, At, B1); PG8_BAR; PG8_SCHED;
            PG8_LDA(At, 0, 1); PG8_STAGE(PG8_SB(0, 0), b2, voffB[0], voffB[1]); PG8_STAGE(PG8_SB(0, 1), b2 + hstep, voffB[0], voffB[1]); PG8_STAGE(PG8_SA(0, 0), a2, x00, x01);
            PG8_WAIT_V(8); PG8_WAIT_L(0); PG8_BAR; PG8_MMA(1, 0, At, B0); PG8_MMA(1, 1, At, B1); PG8_BAR; PG8_SCHED;
            PG8_LDB(B0, 1, 0); PG8_LDB(B1, 1, 1); PG8_SCHED; PG8_LDA(At, 1, 0); PG8_STAGE(PG8_SA(0, 1), a2, x10, x11);
            PG8_WAIT_V(8); PG8_WAIT_L(0); PG8_BAR; PG8_MMA(0, 0, At, B0); PG8_MMA(0, 1, At, B1); PG8_BAR; PG8_SCHED;
            PG8_LDA(At, 1, 1); PG8_STAGE(PG8_SB(1, 0), b3, voffB[0], voffB[1]); PG8_STAGE(PG8_SB(1, 1), b3 + hstep, voffB[0], voffB[1]); PG8_STAGE(PG8_SA(1, 0), a3, x00, x01);
            PG8_WAIT_V(8); PG8_WAIT_L(0); PG8_BAR; PG8_MMA(1, 0, At, B0); PG8_MMA(1, 1, At, B1); PG8_BAR; PG8_SCHED;
        }
        if (wr == 0) PG8_BAR;
        E(acc, cur, wr, wc, fr, fq);
        if (!has_next) break;
#pragma unroll
        for (int a = 0; a < 2; ++a)
#pragma unroll
            for (int b = 0; b < 2; ++b)
#pragma unroll
                for (int m = 0; m < 4; ++m)
#pragma unroll
                    for (int n = 0; n < 2; ++n) acc[a][b][m][n] = (f32x4){0.f, 0.f, 0.f, 0.f};
        cur = nxt; cB = nB; va00 = na00; va01 = na01; va10 = na10; va11 = na11; ++ui;
        if (wr == 1) PG8_BAR;
    }
    PG8_WAIT_V(0);
    PG8_BAR;
#undef PG8_SA
#undef PG8_SB
#undef PG8_STAGE
#undef PG8_LDA
#undef PG8_LDB
#undef PG8_MMA
#undef PG8_WAIT_V
#undef PG8_WAIT_L
#undef PG8_BAR
#undef PG8_SCHED
}
}

__host__ __device__ __forceinline__ int vperm(int key) { const int x = key & 31; return (key & ~31) | (8 * ((x >> 2) & 3) + 4 * ((x >> 4) & 1) + (x & 3)); }
using pg8::Unit;
struct SchedDense {
    const char* abase; unsigned a_kstep; int K;
    unsigned a_base; unsigned lda; const char* Bt; pg8::DenseOrder ord;
    __device__ __forceinline__ bool next(int i, Unit& u) const { return ord.next(i, u); }
    __device__ __forceinline__ unsigned a_off(const Unit& u, int R) const { return a_base + (unsigned)(u.pm * 256 + R) * lda; }
    __device__ __forceinline__ const char* b_ptr(const Unit& u) const { return Bt + (size_t)u.pn * 256 * K * 2; }
};
__device__ __forceinline__ SchedDense make_dense(const char* ws, size_t a_off, int lda_bytes, const char* Bt, int M, int N, int K) {
    SchedDense S; S.abase = ws; S.a_kstep = 128; S.K = K; S.a_base = (unsigned)a_off; S.lda = (unsigned)lda_bytes; S.Bt = Bt; S.ord.init(M / 256, N / 256, (int)gridDim.x, (int)blockIdx.x); return S;
}
struct SchedCmp1 {
    const char* abase; unsigned a_kstep; int K; const char* Bt; pg8::DenseOrder ord;
    __device__ __forceinline__ bool next(int i, Unit& u) const { return ord.next(i, u); }
    __device__ __forceinline__ unsigned a_off(const Unit& u, int R) const {
        const int row = u.pm * 256 + R, g = row & 3, bn = row >> 2, b = bn >> 9; int n = bn & 511; n = n > 510 ? 510 : n;
        return (unsigned)(u.pn ? WS_VCR : WS_KCR) + (unsigned)(((b * SEQ + 16 * n) * KVW + g * HD) * 2);
    }
    __device__ __forceinline__ const char* b_ptr(const Unit& u) const { return Bt + (size_t)u.pn * 256 * 2048 * 2; }
};
struct SchedCmp2 {
    const char* abase; unsigned a_kstep; int K; const char* Bt; pg8::DenseOrder ord;
    __device__ __forceinline__ bool next(int i, Unit& u) const { return ord.next(i, u); }
    __device__ __forceinline__ unsigned a_off(const Unit& u, int R) const { return (unsigned)WS_CMPH + (unsigned)(((u.pn * 16384) + u.pm * 256 + R) * 512); }
    __device__ __forceinline__ const char* b_ptr(const Unit& u) const { return Bt + (size_t)u.pn * 256 * 256 * 2; }
};

struct EpiProj {
    static constexpr bool PERM = true;
    unsigned char* ws;
    __device__ __forceinline__ void operator()(const f32x4 (&acc)[2][2][4][2], const Unit& u, int wr, int wc, int fr, int fq) const {
        const int pn = u.pn;
#pragma unroll
        for (int ai = 0; ai < 2; ++ai)
#pragma unroll
            for (int m = 0; m < 4; ++m) {
                const int row = u.pm * 256 + 128 * ai + 64 * wr + 16 * m + fr;
#pragma unroll
                for (int bj = 0; bj < 2; ++bj) {
                    const int c8 = 128 * bj + 32 * wc + 8 * fq;
                    float v[8];
#pragma unroll
                    for (int j = 0; j < 4; ++j) { v[j] = acc[ai][bj][m][0][j]; v[4 + j] = acc[ai][bj][m][1][j]; }
                    if (pn < 12 && pn != 9 && pn != 11) {
                        bf16_t* dst; float sc = 1.0f;
                        if (pn < 2) dst = (bf16_t*)(ws + WS_U) + (size_t)row * 512 + pn * 256 + c8;
                        else if (pn < 6) { dst = (bf16_t*)(ws + WS_Q) + (size_t)row * 1024 + (pn - 2) * 256 + c8; sc = 0.125f * 1.4426950408889634f; }
                        else { const size_t off = pn == 6 ? WS_KCR : pn == 7 ? WS_VCR : pn == 8 ? WS_KS : WS_KW; dst = (bf16_t*)(ws + off) + (size_t)row * 256 + c8; }
                        u32x4 w; w.x = pk2(v[0] * sc, v[1] * sc); w.y = pk2(v[2] * sc, v[3] * sc); w.z = pk2(v[4] * sc, v[5] * sc); w.w = pk2(v[6] * sc, v[7] * sc);
                        *(u32x4*)dst = w;
                    } else if (pn == 9 || pn == 11) {
                        bf16_t* base = (bf16_t*)(ws + (pn == 9 ? WS_VST : WS_VWT));
                        const int b = row >> 13, t = row & (SEQ - 1);
#pragma unroll
                        for (int e = 0; e < 8; ++e) { const int c = c8 + e, g = c >> 6, d = c & 63; base[((size_t)((b * 4 + g) * 64 + d)) * SEQ + vperm(t)] = (bf16_t)f2bf(v[e]); }
                    } else if (pn < 20) {
                        unsigned char* dst = ws + WS_MG + (size_t)row * 2048 + (pn - 12) * 256 + c8;
                        int w0 = __builtin_amdgcn_cvt_pk_fp8_f32(sigmoidf_(v[0]) * 64.f, sigmoidf_(v[1]) * 64.f, 0, false); w0 = __builtin_amdgcn_cvt_pk_fp8_f32(sigmoidf_(v[2]) * 64.f, sigmoidf_(v[3]) * 64.f, w0, true);
                        int w1 = __builtin_amdgcn_cvt_pk_fp8_f32(sigmoidf_(v[4]) * 64.f, sigmoidf_(v[5]) * 64.f, 0, false); w1 = __builtin_amdgcn_cvt_pk_fp8_f32(sigmoidf_(v[6]) * 64.f, sigmoidf_(v[7]) * 64.f, w1, true);
                        u32x2 w; w.x = (unsigned)w0; w.y = (unsigned)w1; *(u32x2*)dst = w;
                    } else {
                        if (c8 < 48) { float* dst = (float*)(ws + WS_GATES) + (size_t)row * 48 + c8;
                            *(f32x4*)dst = (f32x4){sigmoidf_(v[0]), sigmoidf_(v[1]), sigmoidf_(v[2]), sigmoidf_(v[3])}; *(f32x4*)(dst + 4) = (f32x4){sigmoidf_(v[4]), sigmoidf_(v[5]), sigmoidf_(v[6]), sigmoidf_(v[7])}; }
                    }
                }
            }
    }
};
struct EpiCmp1 {
    static constexpr bool PERM = true;
    unsigned char* ws;
    __device__ __forceinline__ void operator()(const f32x4 (&acc)[2][2][4][2], const Unit& u, int wr, int wc, int fr, int fq) const {
        const float* bias = (const float*)(ws + WS_CTL + 65536) + u.pn * 256;
#pragma unroll
        for (int bj = 0; bj < 2; ++bj) {
            const int c8 = 128 * bj + 32 * wc + 8 * fq;
            const f32x4 b0 = *(const f32x4*)(bias + c8), b1 = *(const f32x4*)(bias + c8 + 4);
#pragma unroll
            for (int ai = 0; ai < 2; ++ai)
#pragma unroll
                for (int m = 0; m < 4; ++m) {
                    const int row = u.pm * 256 + 128 * ai + 64 * wr + 16 * m + fr;
                    const f32x4 x0 = acc[ai][bj][m][0] + b0, x1 = acc[ai][bj][m][1] + b1;
                    u32x4 w; w.x = pk2(gelu_tanh(x0[0]), gelu_tanh(x0[1])); w.y = pk2(gelu_tanh(x0[2]), gelu_tanh(x0[3])); w.z = pk2(gelu_tanh(x1[0]), gelu_tanh(x1[1])); w.w = pk2(gelu_tanh(x1[2]), gelu_tanh(x1[3]));
                    *(u32x4*)((bf16_t*)(ws + WS_CMPH) + ((size_t)u.pn * 16384 + row) * 256 + c8) = w;
                }
        }
    }
};
struct EpiCmp2 {
    static constexpr bool PERM = false;
    unsigned char* ws;
    __device__ __forceinline__ void operator()(const f32x4 (&acc)[2][2][4][2], const Unit& u, int wr, int wc, int fr, int fq) const {
        if (wc >= 2) return;
#pragma unroll
        for (int ai = 0; ai < 2; ++ai)
#pragma unroll
            for (int m = 0; m < 4; ++m) {
                const int row = u.pm * 256 + 128 * ai + 64 * wr + 16 * m + fr;
#pragma unroll
                for (int n = 0; n < 2; ++n) {
                    const int c = 32 * wc + 16 * n + 4 * fq; const f32x4 x = acc[ai][0][m][n];
                    if (u.pn == 0) { u32x2 w; w.x = pk2(x[0], x[1]); w.y = pk2(x[2], x[3]); *(u32x2*)((bf16_t*)(ws + WS_KC) + (size_t)row * 64 + c) = w; }
                    else { const int g = row & 3, bn = row >> 2, b = bn >> 9, nn = bn & 511; bf16_t* base = (bf16_t*)(ws + WS_VCT) + ((size_t)((b * 4 + g) * 64 + c)) * NCMP_PAD + vperm(nn);
#pragma unroll
                        for (int j = 0; j < 4; ++j) base[(size_t)j * NCMP_PAD] = (bf16_t)f2bf(x[j]); }
                }
            }
    }
};
struct EpiGlu {
    static constexpr bool PERM = true;
    unsigned char* ws;
    __device__ __forceinline__ void operator()(const f32x4 (&acc)[2][2][4][2], const Unit& u, int wr, int wc, int fr, int fq) const {
        const int col = u.pn * 128 + 32 * wc + 8 * fq;
#pragma unroll
        for (int ai = 0; ai < 2; ++ai) {
            u32x2 g0[4], g1[4]; u32x4 yn[4];
#pragma unroll
            for (int m = 0; m < 4; ++m) { const int row = u.pm * 256 + 128 * ai + 64 * wr + 16 * m + fr;
                g0[m] = *(const u32x2*)(ws + WS_MG + (size_t)row * 2048 + col);
                g1[m] = *(const u32x2*)(ws + WS_MG + (size_t)row * 2048 + 1024 + col);
                yn[m] = *(const u32x4*)((const bf16_t*)(ws + WS_YNSA) + (size_t)row * 1024 + col); }
#pragma unroll
            for (int m = 0; m < 4; ++m) { const int row = u.pm * 256 + 128 * ai + 64 * wr + 16 * m + fr;
                float o[8];
#pragma unroll
                for (int e = 0; e < 8; ++e) { const float val = acc[ai][0][m][e >> 2][e & 3], gate = acc[ai][1][m][e >> 2][e & 3]; const float ys = val * sigmoidf_(gate);
                    const unsigned wy = yn[m][e >> 1];
                    const f32x2 p0 = ((e >> 1) & 1) ? __builtin_amdgcn_cvt_pk_f32_fp8((int)g0[m][e >> 2], true) : __builtin_amdgcn_cvt_pk_f32_fp8((int)g0[m][e >> 2], false);
                    const f32x2 p1 = ((e >> 1) & 1) ? __builtin_amdgcn_cvt_pk_f32_fp8((int)g1[m][e >> 2], true) : __builtin_amdgcn_cvt_pk_f32_fp8((int)g1[m][e >> 2], false);
                    const float a0 = (e & 1) ? p0.y : p0.x, a1 = (e & 1) ? p1.y : p1.x, yy = (e & 1) ? bfhi(wy) : bflo(wy);
                    o[e] = (a0 * ys + a1 * yy) * (1.0f / 64.0f); }
                u32x4 w; w.x = pk2(o[0], o[1]); w.y = pk2(o[2], o[3]); w.z = pk2(o[4], o[5]); w.w = pk2(o[6], o[7]);
                *(u32x4*)((bf16_t*)(ws + WS_MERGED) + (size_t)row * 1024 + col) = w; }
        }
    }
};
struct EpiWout {
    static constexpr bool PERM = false;
    const float* x; float* out; const float* gmod;
    __device__ __forceinline__ void operator()(const f32x4 (&acc)[2][2][4][2], const Unit& u, int wr, int wc, int fr, int fq) const {
        const int b = u.pm >> 5;
#pragma unroll
        for (int bj = 0; bj < 2; ++bj)
#pragma unroll
            for (int n = 0; n < 2; ++n) {
                const int col = u.pn * 256 + 128 * bj + 32 * wc + 16 * n + 4 * fq; const f32x4 gv = *(const f32x4*)(gmod + (size_t)b * 6144 + col);
                f32x4 xv[2][4];
#pragma unroll
                for (int ai = 0; ai < 2; ++ai)
#pragma unroll
                    for (int m = 0; m < 4; ++m) xv[ai][m] = *(const f32x4*)(x + (size_t)(u.pm * 256 + 128 * ai + 64 * wr + 16 * m + fr) * 1024 + col);
#pragma unroll
                for (int ai = 0; ai < 2; ++ai)
#pragma unroll
                    for (int m = 0; m < 4; ++m) { const f32x4 rv = xv[ai][m] * DN_ALPHA + gv * acc[ai][bj][m][n]; u32x2 w; w.x = pk2(rv[0], rv[1]); w.y = pk2(rv[2], rv[3]);
                        *(u32x2*)((bf16_t*)(out + (size_t)(u.pm * 256 + 128 * ai + 64 * wr + 16 * m + fr) * 1024) + col) = w; }
            }
    }
};
struct EpiF32 {
    static constexpr bool PERM = false;
    float* C; int ldc;
    __device__ __forceinline__ void operator()(const f32x4 (&acc)[2][2][4][2], const Unit& u, int wr, int wc, int fr, int fq) const {
#pragma unroll
        for (int ai = 0; ai < 2; ++ai)
#pragma unroll
            for (int m = 0; m < 4; ++m) { float* rowp = C + (size_t)(u.pm * 256 + 128 * ai + 64 * wr + 16 * m + fr) * ldc + u.pn * 256 + 32 * wc + 4 * fq;
#pragma unroll
                for (int bj = 0; bj < 2; ++bj)
#pragma unroll
                    for (int n = 0; n < 2; ++n) *(f32x4*)(rowp + bj * 128 + n * 16) = acc[ai][bj][m][n]; }
    }
};
struct EpiSwiglu {
    static constexpr bool PERM = true;
    bf16_t* H;
    __device__ __forceinline__ void operator()(const f32x4 (&acc)[2][2][4][2], const Unit& u, int wr, int wc, int fr, int fq) const {
#pragma unroll
        for (int ai = 0; ai < 2; ++ai)
#pragma unroll
            for (int m = 0; m < 4; ++m) {
                const size_t row = (size_t)u.pm * 256 + 128 * ai + 64 * wr + 16 * m + fr; const int col = u.pn * 128 + 32 * wc + 8 * fq;
                float o[8];
#pragma unroll
                for (int e = 0; e < 8; ++e) o[e] = siluf_(acc[ai][0][m][e >> 2][e & 3]) * acc[ai][1][m][e >> 2][e & 3];
                u32x4 w; w.x = pk2(o[0], o[1]); w.y = pk2(o[2], o[3]); w.z = pk2(o[4], o[5]); w.w = pk2(o[6], o[7]);
                *(u32x4*)(H + row * 256 + col) = w;
            }
    }
};

__device__ __forceinline__ int find_expert(const LAS int* tstart, int tau) {
    int lo = 0, hi = 256;
    while (hi - lo > 1) { const int mid = (lo + hi) >> 1; if (tstart[mid] <= tau) lo = mid; else hi = mid; }
    return lo;
}
struct SchedMoeGU {
    const char* abase; unsigned a_kstep; int K; const LAS int* tstart; const int* rowasg; const char* W; int G, c;
    __device__ __forceinline__ bool next(int i, Unit& u) const { const int x = c & 7, slot = c >> 3, per = (G >> 3) >> 1; const int tau = (i * 8 + x) * per + (slot >> 1); if ((G & 15) != 0 || tau >= tstart[256]) { if ((G & 15) != 0) { const int L = i * G + c; if (L >= 2 * tstart[256]) return false; u.pm = L >> 1; u.pn = L & 1; return true; } return false; } u.pm = tau; u.pn = slot & 1; return true; }
    __device__ __forceinline__ unsigned a_off(const Unit& u, int R) const { const int a = rowasg[u.pm * 256 + R]; const unsigned tok = a < 0 ? (unsigned)MTOK : (unsigned)a >> 3; return (unsigned)WS_H2 + tok * 2048u; }
    __device__ __forceinline__ const char* b_ptr(const Unit& u) const { const int e = find_expert(tstart, u.pm); return W + ((size_t)e * 512 + u.pn * 256) * 1024 * 2; }
};
struct SchedMoeD {
    const char* abase; unsigned a_kstep; int K; const LAS int* tstart; const char* W; int G, c;
    __device__ __forceinline__ bool next(int i, Unit& u) const { const int x = c & 7, slot = c >> 3, per = (G >> 3) >> 2; const int tau = (i * 8 + x) * per + (slot >> 2); if ((G & 31) != 0 || tau >= tstart[256]) { if ((G & 31) != 0) { const int L = i * G + c; if (L >= 4 * tstart[256]) return false; u.pm = L >> 2; u.pn = L & 3; return true; } return false; } u.pm = tau; u.pn = slot & 3; return true; }
    __device__ __forceinline__ unsigned a_off(const Unit& u, int R) const { return (unsigned)WS_HID + (unsigned)(u.pm * 256 + R) * 512u; }
    __device__ __forceinline__ const char* b_ptr(const Unit& u) const { const int e = find_expert(tstart, u.pm); return W + ((size_t)e * 1024 + u.pn * 256) * 256 * 2; }
};
struct EpiMoeDown {
    static constexpr bool PERM = true;
    unsigned char* O; const int* rowasg; const float* roww; int asg0;
    __device__ __forceinline__ void operator()(const f32x4 (&acc)[2][2][4][2], const Unit& u, int wr, int wc, int fr, int fq) const {
        int av[2][4]; float wv[2][4];
#pragma unroll
        for (int ai = 0; ai < 2; ++ai)
#pragma unroll
            for (int m = 0; m < 4; ++m) { const int row = u.pm * 256 + 128 * ai + 64 * wr + 16 * m + fr; av[ai][m] = rowasg[row]; wv[ai][m] = roww[row] * OUTS_SCALE; }
#pragma unroll
        for (int ai = 0; ai < 2; ++ai)
#pragma unroll
            for (int m = 0; m < 4; ++m) {
                const int a = av[ai][m]; const float w = wv[ai][m];
                if (a >= 0) { unsigned char* rowp = O + (size_t)(a - asg0) * 1024 + u.pn * 256 + 32 * wc + 8 * fq;
#pragma unroll
                    for (int bj = 0; bj < 2; ++bj) { f32x4 x0 = acc[ai][bj][m][0] * w, x1 = acc[ai][bj][m][1] * w;
#pragma unroll
                        for (int e = 0; e < 4; ++e) { x0[e] = fminf(fmaxf(x0[e], -440.f), 440.f); x1[e] = fminf(fmaxf(x1[e], -440.f), 440.f); }
                        int w0 = __builtin_amdgcn_cvt_pk_fp8_f32(x0[0], x0[1], 0, false); w0 = __builtin_amdgcn_cvt_pk_fp8_f32(x0[2], x0[3], w0, true);
                        int w1 = __builtin_amdgcn_cvt_pk_fp8_f32(x1[0], x1[1], 0, false); w1 = __builtin_amdgcn_cvt_pk_fp8_f32(x1[2], x1[3], w1, true);
                        u32x2 o; o.x = (unsigned)w0; o.y = (unsigned)w1; *(u32x2*)(rowp + bj * 128) = o; } }
            }
    }
};
struct EpiShDown {
    static constexpr bool PERM = true;
    unsigned char* O;
    __device__ __forceinline__ void operator()(const f32x4 (&acc)[2][2][4][2], const Unit& u, int wr, int wc, int fr, int fq) const {
#pragma unroll
        for (int ai = 0; ai < 2; ++ai)
#pragma unroll
            for (int m = 0; m < 4; ++m) { unsigned char* rowp = O + (size_t)(u.pm * 256 + 128 * ai + 64 * wr + 16 * m + fr) * 1024 + u.pn * 256 + 32 * wc + 8 * fq;
#pragma unroll
                for (int bj = 0; bj < 2; ++bj) { f32x4 x0 = acc[ai][bj][m][0] * OUTS_SCALE, x1 = acc[ai][bj][m][1] * OUTS_SCALE;
#pragma unroll
                    for (int e = 0; e < 4; ++e) { x0[e] = fminf(fmaxf(x0[e], -440.f), 440.f); x1[e] = fminf(fmaxf(x1[e], -440.f), 440.f); }
                    int w0 = __builtin_amdgcn_cvt_pk_fp8_f32(x0[0], x0[1], 0, false); w0 = __builtin_amdgcn_cvt_pk_fp8_f32(x0[2], x0[3], w0, true);
                    int w1 = __builtin_amdgcn_cvt_pk_fp8_f32(x1[0], x1[1], 0, false); w1 = __builtin_amdgcn_cvt_pk_fp8_f32(x1[2], x1[3], w1, true);
                    u32x2 o; o.x = (unsigned)w0; o.y = (unsigned)w1; *(u32x2*)(rowp + bj * 128) = o; } }
    }
};

__device__ __forceinline__ void transpose_item(const float* src, size_t ld, int nvalid, bf16_t* dst, size_t dld, LAS float* scr, int lane) {
    { const int j4 = lane & 7, k8 = lane >> 3;
        f32x4 v[8];
#pragma unroll
        for (int i = 0; i < 8; ++i) v[i] = 4 * j4 < nvalid ? *(const f32x4*)(src + (size_t)(8 * i + k8) * ld + 4 * j4) : (f32x4){0.f, 0.f, 0.f, 0.f};
#pragma unroll
        for (int i = 0; i < 8; ++i) { LAS float* d = scr + (8 * i + k8) * 33 + 4 * j4; d[0] = v[i][0]; d[1] = v[i][1]; d[2] = v[i][2]; d[3] = v[i][3]; } }
    LDS_WAIT(); asm volatile("" ::: "memory");
    const int c = lane & 7;
#pragma unroll
    for (int j = 0; j < 4; ++j) { const int n = (lane >> 3) + 8 * j; const LAS float* s = scr + (8 * c) * 33 + n;
        u32x4 o; o.x = pk2(s[0 * 33], s[1 * 33]); o.y = pk2(s[2 * 33], s[3 * 33]); o.z = pk2(s[4 * 33], s[5 * 33]); o.w = pk2(s[6 * 33], s[7 * 33]);
        *(u32x4*)(dst + (size_t)n * dld + 8 * c) = o; }
    LDS_WAIT(); asm volatile("" ::: "memory");
}
__device__ __forceinline__ void transpose_item2(const float* srcA, size_t ldA, bf16_t* dstA, size_t dldA, const float* srcB, size_t ldB, bf16_t* dstB, size_t dldB, LAS float* scr, int lane) {
    const int j4 = lane & 7, k8 = lane >> 3, c = lane & 7;
    f32x4 va[8], vb[8];
#pragma unroll
    for (int i = 0; i < 8; ++i) va[i] = *(const f32x4*)(srcA + (size_t)(8 * i + k8) * ldA + 4 * j4);
#pragma unroll
    for (int i = 0; i < 8; ++i) vb[i] = *(const f32x4*)(srcB + (size_t)(8 * i + k8) * ldB + 4 * j4);
#pragma unroll
    for (int i = 0; i < 8; ++i) { LAS float* d = scr + (8 * i + k8) * 33 + 4 * j4; d[0] = va[i][0]; d[1] = va[i][1]; d[2] = va[i][2]; d[3] = va[i][3]; }
    LDS_WAIT(); asm volatile("" ::: "memory");
#pragma unroll
    for (int j = 0; j < 4; ++j) { const int n = (lane >> 3) + 8 * j; const LAS float* sp = scr + (8 * c) * 33 + n;
        u32x4 o; o.x = pk2(sp[0 * 33], sp[1 * 33]); o.y = pk2(sp[2 * 33], sp[3 * 33]); o.z = pk2(sp[4 * 33], sp[5 * 33]); o.w = pk2(sp[6 * 33], sp[7 * 33]);
        *(u32x4*)(dstA + (size_t)n * dldA + 8 * c) = o; }
    LDS_WAIT(); asm volatile("" ::: "memory");
#pragma unroll
    for (int i = 0; i < 8; ++i) { LAS float* d = scr + (8 * i + k8) * 33 + 4 * j4; d[0] = vb[i][0]; d[1] = vb[i][1]; d[2] = vb[i][2]; d[3] = vb[i][3]; }
    LDS_WAIT(); asm volatile("" ::: "memory");
#pragma unroll
    for (int j = 0; j < 4; ++j) { const int n = (lane >> 3) + 8 * j; const LAS float* sp = scr + (8 * c) * 33 + n;
        u32x4 o; o.x = pk2(sp[0 * 33], sp[1 * 33]); o.y = pk2(sp[2 * 33], sp[3 * 33]); o.z = pk2(sp[4 * 33], sp[5 * 33]); o.w = pk2(sp[6 * 33], sp[7 * 33]);
        *(u32x4*)(dstB + (size_t)n * dldB + 8 * c) = o; }
    LDS_WAIT(); asm volatile("" ::: "memory");
}
struct In {
    const float *x, *c, *ada_w, *ada_b, *w_in, *lam_re, *lam_im, *log_step, *b_re, *b_im, *c_re, *c_im, *ssm_d, *glu_w, *cmp_pos, *cmp_w1, *cmp_w2, *rel_bias, *w_out,
        *ln1_g, *ln1_b, *router_w, *router_bias, *w_gate, *w_up, *w_down, *sh_gate, *sh_up, *sh_down, *ln2_g, *ln2_b;
};
static_assert(sizeof(In) == 31 * sizeof(void*), "In");

__device__ __forceinline__ void p0_small_weights(const In& in, unsigned char* ws, LAS float* scr, int gw, int NGW, int lane) {
    constexpr int I_WIN = 168 * 16, I_GLU = 64 * 8, I_WOUT = 32 * 16, I_ROUT = 8 * 16, I_SHGU = 16 * 16, I_SHD = 32 * 4, I_CW1 = 2 * 8 * 32, I_CW2 = 2 * 2 * 4;
    constexpr int NITEMS = I_WIN + I_GLU + I_WOUT + I_ROUT + I_SHGU + I_SHD + I_CW1 + I_CW2;
    for (int it = gw; it < NITEMS; it += NGW) {
        int r = it;
        if (r < I_WIN) { const int db = r / 16, kb = r % 16, n0 = 32 * db; int src, nv = 32;
            if (n0 < 3072) src = n0; else if (n0 < 5120) src = n0 + 48; else if (n0 < 5152) src = n0 - 2048; else if (n0 == 5152) { src = 3104; nv = 16; } else { src = 0; nv = 0; }
            transpose_item(in.w_in + (size_t)(64 * kb) * 5168 + src, 5168, nv, (bf16_t*)(ws + WS_WIN) + (size_t)n0 * 1024 + 64 * kb, 1024, scr, lane); continue; } r -= I_WIN;
        if (r < I_GLU) { const int db = r / 8, kb = r % 8, n0 = 32 * db, pn = n0 >> 8, half = (n0 >> 7) & 1, j = n0 & 127;
            transpose_item(in.glu_w + (size_t)(64 * kb) * 2048 + half * 1024 + pn * 128 + j, 2048, 32, (bf16_t*)(ws + WS_GLU) + (size_t)n0 * 512 + 64 * kb, 512, scr, lane); continue; } r -= I_GLU;
        if (r < I_WOUT) { const int db = r / 16, kb = r % 16;
            transpose_item(in.w_out + (size_t)(64 * kb) * 1024 + 32 * db, 1024, 32, (bf16_t*)(ws + WS_WOUT) + (size_t)(32 * db) * 1024 + 64 * kb, 1024, scr, lane); continue; } r -= I_WOUT;
        if (r < I_ROUT) { const int db = r / 16, kb = r % 16;
            transpose_item(in.router_w + (size_t)(64 * kb) * 256 + 32 * db, 256, 32, (bf16_t*)(ws + WS_ROUT) + (size_t)(32 * db) * 1024 + 64 * kb, 1024, scr, lane); continue; } r -= I_ROUT;
        if (r < I_SHGU) { const int db = r / 16, kb = r % 16, n0 = 32 * db, pn = n0 >> 8, half = (n0 >> 7) & 1, j = n0 & 127;
            transpose_item((half ? in.sh_up : in.sh_gate) + (size_t)(64 * kb) * 256 + pn * 128 + j, 256, 32, (bf16_t*)(ws + WS_SHGU) + (size_t)n0 * 1024 + 64 * kb, 1024, scr, lane); continue; } r -= I_SHGU;
        if (r < I_SHD) { const int db = r / 4, kb = r % 4;
            transpose_item(in.sh_down + (size_t)(64 * kb) * 1024 + 32 * db, 1024, 32, (bf16_t*)(ws + WS_SHD) + (size_t)(32 * db) * 256 + 64 * kb, 256, scr, lane); continue; } r -= I_SHD;
        if (r < I_CW1) { const int ts = r / 256, rr = r % 256, db = rr / 32, kb = rr % 32;
            transpose_item(in.cmp_w1 + (size_t)ts * 2048 * 256 + (size_t)(64 * kb) * 256 + 32 * db, 256, 32, (bf16_t*)(ws + WS_CW1) + (size_t)ts * 256 * 2048 + (size_t)(32 * db) * 2048 + 64 * kb, 2048, scr, lane); continue; } r -= I_CW1;
        { const int ts = r / 8, rr = r % 8, db = rr / 4, kb = rr % 4;
            transpose_item(in.cmp_w2 + (size_t)ts * 256 * 64 + (size_t)(64 * kb) * 64 + 32 * db, 64, 32, (bf16_t*)(ws + WS_CW2) + (size_t)ts * 256 * 256 + (size_t)(32 * db) * 256 + 64 * kb, 256, scr, lane); }
    }
    for (int i = gw * 64 + lane; i < 2 * 192 * 32; i += NGW * 64) { const int ts = i / (192 * 32), rr = i % (192 * 32); *(u32x4*)(ws + WS_CW2 + (size_t)ts * 256 * 512 + (size_t)64 * 512 + (size_t)rr * 16) = (u32x4){0u, 0u, 0u, 0u}; }
}
struct ConvItem { const float* src; size_t ld; bf16_t* dst; size_t dld; };
__device__ __forceinline__ void convert_expert_weights(const In& in, unsigned char* ws, LAS float* scr, int gw, int NGW, int lane, int part) {
    constexpr int I_GU = 256, I_D = 128;
    bool have = false; ConvItem pa{nullptr, 0, nullptr, 0};
    for (int it = gw; it < NEXP * (I_GU + I_D); it += NGW) {
        const int e = it / (I_GU + I_D), r = it % (I_GU + I_D);
        { const bool mid = e >= 63 && e <= 190; const bool early = r >= I_GU || !mid; if (early != (part == 0)) continue; }
        ConvItem d;
        if (r < I_GU) { const int db = r / 16, kb = r % 16, n0 = 32 * db, pn = n0 >> 8, half = (n0 >> 7) & 1, j = n0 & 127;
            d.src = (half ? in.w_up : in.w_gate) + (size_t)e * 1024 * 256 + (size_t)(64 * kb) * 256 + pn * 128 + j; d.ld = 256; d.dst = (bf16_t*)(ws + WS_WGU) + ((size_t)e * 512 + n0) * 1024 + 64 * kb; d.dld = 1024; }
        else { const int rr = r - I_GU, db = rr / 4, kb = rr % 4;
            d.src = in.w_down + (size_t)e * 256 * 1024 + (size_t)(64 * kb) * 1024 + 32 * db; d.ld = 1024; d.dst = (bf16_t*)(ws + WS_WD) + ((size_t)e * 1024 + 32 * db) * 256 + 64 * kb; d.dld = 256; }
        if (!have) { pa = d; have = true; }
        else { transpose_item2(pa.src, pa.ld, pa.dst, pa.dld, d.src, d.ld, d.dst, d.dld, scr, lane); have = false; }
    }
    if (have) transpose_item(pa.src, pa.ld, 32, pa.dst, pa.dld, scr, lane);
}

__device__ __forceinline__ void p0_mod(const In& in, unsigned char* ws, LAS unsigned char* lds, int tid) {
    LAS float* cond = (LAS float*)lds;
    LAS float* part = (LAS float*)(lds + 32768);
    for (int i = tid; i < 8192; i += NTHREADS) cond[i] = siluf_(in.c[i]);
    __syncthreads();
    const int col = tid % 24, ks = tid / 24, e = (int)blockIdx.x * 24 + col;
    if (tid < 504) {
        float a[8];
#pragma unroll
        for (int b = 0; b < 8; ++b) a[b] = 0.f;
        for (int k = ks; k < 1024; k += 21) { const float w = in.ada_w[(size_t)k * 6144 + e];
#pragma unroll
            for (int b = 0; b < 8; ++b) a[b] += cond[b * 1024 + k] * w; }
#pragma unroll
        for (int b = 0; b < 8; ++b) part[(ks * 24 + col) * 8 + b] = a[b];
    }
    __syncthreads();
    if (tid < 192) { const int c2 = tid % 24, b = tid / 24; float s = 0.f; for (int k = 0; k < 21; ++k) s += part[(k * 24 + c2) * 8 + b];
        const int e2 = (int)blockIdx.x * 24 + c2; ((float*)(ws + WS_MOD))[b * 6144 + e2] = s + in.ada_b[e2]; }
    __syncthreads();
}
__device__ __forceinline__ void p0_tables(const In& in, unsigned char* ws, LAS unsigned char* lds, int tid) {
    const int w = (int)blockIdx.x;
    if (w < 16) {
        const int ts = w >> 3, kq = w & 7, c = tid & 255, kh = tid >> 8; float s = 0.f;
        const float* pos = in.cmp_pos + ts * 2048; const float* w1 = in.cmp_w1 + (size_t)ts * 2048 * 256;
        for (int k = kq * 256 + kh * 128; k < kq * 256 + kh * 128 + 128; ++k) s += pos[k] * w1[(size_t)k * 256 + c];
        ((float*)(ws + WS_CTL + 131072))[((ts * 8 + kq) * 2 + kh) * 256 + c] = s;
    } else if (w == 16) {
        for (int i = tid; i < 16 * 132; i += NTHREADS) { const int h = i / 132, dd = i % 132; int bk;
            if (dd < 16) bk = dd; else { const int v = 16 + (int)(__logf((float)dd * (1.0f / 16.0f)) / 2.0794415416798357f * 16.0f); bk = v < 31 ? v : 31; }
            if (dd >= 128) bk = 31;
            ((float*)(ws + WS_TAB + TAB_LUT))[i] = in.rel_bias[bk * 16 + h] * 1.4426950408889634f; }
    } else if (w >= 32 && w < 64) {
        const int g = w - 32;
        LAS float* bbr = (LAS float*)lds; LAS float* bbi = bbr + 1024;
        if (tid < 64) { const int p = tid; const float lr = in.lam_re[g * 64 + p], li = in.lam_im[g * 64 + p], dt = expf(in.log_step[g]);
            const float mag = expf(lr * dt), ar = mag * cosf(li * dt), ai = mag * sinf(li * dt), den = lr * lr + li * li;
            const float kr = ((ar - 1.0f) * lr + ai * li) / den, ki = (ai * lr - (ar - 1.0f) * li) / den;
            for (int c = 0; c < 16; ++c) { const float br = in.b_re[(g * 64 + p) * 16 + c], bi = in.b_im[(g * 64 + p) * 16 + c]; bbr[p * 16 + c] = kr * br - ki * bi; bbi[p * 16 + c] = kr * bi + ki * br; }
            float* A = (float*)(ws + WS_S5T + S5_A) + (g * 64 + p) * 2; A[0] = ar; A[1] = ai;
            float xr = ar, xi = ai; for (int s = 0; s < 10; ++s) { const float nr = xr * xr - xi * xi, ni = 2.0f * xr * xi; xr = nr; xi = ni; }
            float* AC = (float*)(ws + WS_S5T + S5_AC) + (g * 64 + p) * 2; AC[0] = xr; AC[1] = xi; }
        __syncthreads();
        { const int f = tid >> 6, lane = tid & 63, pt = f >> 1, ri = f & 1, p = 16 * pt + (lane & 15), q = lane >> 4;
            bf16_t* dst = (bf16_t*)(ws + WS_S5T + S5_AFR) + ((size_t)(g * 8 + f) * 64 + lane) * 8;
            for (int j = 0; j < 8; ++j) { const float v = q < 2 ? (ri ? bbi : bbr)[p * 16 + 8 * q + j] : 0.f; dst[j] = (bf16_t)f2bf(v); } }
        if (tid < 256) { const int s = tid >> 6, lane = tid & 63, c = lane & 15, q = lane >> 4;
            bf16_t* dst = (bf16_t*)(ws + WS_S5T + S5_CFR) + ((size_t)(g * 4 + s) * 64 + lane) * 8;
            for (int j = 0; j < 8; ++j) { const int k = 32 * s + 8 * q + j, p = k >> 1; const float v = (k & 1) ? -in.c_im[(g * 16 + c) * 64 + p] : in.c_re[(g * 16 + c) * 64 + p]; dst[j] = (bf16_t)f2bf(v); } }
        __syncthreads();
    }
}

struct RowV { f32x4 v[4]; };
__device__ __forceinline__ RowV row_load(const float* p, int lane) { RowV r; const f32x4* q = (const f32x4*)p + lane;
#pragma unroll
    for (int j = 0; j < 4; ++j) r.v[j] = q[64 * j]; return r; }
__device__ __forceinline__ RowV row_load_bf16(const bf16_t* p, int lane) { RowV r; const u32x2* q = (const u32x2*)p + lane;
#pragma unroll
    for (int j = 0; j < 4; ++j) { const u32x2 w = q[64 * j]; r.v[j] = (f32x4){bflo(w.x), bfhi(w.x), bflo(w.y), bfhi(w.y)}; } return r; }
__device__ __forceinline__ void row_norm(RowV& r) {
    float s = 0.f;
#pragma unroll
    for (int j = 0; j < 4; ++j) s += (r.v[j].x + r.v[j].y) + (r.v[j].z + r.v[j].w);
    const float mean = wave_sum(s) * (1.f / DM); float s2 = 0.f;
#pragma unroll
    for (int j = 0; j < 4; ++j) { r.v[j] = r.v[j] - mean; s2 += (r.v[j].x * r.v[j].x + r.v[j].y * r.v[j].y) + (r.v[j].z * r.v[j].z + r.v[j].w * r.v[j].w); }
    const float rstd = 1.f / sqrtf(wave_sum(s2) * (1.f / DM) + LN_EPS);
#pragma unroll
    for (int j = 0; j < 4; ++j) r.v[j] = r.v[j] * rstd;
}
__device__ __forceinline__ void row_norm_stats(RowV& r, float& mean_o, float& rstd_o) {
    float s = 0.f;
#pragma unroll
    for (int j = 0; j < 4; ++j) s += (r.v[j].x + r.v[j].y) + (r.v[j].z + r.v[j].w);
    const float mean = wave_sum(s) * (1.f / DM); float s2 = 0.f;
#pragma unroll
    for (int j = 0; j < 4; ++j) { r.v[j] = r.v[j] - mean; s2 += (r.v[j].x * r.v[j].x + r.v[j].y * r.v[j].y) + (r.v[j].z * r.v[j].z + r.v[j].w * r.v[j].w); }
    const float rstd = 1.f / sqrtf(wave_sum(s2) * (1.f / DM) + LN_EPS);
#pragma unroll
    for (int j = 0; j < 4; ++j) r.v[j] = r.v[j] * rstd;
    mean_o = mean; rstd_o = rstd;
}
__device__ __forceinline__ void row_store_bf16(bf16_t* p, const RowV& r, int lane) { u32x2* o = (u32x2*)p + lane;
#pragma unroll
    for (int j = 0; j < 4; ++j) { u32x2 w; w.x = pk2(r.v[j].x, r.v[j].y); w.y = pk2(r.v[j].z, r.v[j].w); o[64 * j] = w; } }
__device__ __forceinline__ void ph_h1(const In& in, unsigned char* ws, int gw, int NGW, int lane) {
    const float* mod = (const float*)(ws + WS_MOD);
    for (int row = gw; row < MTOK; row += NGW) { const int b = row >> 13;
        RowV r = row_load(in.x + (size_t)row * DM, lane); row_norm(r);
        const RowV sh = row_load(mod + b * 6144, lane), sc = row_load(mod + b * 6144 + 1024, lane);
#pragma unroll
        for (int j = 0; j < 4; ++j) r.v[j] = r.v[j] * (sc.v[j] + 1.0f) + sh.v[j];
        row_store_bf16((bf16_t*)(ws + WS_H1) + (size_t)row * DM, r, lane); }
}
__device__ __forceinline__ void ph_ln1(const In& in, unsigned char* ws, float* r1, int gw, int NGW, int lane) {
    const float* mod = (const float*)(ws + WS_MOD);
    const RowV g = row_load(in.ln1_g, lane), bb = row_load(in.ln1_b, lane);
    for (int row = gw; row < MTOK; row += NGW) { const int b = row >> 13;
        RowV r = row_load_bf16((const bf16_t*)(r1 + (size_t)row * DM), lane); float mean, rstd; row_norm_stats(r, mean, rstd);
        if (lane == 0) *(f32x2*)((float*)(ws + WS_LNST) + (size_t)row * 2) = (f32x2){mean, rstd};
#pragma unroll
        for (int j = 0; j < 4; ++j) r.v[j] = r.v[j] * g.v[j] + bb.v[j];
        row_norm(r);
        const RowV sh = row_load(mod + b * 6144 + 3072, lane), sc = row_load(mod + b * 6144 + 4096, lane);
#pragma unroll
        for (int j = 0; j < 4; ++j) r.v[j] = r.v[j] * (sc.v[j] + 1.0f) + sh.v[j];
        row_store_bf16((bf16_t*)(ws + WS_H2) + (size_t)row * DM, r, lane); }
}
__device__ __forceinline__ void final_row(const In& in, unsigned char* ws, float* out, int tok, int chunk, const RowV& g, const RowV& bb, const RowV& g1, const RowV& b1, int lane) {
    const float* mod = (const float*)(ws + WS_MOD); const int b = tok >> 13;
    RowV v = row_load_bf16((const bf16_t*)(out + (size_t)tok * DM), lane); const RowV g2 = row_load(mod + b * 6144 + 5120, lane);
    const f32x2 stt = *(const f32x2*)((const float*)(ws + WS_LNST) + (size_t)tok * 2);
    const unsigned* sp = (const unsigned*)(ws + WS_OUTS + (size_t)(tok - chunk * CHUNK_TOK) * 8 * DM) + lane;
    const unsigned* shp = (const unsigned*)(ws + WS_SHOUT + (size_t)tok * DM) + lane;
    f32x4 acc[4];
#pragma unroll
    for (int j = 0; j < 4; ++j) { const int w = (int)shp[64 * j]; const f32x2 lo = __builtin_amdgcn_cvt_pk_f32_fp8(w, false), hi = __builtin_amdgcn_cvt_pk_f32_fp8(w, true); acc[j] = (f32x4){lo.x, lo.y, hi.x, hi.y}; }
#pragma unroll
    for (int k = 0; k < 8; ++k)
#pragma unroll
        for (int j = 0; j < 4; ++j) { const int w = (int)sp[k * 256 + 64 * j]; const f32x2 lo = __builtin_amdgcn_cvt_pk_f32_fp8(w, false), hi = __builtin_amdgcn_cvt_pk_f32_fp8(w, true);
            acc[j] = acc[j] + (f32x4){lo.x, lo.y, hi.x, hi.y}; }
#pragma unroll
    for (int j = 0; j < 4; ++j) { const f32x4 x1 = (v.v[j] - stt.x) * stt.y * g1.v[j] + b1.v[j]; v.v[j] = x1 * DN_ALPHA + g2.v[j] * (acc[j] * (1.0f / OUTS_SCALE)); }
    row_norm(v);
    f32x4* o = (f32x4*)(out + (size_t)tok * DM) + lane;
#pragma unroll
    for (int j = 0; j < 4; ++j) o[64 * j] = v.v[j] * g.v[j] + bb.v[j];
}
__device__ __forceinline__ void final_chunk(const In& in, unsigned char* ws, float* out, unsigned* ticket, int chunk, volatile LAS unsigned* bcast, int tid, int wave, int lane) {
    int ll = lane; asm volatile("" : "+v"(ll));
    const RowV g = row_load(in.ln2_g, ll), bb = row_load(in.ln2_b, ll), g1 = row_load(in.ln1_g, ll), b1 = row_load(in.ln1_b, ll);
    for (;;) {
        __syncthreads();
        if (tid == 0) bcast[0] = __hip_atomic_fetch_add(ticket, 64u, RLX_AGENT);
        __syncthreads();
        const unsigned base = bcast[0];
        if (base >= (unsigned)chunk_ntok(chunk)) break;
        for (int i = 0; i < 8; ++i) final_row(in, ws, out, chunk * CHUNK_TOK + (int)base + wave * 8 + i, chunk, g, bb, g1, b1, lane);
    }
}
constexpr int S5_LDS_PER_WAVE = 4352;
template <bool FULL>
__device__ __forceinline__ void s5_task(const In& in, unsigned char* ws, LAS unsigned char* wlds, int b, int g, int ch, int lane) {
    const int col = lane & 15, q = lane >> 4;
    LAS unsigned* BU = (LAS unsigned*)wlds;
    LAS unsigned char* XB = wlds;
    bf16x8 afr[8], cfr[4];
#pragma unroll
    for (int f = 0; f < 8; ++f) afr[f] = *(const bf16x8*)((const bf16_t*)(ws + WS_S5T + S5_AFR) + ((size_t)(g * 8 + f) * 64 + lane) * 8);
    if (FULL) {
#pragma unroll
        for (int s = 0; s < 4; ++s) cfr[s] = *(const bf16x8*)((const bf16_t*)(ws + WS_S5T + S5_CFR) + ((size_t)(g * 4 + s) * 64 + lane) * 8);
    }
    const float ar = ((const float*)(ws + WS_S5T + S5_A))[(g * 64 + lane) * 2], ai = ((const float*)(ws + WS_S5T + S5_A))[(g * 64 + lane) * 2 + 1];
    float xr = 0.f, xi = 0.f;
    float* st = (float*)(ws + WS_S5ST);
    if (FULL) {
        const float cr_ = ((const float*)(ws + WS_S5T + S5_AC))[(g * 64 + lane) * 2], ci_ = ((const float*)(ws + WS_S5T + S5_AC))[(g * 64 + lane) * 2 + 1];
        for (int c2 = 0; c2 < ch; ++c2) { const float sr = st[((size_t)((b * 32 + g) * 8 + c2) * 64 + lane) * 2], si = st[((size_t)((b * 32 + g) * 8 + c2) * 64 + lane) * 2 + 1];
            const float nr = cr_ * xr - ci_ * xi + sr, ni = cr_ * xi + ci_ * xr + si; xr = nr; xi = ni; }
    }
    const bf16_t* U = (const bf16_t*)(ws + WS_U);
    f32x4 dsk = (f32x4){0.f, 0.f, 0.f, 0.f};
    if (FULL) dsk = *(const f32x4*)(in.ssm_d + g * 16 + 4 * q);
    const size_t row00 = (size_t)b * SEQ + (size_t)ch * 1024;
    for (int sb = 0; sb < 64; ++sb) {
        const size_t row0 = row00 + 16 * sb;
        bf16x8 ufr = (bf16x8){0, 0, 0, 0, 0, 0, 0, 0};
        if (q < 2) ufr = *(const bf16x8*)(U + (row0 + col) * 512 + g * 16 + 8 * q);
#pragma unroll
        for (int pt = 0; pt < 4; ++pt) {
            const f32x4 dr = __builtin_amdgcn_mfma_f32_16x16x32_bf16(afr[2 * pt], ufr, (f32x4){0.f, 0.f, 0.f, 0.f}, 0, 0, 0);
            const f32x4 di = __builtin_amdgcn_mfma_f32_16x16x32_bf16(afr[2 * pt + 1], ufr, (f32x4){0.f, 0.f, 0.f, 0.f}, 0, 0, 0);
            u32x4 w; w.x = pk2(dr[0], di[0]); w.y = pk2(dr[1], di[1]); w.z = pk2(dr[2], di[2]); w.w = pk2(dr[3], di[3]);
            *(LAS u32x4*)(BU + col * 68 + 16 * pt + 4 * q) = w; }
        asm volatile("s_waitcnt lgkmcnt(0)" ::: "memory");
#pragma unroll
        for (int t = 0; t < 16; ++t) { const unsigned bw = BU[t * 68 + lane]; const float br = bflo(bw), bi = bfhi(bw);
            const float nr = ar * xr - ai * xi + br, ni = ar * xi + ai * xr + bi; xr = nr; xi = ni;
            if (FULL) *(LAS unsigned*)(XB + t * 272 + 4 * lane) = pk2(xr, xi); }
        asm volatile("s_waitcnt lgkmcnt(0)" ::: "memory");
        if (FULL) {
            f32x4 y = (f32x4){0.f, 0.f, 0.f, 0.f};
#pragma unroll
            for (int s = 0; s < 4; ++s) { const bf16x8 xf = *(const LAS bf16x8*)(XB + col * 272 + (32 * s + 8 * q) * 2); y = __builtin_amdgcn_mfma_f32_16x16x32_bf16(cfr[s], xf, y, 0, 0, 0); }
            const u32x2 uw = *(const u32x2*)(U + (row0 + col) * 512 + g * 16 + 4 * q);
            const f32x4 uv = (f32x4){bflo(uw.x), bfhi(uw.x), bflo(uw.y), bfhi(uw.y)};
            y = y + dsk * uv;
            u32x2 o; o.x = pk2(gelu_tanh(y[0]), gelu_tanh(y[1])); o.y = pk2(gelu_tanh(y[2]), gelu_tanh(y[3]));
            *(u32x2*)((bf16_t*)(ws + WS_Z) + (row0 + col) * 512 + g * 16 + 4 * q) = o;
            asm volatile("s_waitcnt lgkmcnt(0)" ::: "memory");
        }
    }
    if (!FULL) { st[((size_t)((b * 32 + g) * 8 + ch) * 64 + lane) * 2] = xr; st[((size_t)((b * 32 + g) * 8 + ch) * 64 + lane) * 2 + 1] = xi; }
}

constexpr int NSA_KB = 0, NSA_VB = 32768, NSA_IMP = 65536, NSA_RES = 65536;
static_assert(NSA_IMP + 67584 <= MISC_OFF && NSA_RES + 65536 <= MISC_OFF, "attention LDS map");
__device__ __forceinline__ bf16x8 pack8(const f32x4& a, const f32x4& b) {
    u32x4 w; w.x = pk2(a[0], a[1]); w.y = pk2(a[2], a[3]); w.z = pk2(b[0], b[1]); w.w = pk2(b[2], b[3]); return __builtin_bit_cast(bf16x8, w);
}
struct Softmax { float m; f32x4 l; };
typedef unsigned u32x2s __attribute__((ext_vector_type(2)));
__device__ __forceinline__ float fmax_x16(float x) { return fmaxf(x, __shfl_xor(x, 16)); }
__device__ __forceinline__ float fmax_x32(float x) { return fmaxf(x, __shfl_xor(x, 32)); }
__device__ __forceinline__ float fadd_x16(float x) { return x + __shfl_xor(x, 16); }
__device__ __forceinline__ float fadd_x32(float x) { return x + __shfl_xor(x, 32); }
__device__ __forceinline__ unsigned or_x16(unsigned u) { return u | __shfl_xor(u, 16); }
__device__ __forceinline__ unsigned or_x32(unsigned u) { return u | __shfl_xor(u, 32); }
__device__ __forceinline__ float dpp_x1(float x) { return __builtin_bit_cast(float, __builtin_amdgcn_update_dpp(0, __builtin_bit_cast(int, x), 0xB1, 0xF, 0xF, true)); }
__device__ __forceinline__ float dpp_x2(float x) { return __builtin_bit_cast(float, __builtin_amdgcn_update_dpp(0, __builtin_bit_cast(int, x), 0x4E, 0xF, 0xF, true)); }
__device__ __forceinline__ int dpp_x1i(int x) { return __builtin_amdgcn_update_dpp(0, x, 0xB1, 0xF, 0xF, true); }
__device__ __forceinline__ int dpp_x2i(int x) { return __builtin_amdgcn_update_dpp(0, x, 0x4E, 0xF, 0xF, true); }
__device__ __forceinline__ float ex2(float x) { return __builtin_amdgcn_exp2f(x); }
__device__ __forceinline__ float max16(const f32x4 (&S)[4]) {
    float a = fmaxf(fmaxf(S[0][0], S[0][1]), S[0][2]); a = fmaxf(fmaxf(a, S[0][3]), S[1][0]); a = fmaxf(fmaxf(a, S[1][1]), S[1][2]);
    float b = fmaxf(fmaxf(S[2][0], S[2][1]), S[2][2]); b = fmaxf(fmaxf(b, S[2][3]), S[3][0]); b = fmaxf(fmaxf(b, S[3][1]), S[3][2]);
    return fmaxf(fmaxf(a, S[1][3]), fmaxf(b, S[3][3]));
}
#define ONES8 ((bf16x8){(bf16_t)0x3F80, (bf16_t)0x3F80, (bf16_t)0x3F80, (bf16_t)0x3F80, (bf16_t)0x3F80, (bf16_t)0x3F80, (bf16_t)0x3F80, (bf16_t)0x3F80})
__device__ __forceinline__ void best_pair(float& bv, int& bj, float ov, int oj) { const bool take = (ov > bv) | ((ov == bv) & (oj < bj)); bv = take ? ov : bv; bj = take ? oj : bj; }
__device__ __forceinline__ void best_x16(float& bv, int& bj) { const float ov = __shfl_xor(bv, 16); const int oj = __shfl_xor(bj, 16); best_pair(bv, bj, ov, oj); }
__device__ __forceinline__ void best_x32(float& bv, int& bj) { const float ov = __shfl_xor(bv, 32); const int oj = __shfl_xor(bj, 32); best_pair(bv, bj, ov, oj); }
struct Stage { u32x4 k, v; };
__device__ __forceinline__ void stage_load(Stage& s, const unsigned char* kg, size_t kstride, const unsigned char* vg, size_t vstride, int tid, bool hasv) {
    const int row = tid >> 3, ch = tid & 7;
    s.k = *(const u32x4*)(kg + (size_t)row * kstride + ch * 16);
    if (hasv) s.v = *(const u32x4*)(vg + (size_t)row * vstride + ch * 16);
}
__device__ __forceinline__ void stage_store(const Stage& s, LAS unsigned char* lds, int buf, int tid, bool hasv) {
    const int row = tid >> 3, ch = tid & 7, off = row * 128 + ((ch ^ (row & 7)) << 4);
    *(LAS u32x4*)(lds + NSA_KB + buf * 8192 + off) = s.k;
    if (hasv) *(LAS u32x4*)(lds + NSA_VB + buf * 8192 + off) = s.v;
}
__device__ __forceinline__ bf16x8 lds_frag(const LAS unsigned char* base, int row, int ch) { return *(const LAS bf16x8*)(base + row * 128 + ((ch ^ (row & 7)) << 4)); }

__device__ __forceinline__ void select_blocks(const LAS float* impw, int tl, int r, int q, int cur, unsigned (&w)[4]) {
    w[0] = w[1] = w[2] = w[3] = 0u;
    if (cur < 16) { w[0] = (2u << cur) - 1u; return; }
    const int s16 = r * 4 + q;
    float cand[8];
#pragma unroll
    for (int k = 0; k < 8; ++k) { const int j = s16 + 16 * k; cand[k] = (j >= 1 && j <= cur - 2) ? impw[tl * 264 + j] + impw[tl * 264 + 132 + j] : -1.0f; }
    unsigned chosen = 0u;
    for (int it = 0; it < 13; ++it) {
        float bv = -2.0f; int bj = 1 << 20;
#pragma unroll
        for (int k = 0; k < 8; ++k) { const bool ok = !((chosen >> k) & 1u) && cand[k] > bv; bv = ok ? cand[k] : bv; bj = ok ? s16 + 16 * k : bj; }
        best_pair(bv, bj, dpp_x1(bv), dpp_x1i(bj)); best_pair(bv, bj, dpp_x2(bv), dpp_x2i(bj)); best_x16(bv, bj); best_x32(bv, bj);
        if ((bj & 15) == s16) chosen |= 1u << (bj >> 4);
    }
#pragma unroll
    for (int k = 0; k < 8; ++k) { const unsigned bit = ((chosen >> k) & 1u) << (s16 + 16 * (k & 1)); w[k >> 1] |= bit; }
#pragma unroll
    for (int x = 0; x < 4; ++x) { unsigned v = w[x]; v |= (unsigned)dpp_x1i((int)v); v |= (unsigned)dpp_x2i((int)v); v = or_x16(v); v = or_x32(v); w[x] = v; }
    w[0] |= 1u;
#pragma unroll
    for (int x = 0; x < 4; ++x) { if (((cur - 1) >> 5) == x) w[x] |= 1u << ((cur - 1) & 31); if ((cur >> 5) == x) w[x] |= 1u << (cur & 31); }
}

__device__ __forceinline__ float dpp_r4(float x) { return __builtin_bit_cast(float, __builtin_amdgcn_update_dpp(0, __builtin_bit_cast(int, x), 0x124, 0xF, 0xF, true)); }
__device__ __forceinline__ float dpp_r8(float x) { return __builtin_bit_cast(float, __builtin_amdgcn_update_dpp(0, __builtin_bit_cast(int, x), 0x128, 0xF, 0xF, true)); }
__device__ __forceinline__ int dpp_r4i(int x) { return __builtin_amdgcn_update_dpp(0, x, 0x124, 0xF, 0xF, true); }
__device__ __forceinline__ int dpp_r8i(int x) { return __builtin_amdgcn_update_dpp(0, x, 0x128, 0xF, 0xF, true); }
__device__ __forceinline__ void select_blocks8(const LAS float* impw, LAS unsigned* mk, int lane, int cur, unsigned (&u)[2][4]) {
    const int i = lane & 15, k = lane >> 4;
    unsigned m4[2][4];
    if (cur < 16) {
#pragma unroll
        for (int c = 0; c < 2; ++c) { m4[c][0] = (2u << cur) - 1u; m4[c][1] = 0u; m4[c][2] = 0u; m4[c][3] = 0u; }
    } else {
        float cand[2][8]; unsigned chosen[2] = {0u, 0u};
#pragma unroll
        for (int c = 0; c < 2; ++c)
#pragma unroll
            for (int m = 0; m < 8; ++m) { const int j = i + 16 * m; const LAS float* p = impw + (4 * c + k) * 264; const float va = p[j], vb2 = p[132 + j];
                cand[c][m] = ((j >= 1) & (j <= cur - 2)) ? va + vb2 : -1.0f; }
        for (int it = 0; it < 13; ++it) {
#pragma unroll
            for (int c = 0; c < 2; ++c) {
                float bv = -2.0f; int bj = 1 << 20;
#pragma unroll
                for (int m = 0; m < 8; ++m) { const bool ok = !((chosen[c] >> m) & 1u) && cand[c][m] > bv; bv = ok ? cand[c][m] : bv; bj = ok ? i + 16 * m : bj; }
                best_pair(bv, bj, dpp_r8(bv), dpp_r8i(bj)); best_pair(bv, bj, dpp_r4(bv), dpp_r4i(bj)); best_pair(bv, bj, dpp_x2(bv), dpp_x2i(bj)); best_pair(bv, bj, dpp_x1(bv), dpp_x1i(bj));
                if ((bj & 15) == i) chosen[c] |= 1u << (bj >> 4);
            }
        }
        const int c1 = cur - 1;
        const unsigned long long flo = 1ull | (c1 < 64 ? 1ull << c1 : 0ull) | (cur < 64 ? 1ull << cur : 0ull), fhi = (c1 >= 64 ? 1ull << (c1 - 64) : 0ull) | (cur >= 64 ? 1ull << (cur - 64) : 0ull);
#pragma unroll
        for (int c = 0; c < 2; ++c) {
#pragma unroll
            for (int x = 0; x < 4; ++x) m4[c][x] = 0u;
#pragma unroll
            for (int m = 0; m < 8; ++m) m4[c][m >> 1] |= ((chosen[c] >> m) & 1u) << (i + 16 * (m & 1));
#pragma unroll
            for (int x = 0; x < 4; ++x) { unsigned v = m4[c][x]; v |= (unsigned)dpp_r8i((int)v); v |= (unsigned)dpp_r4i((int)v); v |= (unsigned)dpp_x2i((int)v); v |= (unsigned)dpp_x1i((int)v); m4[c][x] = v; }
            m4[c][0] |= (unsigned)flo; m4[c][1] |= (unsigned)(flo >> 32); m4[c][2] |= (unsigned)fhi; m4[c][3] |= (unsigned)(fhi >> 32);
        }
    }
#pragma unroll
    for (int c = 0; c < 2; ++c) {
        if (i == 0) *(LAS u32x4*)(mk + (4 * c + k) * 4) = (u32x4){m4[c][0], m4[c][1], m4[c][2], m4[c][3]};
#pragma unroll
        for (int x = 0; x < 4; ++x) { unsigned v = m4[c][x]; v = or_x16(v); v = or_x32(v); u[c][x] = __builtin_amdgcn_readfirstlane(v); }
    }
}

template <int MODE, bool SELMASK>
__device__ __forceinline__ void attn_block(const LAS unsigned char* kb, const LAS unsigned char* vb, const bf16x8 (&qf)[2][2], int col, int q, const int (&tq)[2], int key0, const LAS float* nbq, float bias_far,
                                           bool sel0, bool sel1, Softmax (&st)[2], f32x4 (&O)[2][4]) {
    const f32x4 z4 = (f32x4){0.f, 0.f, 0.f, 0.f};
    const float NEG = -__builtin_inff();
    f32x4 S[2][4];
#pragma unroll
    for (int kt = 0; kt < 4; ++kt) { const bf16x8 k0 = lds_frag(kb, 16 * kt + col, q), k1 = lds_frag(kb, 16 * kt + col, 4 + q);
#pragma unroll
        for (int c = 0; c < 2; ++c) { S[c][kt] = __builtin_amdgcn_mfma_f32_16x16x32_bf16(k0, qf[c][0], z4, 0, 0, 0); S[c][kt] = __builtin_amdgcn_mfma_f32_16x16x32_bf16(k1, qf[c][1], S[c][kt], 0, 0, 0); } }
    float rowb[2] = {bias_far, bias_far}, cm[2];
#pragma unroll
    for (int c = 0; c < 2; ++c) {
        const bool sel = c == 0 ? sel0 : sel1;
        if (MODE == 0) { if (SELMASK) rowb[c] = sel ? bias_far : NEG; }
        else if (MODE == 1) { rowb[c] = (SELMASK && !sel) ? NEG : 0.f;
            const LAS float* bp = nbq - (tq[c] - key0);
#pragma unroll
            for (int kt = 0; kt < 4; ++kt) S[c][kt] = S[c][kt] + *(const LAS f32x4*)(bp + 16 * kt); }
        else {
#pragma unroll
            for (int kt = 0; kt < 4; ++kt)
#pragma unroll
                for (int e = 0; e < 4; ++e) { const int d = tq[c] - (key0 + 16 * kt + 4 * q + e); S[c][kt][e] = d < 512 ? S[c][kt][e] : NEG; } }
        cm[c] = max16(S[c]) + rowb[c];
    }
    if (__any(cm[0] > st[0].m || cm[1] > st[1].m)) {
#pragma unroll
        for (int c = 0; c < 2; ++c) { float x = fmax_x16(cm[c]); x = fmax_x32(x);
            const float mn = fmaxf(st[c].m, x), alpha = ex2(st[c].m - mn);
            st[c].m = mn; st[c].l = st[c].l * alpha;
#pragma unroll
            for (int dt = 0; dt < 4; ++dt) O[c][dt] = O[c][dt] * alpha; }
    }
    bf16x8 pf[2][2];
#pragma unroll
    for (int c = 0; c < 2; ++c) {
        const float off = rowb[c] - st[c].m;
#pragma unroll
        for (int kt = 0; kt < 4; ++kt) { f32x4 p = S[c][kt] + off;
#pragma unroll
            for (int e = 0; e < 4; ++e) p[e] = ex2(p[e]);
            S[c][kt] = p; }
        pf[c][0] = pack8(S[c][0], S[c][1]); pf[c][1] = pack8(S[c][2], S[c][3]);
        st[c].l = __builtin_amdgcn_mfma_f32_16x16x32_bf16(ONES8, pf[c][0], st[c].l, 0, 0, 0); st[c].l = __builtin_amdgcn_mfma_f32_16x16x32_bf16(ONES8, pf[c][1], st[c].l, 0, 0, 0);
    }
#pragma unroll
    for (int c32 = 0; c32 < 2; ++c32)
#pragma unroll
        for (int dt = 0; dt < 4; ++dt) { const bf16x8 vf = lds_frag(vb, 16 * dt + col, 4 * c32 + q);
            O[0][dt] = __builtin_amdgcn_mfma_f32_16x16x32_bf16(vf, pf[0][c32], O[0][dt], 0, 0, 0);
            O[1][dt] = __builtin_amdgcn_mfma_f32_16x16x32_bf16(vf, pf[1][c32], O[1][dt], 0, 0, 0); }
}

template <int C>
__device__ __forceinline__ void attn_block_far1(const LAS unsigned char* kb, const LAS unsigned char* vb, const bf16x8 (&qf)[2][2], int col, int q, float bias_far, bool sel, Softmax (&st)[2], f32x4 (&O)[2][4]) {
    const f32x4 z4 = (f32x4){0.f, 0.f, 0.f, 0.f};
    const float NEG = -__builtin_inff();
    f32x4 S[4];
#pragma unroll
    for (int kt = 0; kt < 4; ++kt) { const bf16x8 k0 = lds_frag(kb, 16 * kt + col, q), k1 = lds_frag(kb, 16 * kt + col, 4 + q);
        S[kt] = __builtin_amdgcn_mfma_f32_16x16x32_bf16(k0, qf[C][0], z4, 0, 0, 0); S[kt] = __builtin_amdgcn_mfma_f32_16x16x32_bf16(k1, qf[C][1], S[kt], 0, 0, 0); }
    const float rowb = sel ? bias_far : NEG;
    float cm = max16(S) + rowb;
    if (__any(cm > st[C].m)) { float x = fmax_x16(cm); x = fmax_x32(x);
        const float mn = fmaxf(st[C].m, x), alpha = ex2(st[C].m - mn);
        st[C].m = mn; st[C].l = st[C].l * alpha;
#pragma unroll
        for (int dt = 0; dt < 4; ++dt) O[C][dt] = O[C][dt] * alpha; }
    const float off = rowb - st[C].m;
#pragma unroll
    for (int kt = 0; kt < 4; ++kt) { f32x4 p = S[kt] + off;
#pragma unroll
        for (int e = 0; e < 4; ++e) p[e] = ex2(p[e]);
        S[kt] = p; }
    const bf16x8 pf0 = pack8(S[0], S[1]), pf1 = pack8(S[2], S[3]);
    st[C].l = __builtin_amdgcn_mfma_f32_16x16x32_bf16(ONES8, pf0, st[C].l, 0, 0, 0); st[C].l = __builtin_amdgcn_mfma_f32_16x16x32_bf16(ONES8, pf1, st[C].l, 0, 0, 0);
#pragma unroll
    for (int dt = 0; dt < 4; ++dt) { const bf16x8 vf0 = lds_frag(vb, 16 * dt + col, q), vf1 = lds_frag(vb, 16 * dt + col, 4 + q);
        O[C][dt] = __builtin_amdgcn_mfma_f32_16x16x32_bf16(vf0, pf0, O[C][dt], 0, 0, 0); O[C][dt] = __builtin_amdgcn_mfma_f32_16x16x32_bf16(vf1, pf1, O[C][dt], 0, 0, 0); }
}

template <bool SELMASK>
__device__ __forceinline__ void attn_far_fast(const LAS unsigned char* kb, const LAS unsigned char* vb, const bf16x8 (&qf)[2][2], int col, int q, float bias_far, bool sel0, bool sel1, Softmax (&st)[2], f32x4 (&O)[2][4]) {
    const f32x4 z4 = (f32x4){0.f, 0.f, 0.f, 0.f};
    const float NEG = -__builtin_inff();
    f32x4 S[2][4];
#pragma unroll
    for (int kt = 0; kt < 4; ++kt) { const bf16x8 k0 = lds_frag(kb, 16 * kt + col, q), k1 = lds_frag(kb, 16 * kt + col, 4 + q);
#pragma unroll
        for (int c = 0; c < 2; ++c) { S[c][kt] = __builtin_amdgcn_mfma_f32_16x16x32_bf16(k0, qf[c][0], z4, 0, 0, 0); S[c][kt] = __builtin_amdgcn_mfma_f32_16x16x32_bf16(k1, qf[c][1], S[c][kt], 0, 0, 0); } }
    bf16x8 pf[2][2];
#pragma unroll
    for (int c = 0; c < 2; ++c) {
        const bool sel = c == 0 ? sel0 : sel1;
        const float off = ((SELMASK && !sel) ? NEG : bias_far) - st[c].m;
#pragma unroll
        for (int kt = 0; kt < 4; ++kt) { f32x4 p = S[c][kt] + off;
#pragma unroll
            for (int e = 0; e < 4; ++e) p[e] = ex2(p[e]);
            S[c][kt] = p; }
        pf[c][0] = pack8(S[c][0], S[c][1]); pf[c][1] = pack8(S[c][2], S[c][3]);
        st[c].l = __builtin_amdgcn_mfma_f32_16x16x32_bf16(ONES8, pf[c][0], st[c].l, 0, 0, 0); st[c].l = __builtin_amdgcn_mfma_f32_16x16x32_bf16(ONES8, pf[c][1], st[c].l, 0, 0, 0);
    }
#pragma unroll
    for (int c32 = 0; c32 < 2; ++c32)
#pragma unroll
        for (int dt = 0; dt < 4; ++dt) { const bf16x8 vf = lds_frag(vb, 16 * dt + col, 4 * c32 + q);
            O[0][dt] = __builtin_amdgcn_mfma_f32_16x16x32_bf16(vf, pf[0][c32], O[0][dt], 0, 0, 0);
            O[1][dt] = __builtin_amdgcn_mfma_f32_16x16x32_bf16(vf, pf[1][c32], O[1][dt], 0, 0, 0); }
}
template <int C>
__device__ __forceinline__ void attn_far1_fast(const LAS unsigned char* kb, const LAS unsigned char* vb, const bf16x8 (&qf)[2][2], int col, int q, float bias_far, bool sel, Softmax (&st)[2], f32x4 (&O)[2][4]) {
    const f32x4 z4 = (f32x4){0.f, 0.f, 0.f, 0.f};
    const float NEG = -__builtin_inff();
    f32x4 S[4];
#pragma unroll
    for (int kt = 0; kt < 4; ++kt) { const bf16x8 k0 = lds_frag(kb, 16 * kt + col, q), k1 = lds_frag(kb, 16 * kt + col, 4 + q);
        S[kt] = __builtin_amdgcn_mfma_f32_16x16x32_bf16(k0, qf[C][0], z4, 0, 0, 0); S[kt] = __builtin_amdgcn_mfma_f32_16x16x32_bf16(k1, qf[C][1], S[kt], 0, 0, 0); }
    const float off = (sel ? bias_far : NEG) - st[C].m;
#pragma unroll
    for (int kt = 0; kt < 4; ++kt) { f32x4 p = S[kt] + off;
#pragma unroll
        for (int e = 0; e < 4; ++e) p[e] = ex2(p[e]);
        S[kt] = p; }
    const bf16x8 pf0 = pack8(S[0], S[1]), pf1 = pack8(S[2], S[3]);
    st[C].l = __builtin_amdgcn_mfma_f32_16x16x32_bf16(ONES8, pf0, st[C].l, 0, 0, 0); st[C].l = __builtin_amdgcn_mfma_f32_16x16x32_bf16(ONES8, pf1, st[C].l, 0, 0, 0);
#pragma unroll
    for (int dt = 0; dt < 4; ++dt) { const bf16x8 vf0 = lds_frag(vb, 16 * dt + col, q), vf1 = lds_frag(vb, 16 * dt + col, 4 + q);
        O[C][dt] = __builtin_amdgcn_mfma_f32_16x16x32_bf16(vf0, pf0, O[C][dt], 0, 0, 0); O[C][dt] = __builtin_amdgcn_mfma_f32_16x16x32_bf16(vf1, pf1, O[C][dt], 0, 0, 0); }
}
__device__ __forceinline__ bool attn_overflowed(const Softmax (&st)[2], const f32x4 (&O)[2][4]) {
    float a = 0.f;
#pragma unroll
    for (int c = 0; c < 2; ++c) { a += fabsf(st[c].l[0]);
#pragma unroll
        for (int dt = 0; dt < 4; ++dt) a += (fabsf(O[c][dt][0]) + fabsf(O[c][dt][1])) + (fabsf(O[c][dt][2]) + fabsf(O[c][dt][3])); }
    return !(a < 1e37f);
}

__device__ __forceinline__ void nsa_unit(unsigned char* ws, LAS unsigned char* lds, const LAS float* lut, int b, int g, int tau, int tid_in) {
    int tid = tid_in; asm volatile("" : "+v"(tid));
    const int lane = tid & 63, wave = __builtin_amdgcn_readfirstlane(tid >> 6);
    const int col = lane & 15, q = lane >> 4, tl = col >> 2, r = col & 3, h = g * 4 + r, t0 = 64 * tau, cur = tau;
    const f32x4 z4 = (f32x4){0.f, 0.f, 0.f, 0.f};
    const float NEG = -__builtin_inff();
    int tq[2]; bf16x8 qf[2][2];
#pragma unroll
    for (int c = 0; c < 2; ++c) { tq[c] = t0 + 8 * wave + 4 * c + tl; const size_t qrow = (size_t)b * SEQ + tq[c];
        const bf16_t* Qp = (const bf16_t*)(ws + WS_Q) + qrow * 1024 + h * 64 + 8 * q; qf[c][0] = *(const bf16x8*)Qp; qf[c][1] = *(const bf16x8*)(Qp + 32); }
#define NSA_GATE(c, k) (((const float*)(ws + WS_GATES))[((size_t)b * SEQ + tq[c]) * 48 + h * 3 + (k)])
    const LAS float* lrow = lut + h * 132;
    const float bias_far = lrow[128];
    const int dl = (4 - tl) & 3;
    const LAS float* nbq = (const LAS float*)(lds + NB_OFF) + (r * 4 + dl) * 264 + 196 - dl + 4 * q;
    LAS f32x4* resw = (LAS f32x4*)(lds + NSA_RES + wave * 8192) + lane;
    f32x4 Oc[2][4];
#pragma unroll
    for (int c = 0; c < 2; ++c)
#pragma unroll
        for (int dt = 0; dt < 4; ++dt) Oc[c][dt] = z4;
    LAS float* impw = (LAS float*)(lds + NSA_IMP) + wave * 2112;
    volatile LAS unsigned* ovf = (volatile LAS unsigned*)(lds + MISC_OFF) + 20;
    if (tid == 0) { ovf[0] = 0u; ovf[1] = 0u; }
    Stage stg;
    const int nvmax = (t0 + 63 >= 31) ? ((t0 + 63 - 31) >> 4) + 1 : 0;
    const int ncb = (nvmax + 63) >> 6;
    int nv[2];
#pragma unroll
    for (int c = 0; c < 2; ++c) nv[c] = tq[c] >= 31 ? ((tq[c] - 31) >> 4) + 1 : 0;
    const unsigned char* kcg = ws + WS_KC + ((size_t)(b * 512) * 4 + g) * 128;
    const unsigned char* vcg = ws + WS_VCT + ((size_t)((b * 4 + g) * 64)) * NCMP_PAD * 2;
    float M[2] = {-1e30f, -1e30f}, L[2] = {0.f, 0.f};
    if (ncb > 0) {
        const int nfar = (t0 - 159 >= 0) ? (((t0 - 159) >> 4) + 1) >> 6 : 0;
        stage_load(stg, kcg, 512, nullptr, 0, tid, false); stage_store(stg, lds, 0, tid, false); __syncthreads();
        for (int i = 0; i < ncb; ++i) {
            if (i + 1 < ncb) stage_load(stg, kcg + (size_t)(i + 1) * 64 * 512, 512, nullptr, 0, tid, false);
            else stage_load(stg, kcg, 512, vcg, NCMP_PAD * 2, tid, true);
            const LAS unsigned char* kb = lds + NSA_KB + (i & 1) * 8192;
            f32x4 S[2][4];
#pragma unroll
            for (int kt = 0; kt < 4; ++kt) { const bf16x8 kf0 = lds_frag(kb, 16 * kt + col, q), kf1 = lds_frag(kb, 16 * kt + col, 4 + q);
#pragma unroll
                for (int c = 0; c < 2; ++c) { S[c][kt] = __builtin_amdgcn_mfma_f32_16x16x32_bf16(kf0, qf[c][0], z4, 0, 0, 0); S[c][kt] = __builtin_amdgcn_mfma_f32_16x16x32_bf16(kf1, qf[c][1], S[c][kt], 0, 0, 0); } }
#pragma unroll
            for (int c = 0; c < 2; ++c) {
                float rowb = bias_far;
                if (i >= nfar) { rowb = 0.f;
                    const int tqlo = t0 + 8 * wave + 4 * c, tqhi = tqlo + 3;
#pragma unroll
                    for (int kt = 0; kt < 4; ++kt) { const int nlo = 64 * i + 16 * kt;
                        if (16 * (nlo + 15) + 31 + 128 <= tqlo) S[c][kt] = S[c][kt] + bias_far;
                        else if (16 * nlo + 31 > tqhi) S[c][kt] = (f32x4){NEG, NEG, NEG, NEG};
                        else {
#pragma unroll
                            for (int e = 0; e < 4; ++e) { const int n = nlo + 4 * q + e; int dist = tq[c] - (16 * n + 31); dist = dist < 0 ? 0 : (dist > 128 ? 128 : dist);
                                const float bv = lrow[dist]; const float sv = S[c][kt][e] + bv; S[c][kt][e] = n < nv[c] ? sv : NEG; } } } }
                const float tm = fmaxf(fmaxf(fmaxf(fmaxf(S[c][0][0], S[c][0][1]), fmaxf(S[c][0][2], S[c][0][3])), fmaxf(fmaxf(S[c][1][0], S[c][1][1]), fmaxf(S[c][1][2], S[c][1][3]))),
                                       fmaxf(fmaxf(fmaxf(S[c][2][0], S[c][2][1]), fmaxf(S[c][2][2], S[c][2][3])), fmaxf(fmaxf(S[c][3][0], S[c][3][1]), fmaxf(S[c][3][2], S[c][3][3])))) + rowb;
                const float mn = fmaxf(M[c], tm); L[c] *= ex2(M[c] - mn); M[c] = mn;
                const float off = rowb - mn; float sum = 0.f;
#pragma unroll
                for (int kt = 0; kt < 4; ++kt)
#pragma unroll
                    for (int e = 0; e < 4; ++e) sum += ex2(S[c][kt][e] + off);
                L[c] += sum;
            }
            if (i + 1 < ncb) stage_store(stg, lds, (i + 1) & 1, tid, false);
            __syncthreads();
        }
#pragma unroll
        for (int c = 0; c < 2; ++c) { float mo = fmax_x16(M[c]); mo = fmax_x32(mo); L[c] *= ex2(M[c] - mo); M[c] = mo; L[c] = fadd_x16(L[c]); L[c] = fadd_x32(L[c]); }
        float offN[2];
#pragma unroll
        for (int c = 0; c < 2; ++c) offN[c] = -M[c] - __builtin_amdgcn_logf(fmaxf(L[c], 1e-30f));
        f32x4 (&O)[2][4] = Oc;
        stage_store(stg, lds, 0, tid, true); __syncthreads();
        for (int i = 0; i < ncb; ++i) {
            if (i + 1 < ncb) stage_load(stg, kcg + (size_t)(i + 1) * 64 * 512, 512, vcg + (size_t)(i + 1) * 128, NCMP_PAD * 2, tid, true);
            const LAS unsigned char* kb = lds + NSA_KB + (i & 1) * 8192; const LAS unsigned char* vb = lds + NSA_VB + (i & 1) * 8192;
            f32x4 S[2][4];
#pragma unroll
            for (int kt = 0; kt < 4; ++kt) { const bf16x8 kf0 = lds_frag(kb, 16 * kt + col, q), kf1 = lds_frag(kb, 16 * kt + col, 4 + q);
#pragma unroll
                for (int c = 0; c < 2; ++c) { S[c][kt] = __builtin_amdgcn_mfma_f32_16x16x32_bf16(kf0, qf[c][0], z4, 0, 0, 0); S[c][kt] = __builtin_amdgcn_mfma_f32_16x16x32_bf16(kf1, qf[c][1], S[c][kt], 0, 0, 0); } }
#pragma unroll
            for (int c = 0; c < 2; ++c) {
                if (i >= nfar) {
                    const int tqlo = t0 + 8 * wave + 4 * c, tqhi = tqlo + 3; const float offF = bias_far + offN[c];
#pragma unroll
                    for (int kt = 0; kt < 4; ++kt) { const int nlo = 64 * i + 16 * kt;
                        if (16 * (nlo + 15) + 31 + 128 <= tqlo) {
#pragma unroll
                            for (int e = 0; e < 4; ++e) S[c][kt][e] = ex2(S[c][kt][e] + offF); }
                        else if (16 * nlo + 31 > tqhi) S[c][kt] = (f32x4){0.f, 0.f, 0.f, 0.f};
                        else {
#pragma unroll
                            for (int e = 0; e < 4; ++e) { const int n = nlo + 4 * q + e; int dist = tq[c] - (16 * n + 31); dist = dist < 0 ? 0 : (dist > 128 ? 128 : dist);
                                const float bv = lrow[dist]; const float pv = ex2(S[c][kt][e] + bv + offN[c]); S[c][kt][e] = n < nv[c] ? pv : 0.f; } } }
                } else { const float off = bias_far + offN[c];
#pragma unroll
                    for (int kt = 0; kt < 4; ++kt)
#pragma unroll
                        for (int e = 0; e < 4; ++e) S[c][kt][e] = ex2(S[c][kt][e] + off); }
#pragma unroll
                for (int kt = 0; kt < 4; ++kt) { float sA = (S[c][kt][0] + S[c][kt][1]) + (S[c][kt][2] + S[c][kt][3]), c3 = S[c][kt][3];
                    sA += dpp_x1(sA); sA += dpp_x2(sA); c3 += dpp_x1(c3); c3 += dpp_x2(c3);
                    if (r == 0) { const int jb = 4 * (4 * i + kt) + q; impw[(4 * c + tl) * 264 + jb] = sA; impw[(4 * c + tl) * 264 + 132 + jb + 1] = c3; } }
            }
            const bf16x8 pf00 = pack8(S[0][0], S[0][1]), pf01 = pack8(S[0][2], S[0][3]), pf10 = pack8(S[1][0], S[1][1]), pf11 = pack8(S[1][2], S[1][3]);
#pragma unroll
            for (int dt = 0; dt < 4; ++dt) { const bf16x8 vf0 = lds_frag(vb, 16 * dt + col, q), vf1 = lds_frag(vb, 16 * dt + col, 4 + q);
                O[0][dt] = __builtin_amdgcn_mfma_f32_16x16x32_bf16(vf0, pf00, O[0][dt], 0, 0, 0); O[1][dt] = __builtin_amdgcn_mfma_f32_16x16x32_bf16(vf0, pf10, O[1][dt], 0, 0, 0);
                O[0][dt] = __builtin_amdgcn_mfma_f32_16x16x32_bf16(vf1, pf01, O[0][dt], 0, 0, 0); O[1][dt] = __builtin_amdgcn_mfma_f32_16x16x32_bf16(vf1, pf11, O[1][dt], 0, 0, 0); }
            if (i + 1 < ncb) stage_store(stg, lds, (i + 1) & 1, tid, true);
            __syncthreads();
        }
    }
    unsigned u[2][4];
    Stage stg2;
    const unsigned char* kg_s = ws + WS_KS + ((size_t)b * SEQ * 256 + g * 64) * 2;
    const unsigned char* vg_s = ws + WS_VST + ((size_t)((b * 4 + g) * 64)) * SEQ * 2;
    stage_load(stg, kg_s, 512, vg_s, SEQ * 2, tid, true);
    if (1 <= cur) stage_load(stg2, kg_s + (size_t)64 * 512, 512, vg_s + 128, SEQ * 2, tid, true);
    asm volatile("s_waitcnt lgkmcnt(0)" ::: "memory");
    LAS unsigned* selw = (LAS unsigned*)(lds + TILES_OFF) + wave * 32;
    select_blocks8(impw, selw, lane, cur, u);
    __syncthreads();
#pragma unroll
    for (int c = 0; c < 2; ++c) { const float gc = NSA_GATE(c, 0);
#pragma unroll
        for (int dt = 0; dt < 4; ++dt) resw[(c * 4 + dt) * 64] = Oc[c][dt] * gc; }
    {
        f32x4 O[2][4]; Softmax st[2];
#pragma unroll
        for (int c = 0; c < 2; ++c) { st[c].m = -1e30f; st[c].l = z4;
#pragma unroll
            for (int dt = 0; dt < 4; ++dt) O[c][dt] = z4; }
        const unsigned char* kg = kg_s; const unsigned char* vg = vg_s;
        const unsigned char* kgw = ws + WS_KW + ((size_t)b * SEQ * 256 + g * 64) * 2;
        const unsigned char* vgw = ws + WS_VWT + ((size_t)((b * 4 + g) * 64)) * SEQ * 2;
        const int jlo_w = cur >= 8 ? cur - 8 : 0;
#define SLC_LOAD(ST, J) stage_load(ST, kg + (size_t)(J) * 64 * 512, 512, vg + (size_t)(J) * 128, SEQ * 2, tid, true)
#define SLC_STEP(SAFE, J, BUF) do { const int j_ = (J); \
            const unsigned uw0 = (j_ >> 5) == 0 ? u[0][0] : (j_ >> 5) == 1 ? u[0][1] : (j_ >> 5) == 2 ? u[0][2] : u[0][3]; \
            const unsigned uw1 = (j_ >> 5) == 0 ? u[1][0] : (j_ >> 5) == 1 ? u[1][1] : (j_ >> 5) == 2 ? u[1][2] : u[1][3]; \
            if (((uw0 | uw1) >> (j_ & 31)) & 1u) { \
                const bool sel0 = (cw0 >> (j_ & 31)) & 1u, sel1 = (cw1 >> (j_ & 31)) & 1u; \
                const LAS unsigned char* kb = lds + NSA_KB + (BUF) * 8192; const LAS unsigned char* vb = lds + NSA_VB + (BUF) * 8192; \
                if (j_ + 3 > cur) attn_block<1, true>(kb, vb, qf, col, q, tq, 64 * j_, nbq, bias_far, sel0, sel1, st, O); \
                else { const bool d0_ = (uw0 >> (j_ & 31)) & 1u, d1_ = (uw1 >> (j_ & 31)) & 1u; \
                    if (SAFE) { \
                        if (d0_ && d1_) attn_block<0, true>(kb, vb, qf, col, q, tq, 64 * j_, nbq, bias_far, sel0, sel1, st, O); \
                        else if (d0_) attn_block_far1<0>(kb, vb, qf, col, q, bias_far, sel0, st, O); \
                        else attn_block_far1<1>(kb, vb, qf, col, q, bias_far, sel1, st, O); \
                    } else if (j_ == 0) attn_block<0, true>(kb, vb, qf, col, q, tq, 0, nbq, bias_far, sel0, sel1, st, O); \
                    else if (d0_ && d1_) attn_far_fast<true>(kb, vb, qf, col, q, bias_far, sel0, sel1, st, O); \
                    else if (d0_) attn_far1_fast<0>(kb, vb, qf, col, q, bias_far, sel0, st, O); \
                    else attn_far1_fast<1>(kb, vb, qf, col, q, bias_far, sel1, st, O); } } } while (0)
#define SLC_LOOP(SAFE) do { \
        if (SAFE) { SLC_LOAD(stg, 0); if (1 <= cur) SLC_LOAD(stg2, 1); } \
        stage_store(stg, lds, 0, tid, true); if (1 <= cur) stage_store(stg2, lds, 1, tid, true); __syncthreads(); \
        unsigned cw0 = 0u, cw1 = 0u; \
        for (int j = 0; j <= cur; j += 2) { \
            if ((j & 31) == 0) { cw0 = selw[tl * 4 + (j >> 5)]; cw1 = selw[16 + tl * 4 + (j >> 5)]; } \
            if (j + 2 <= cur) SLC_LOAD(stg, j + 2); \
            else stage_load(stg, kgw + (size_t)jlo_w * 64 * 512, 512, vgw + (size_t)jlo_w * 128, SEQ * 2, tid, true);     \
            if (j + 3 <= cur) SLC_LOAD(stg2, j + 3); \
            SLC_STEP(SAFE, j, j & 3); \
            if (j + 1 <= cur) SLC_STEP(SAFE, j + 1, (j + 1) & 3); \
            if (j + 2 <= cur) stage_store(stg, lds, (j + 2) & 3, tid, true); \
            if (j + 3 <= cur) stage_store(stg2, lds, (j + 3) & 3, tid, true); \
            __syncthreads(); \
        } } while (0)
        SLC_LOOP(false);
        if (__any(attn_overflowed(st, O))) ovf[0] = 1u;
        __syncthreads();
        if (ovf[0] != 0u) {
#pragma unroll
            for (int c = 0; c < 2; ++c) { st[c].m = -1e30f; st[c].l = z4;
#pragma unroll
                for (int dt = 0; dt < 4; ++dt) O[c][dt] = z4; }
            SLC_LOOP(true);
        }
#undef SLC_LOOP
#undef SLC_LOAD
#undef SLC_STEP
#pragma unroll
        for (int c = 0; c < 2; ++c) { const float sc = NSA_GATE(c, 1) / fmaxf(st[c].l[0], 1e-30f);
#pragma unroll
            for (int dt = 0; dt < 4; ++dt) resw[(c * 4 + dt) * 64] = resw[(c * 4 + dt) * 64] + O[c][dt] * sc; }
    }
    {
        f32x4 O[2][4]; Softmax st[2];
#pragma unroll
        for (int c = 0; c < 2; ++c) { st[c].m = -1e30f; st[c].l = z4;
#pragma unroll
            for (int dt = 0; dt < 4; ++dt) O[c][dt] = z4; }
        const unsigned char* kg = ws + WS_KW + ((size_t)b * SEQ * 256 + g * 64) * 2;
        const unsigned char* vg = ws + WS_VWT + ((size_t)((b * 4 + g) * 64)) * SEQ * 2;
        const int jlo = cur >= 8 ? cur - 8 : 0;
#define WIN_LOOP(SAFE) do { \
        if (SAFE) stage_load(stg, kg + (size_t)jlo * 64 * 512, 512, vg + (size_t)jlo * 128, SEQ * 2, tid, true); \
        stage_store(stg, lds, 0, tid, true); __syncthreads(); \
        for (int j = jlo; j <= cur; ++j) { \
            const int bi = (j - jlo) & 1; \
            if (j + 1 <= cur) stage_load(stg, kg + (size_t)(j + 1) * 64 * 512, 512, vg + (size_t)(j + 1) * 128, SEQ * 2, tid, true); \
            const LAS unsigned char* kb = lds + NSA_KB + bi * 8192; const LAS unsigned char* vb = lds + NSA_VB + bi * 8192; \
            if (j + 3 > cur) attn_block<1, false>(kb, vb, qf, col, q, tq, 64 * j, nbq, bias_far, true, true, st, O); \
            else if (j + 8 == cur) attn_block<2, false>(kb, vb, qf, col, q, tq, 64 * j, nbq, bias_far, true, true, st, O); \
            else if ((SAFE) || j < jlo + 2) attn_block<0, false>(kb, vb, qf, col, q, tq, 64 * j, nbq, bias_far, true, true, st, O); \
            else attn_far_fast<false>(kb, vb, qf, col, q, bias_far, true, true, st, O); \
            if (j + 1 <= cur) stage_store(stg, lds, bi ^ 1, tid, true); \
            __syncthreads(); \
        } } while (0)
        WIN_LOOP(false);
        if (__any(attn_overflowed(st, O))) ovf[1] = 1u;
        __syncthreads();
        if (ovf[1] != 0u) {
#pragma unroll
            for (int c = 0; c < 2; ++c) { st[c].m = -1e30f; st[c].l = z4;
#pragma unroll
                for (int dt = 0; dt < 4; ++dt) O[c][dt] = z4; }
            WIN_LOOP(true);
        }
#undef WIN_LOOP
#pragma unroll
        for (int c = 0; c < 2; ++c) { const float sc = NSA_GATE(c, 2) / fmaxf(st[c].l[0], 1e-30f);
            bf16_t* yo = (bf16_t*)(ws + WS_YNSA) + ((size_t)b * SEQ + tq[c]) * 1024 + h * 64 + 4 * q;
#pragma unroll
            for (int dt = 0; dt < 4; ++dt) { const f32x4 rv = resw[(c * 4 + dt) * 64] + O[c][dt] * sc; u32x2 o; o.x = pk2(rv[0], rv[1]); o.y = pk2(rv[2], rv[3]); *(u32x2*)(yo + 16 * dt) = o; } }
    }
}

__device__ __forceinline__ float dpp_ror4(float x) { return __builtin_bit_cast(float, __builtin_amdgcn_update_dpp(0, __builtin_bit_cast(int, x), 0x124, 0xF, 0xF, true)); }
__device__ __forceinline__ float dpp_ror8(float x) { return __builtin_bit_cast(float, __builtin_amdgcn_update_dpp(0, __builtin_bit_cast(int, x), 0x128, 0xF, 0xF, true)); }
__device__ __forceinline__ int dpp_ror4i(int x) { return __builtin_amdgcn_update_dpp(0, x, 0x124, 0xF, 0xF, true); }
__device__ __forceinline__ int dpp_ror8i(int x) { return __builtin_amdgcn_update_dpp(0, x, 0x128, 0xF, 0xF, true); }
__device__ __forceinline__ void route_token(const In& in, unsigned char* ws, LAS unsigned* hist, LAS unsigned* eloc, LAS unsigned* sloc, int tok, int tloc, int lane) {
    const f32x4 lg = *((const f32x4*)((const float*)(ws + WS_LOGIT) + (size_t)tok * 256) + lane);
    const f32x4 rb = *((const f32x4*)in.router_bias + lane);
    float s[4], v[4];
#pragma unroll
    for (int i = 0; i < 4; ++i) { s[i] = sigmoidf_(lg[i]); v[i] = s[i] + rb[i]; }
    unsigned taken = 0u; float my_s = 0.f; int my_e = 0;
    for (int k = 0; k < TOPK; ++k) {
        float bv = -__builtin_inff(); int bi = 1 << 20;
#pragma unroll
        for (int i = 0; i < 4; ++i) { const bool ok = !((taken >> i) & 1u) && v[i] > bv; bv = ok ? v[i] : bv; bi = ok ? 4 * lane + i : bi; }
        best_pair(bv, bi, dpp_ror8(bv), dpp_ror8i(bi)); best_pair(bv, bi, dpp_ror4(bv), dpp_ror4i(bi)); best_pair(bv, bi, dpp_x2(bv), dpp_x2i(bi)); best_pair(bv, bi, dpp_x1(bv), dpp_x1i(bi));
        { const float ov = __shfl_xor(bv, 16); const int oi = __shfl_xor(bi, 16); best_pair(bv, bi, ov, oi); }
        { const float ov = __shfl_xor(bv, 32); const int oi = __shfl_xor(bi, 32); best_pair(bv, bi, ov, oi); }
        const bool mine = (bi >> 2) == lane;
        if (mine) taken |= 1u << (bi & 3);
        const float sw = (bi & 3) == 0 ? s[0] : (bi & 3) == 1 ? s[1] : (bi & 3) == 2 ? s[2] : s[3];
        const float bs = __shfl(sw, bi >> 2);
        if (lane == k) { my_s = bs; my_e = bi; }
    }
    float sum = lane < TOPK ? my_s : 0.f;
    sum += dpp_x1(sum); sum += dpp_x2(sum); sum += dpp_ror4(sum); sum += dpp_ror8(sum);
    if (lane < TOPK) {
        const unsigned slot = __hip_atomic_fetch_add(hist + my_e, 1u, __ATOMIC_RELAXED, __HIP_MEMORY_SCOPE_WORKGROUP);
        eloc[tloc * 8 + lane] = (unsigned)my_e; sloc[tloc * 8 + lane] = slot;
        ((int*)(ws + WS_ASGE))[tok * 8 + lane] = my_e; ((float*)(ws + WS_ASGW))[tok * 8 + lane] = my_s / sum * 2.5f;
    }
}

#ifndef DBG_MODE
#define DBG_MODE 0
#endif
struct Args { In in; float* out; unsigned char* ws; int ph_lo, ph_hi; };
static_assert(sizeof(Args) == 31 * 8 + 8 + 8 + 8, "Args has no padding");

#define CAS __attribute__((address_space(4)))
struct PhaseArgs { In in; float* out; unsigned char* ws; };
__device__ __forceinline__ PhaseArgs load_args() {
    const CAS unsigned char* kp = (const CAS unsigned char*)__builtin_amdgcn_kernarg_segment_ptr(); asm volatile("" : "+s"(kp));
    const float* const CAS* pp = (const float* const CAS*)kp; PhaseArgs r; const float** rp = (const float**)&r.in;
#pragma unroll
    for (int i = 0; i < 31; ++i) rp[i] = pp[i];
    r.out = (float*)pp[31]; r.ws = (unsigned char*)pp[32]; return r;
}
#define PHASE_ARGS() const PhaseArgs pa_ = load_args(); const In& in = pa_.in; float* const out = pa_.out; unsigned char* const ws = pa_.ws; (void)in; (void)out; (void)ws
__global__ void __launch_bounds__(NTHREADS, 2) fwd_kernel(Args args) {
    extern __shared__ __attribute__((aligned(16))) unsigned char lds_raw[];
    LAS unsigned char* lds = (LAS unsigned char*)lds_raw;
    volatile LAS unsigned* MISC = (volatile LAS unsigned*)(lds + MISC_OFF);
    const int tid = threadIdx.x, lane = tid & 63, wave = __builtin_amdgcn_readfirstlane(tid >> 6);
    const int G = gridDim.x, gw = (int)blockIdx.x * NWAVES + wave, NGW = G * NWAVES;
    unsigned* ctl = (unsigned*)(args.ws + WS_CTL);
    for (int u = tid; u < 256; u += NTHREADS) ((LAS unsigned*)(lds + MISC_OFF))[u] = 0u;
    __syncthreads();
    XcdBarrier bar = xcd_barrier_post(ctl + CW_BAR, MISC + 8);
    const int lo = args.ph_lo, hi = args.ph_hi;
#define IN(k) (lo <= (k) && (k) < hi)
#define SEAM(k) do { if (IN(k) && IN((k) + 1)) xcd_barrier(bar); } while (0)
    LAS float* lut = (LAS float*)(lds + LUT_OFF);
    LAS int* tstart = (LAS int*)(lds + TILES_OFF);

    if (IN(0)) {
        PHASE_ARGS();
        p0_mod(in, ws, lds, tid);
        p0_tables(in, ws, lds, tid);
        if (blockIdx.x >= 64) p0_small_weights(in, ws, (LAS float*)(lds + wave * 8448), gw - 64 * NWAVES, NGW - 64 * NWAVES, lane);
    }
    SEAM(0);
    if (IN(1)) { PHASE_ARGS();
        if (blockIdx.x == 0) {
            const float* part = (const float*)(ws + WS_CTL + 131072);
            const int ts = tid >> 8, c = tid & 255; float sb = 0.f;
            for (int pz = 0; pz < 16; ++pz) sb += part[(ts * 16 + pz) * 256 + c];
            ((float*)(ws + WS_CTL + 65536))[ts * 256 + c] = sb; }
        ph_h1(in, ws, gw, NGW, lane); }
    SEAM(1);
    if (IN(2)) {
        PHASE_ARGS();
        SchedDense S = make_dense((const char*)ws, WS_H1, 2048, (const char*)(ws + WS_WIN), MTOK, NPROJ, 1024);
        EpiProj E{ws};
        pg8::gemm_phase<EpiProj, SchedDense>(lds, S, E);
    }
    SEAM(2);
    if (IN(3)) {
        PHASE_ARGS();
        { SchedCmp1 S; S.abase = (const char*)ws; S.a_kstep = 512; S.K = 2048; S.Bt = (const char*)(ws + WS_CW1); S.ord.init(64, 2, G, (int)blockIdx.x);
          EpiCmp1 E{ws}; pg8::gemm_phase<EpiCmp1, SchedCmp1>(lds, S, E); }
        __syncthreads();
        s5_task<false>(in, ws, lds + wave * S5_LDS_PER_WAVE, gw >> 8, (gw >> 3) & 31, gw & 7, lane);
    }
    SEAM(3);
    if (IN(4)) {
        PHASE_ARGS();
        { SchedCmp2 S; S.abase = (const char*)ws; S.a_kstep = 128; S.K = 256; S.Bt = (const char*)(ws + WS_CW2); S.ord.init(64, 2, G, (int)blockIdx.x);
          EpiCmp2 E{ws}; pg8::gemm_phase<EpiCmp2, SchedCmp2>(lds, S, E); }
        __syncthreads();
        s5_task<true>(in, ws, lds + wave * S5_LDS_PER_WAVE, gw >> 8, (gw >> 3) & 31, gw & 7, lane);
    }
    SEAM(4);
    if (IN(5)) {
        PHASE_ARGS();
        for (int i = tid; i < 16 * 132; i += NTHREADS) lut[i] = ((const float*)(ws + WS_TAB + TAB_LUT))[i];
        __syncthreads();
        if ((tid >> 6) >= 4) __builtin_amdgcn_s_setprio(2);
        for (int i = 0; i < 16; ++i) { const int bg = 8 * (i >> 2) + ((int)blockIdx.x & 7), wi = (int)blockIdx.x >> 3, k = i & 3;
            const int tau = k == 0 ? wi : k == 1 ? 63 - wi : k == 2 ? 64 + wi : 127 - wi;
            if (k == 0) {
                __syncthreads();
                LAS float* nbt = (LAS float*)(lds + NB_OFF);
                for (int x = tid; x < 16 * 264; x += NTHREADS) { const int rr = x / 1056, sh = (x / 264) & 3, z = x % 264, d = 196 - z - sh;
                    nbt[x] = d < 0 ? -__builtin_inff() : lut[((bg & 3) * 4 + rr) * 132 + (d > 128 ? 128 : d)]; }
                __syncthreads();
            }
            nsa_unit(ws, lds, lut, bg >> 2, bg & 3, tau, tid); }
        __builtin_amdgcn_s_setprio(0);
    }
    SEAM(5);
    if (IN(6)) {
        PHASE_ARGS();
        SchedDense S = make_dense((const char*)ws, WS_Z, 1024, (const char*)(ws + WS_GLU), MTOK, 2048, 512);
        EpiGlu E{ws}; pg8::gemm_phase<EpiGlu, SchedDense>(lds, S, E);
    }
    SEAM(6);
    if (IN(7)) {
        PHASE_ARGS();
        SchedDense S = make_dense((const char*)ws, WS_MERGED, 2048, (const char*)(ws + WS_WOUT), MTOK, 1024, 1024);
        EpiWout E{in.x, out, (const float*)(ws + WS_MOD) + 2048};
        static_assert(WS_WD >= WS_KS && WS_WD + 128 * MiB <= WS_MG + 256 * MiB && WS_WGU + 63 * MiB <= WS_Q && WS_WGU + 191 * MiB >= WS_Q + 128 * MiB, "early conversion targets must not overlap MERGED (live in this phase)");
        if (blockIdx.x & 1) { convert_expert_weights(in, ws, (LAS float*)(lds + wave * 8448), gw, NGW, lane, 0); __syncthreads(); }
        pg8::gemm_phase<EpiWout, SchedDense>(lds, S, E);
        if (!(blockIdx.x & 1)) { __syncthreads(); convert_expert_weights(in, ws, (LAS float*)(lds + wave * 8448), gw, NGW, lane, 0); }
    }
    SEAM(7);
    if (IN(8)) {
        PHASE_ARGS();
        ph_ln1(in, ws, out, gw, NGW, lane);
        for (int i = gw * 64 + lane; i < 128; i += NGW * 64) ((u32x4*)((bf16_t*)(ws + WS_H2) + (size_t)MTOK * DM))[i] = (u32x4){0u, 0u, 0u, 0u};
        for (int i = gw * 64 + lane; i < NCHUNK * CHUNK_ROWS; i += NGW * 64) { ((int*)(ws + WS_ROWASG))[i] = -1; ((float*)(ws + WS_ROWW))[i] = 0.f; }
        convert_expert_weights(in, ws, (LAS float*)(lds + wave * 8448), gw, NGW, lane, 1);
    }
    SEAM(8);
    if (IN(9)) {
        PHASE_ARGS();
        { SchedDense S = make_dense((const char*)ws, WS_H2, 2048, (const char*)(ws + WS_ROUT), MTOK, 256, 1024);
          EpiF32 E{(float*)(ws + WS_LOGIT), 256}; pg8::gemm_phase<EpiF32, SchedDense>(lds, S, E); }
        { SchedDense S = make_dense((const char*)ws, WS_H2, 2048, (const char*)(ws + WS_SHGU), MTOK, 512, 1024);
          EpiSwiglu E{(bf16_t*)(ws + WS_HSH)}; pg8::gemm_phase<EpiSwiglu, SchedDense>(lds, S, E); }
    }
    SEAM(9);
    if (IN(10)) {
        PHASE_ARGS();
        {
            LAS unsigned* hist = (LAS unsigned*)lds; LAS unsigned* gbase = hist + 256; LAS unsigned* eloc = hist + 512; LAS unsigned* sloc = hist + 2560;
            const int tok0 = (int)blockIdx.x * 256;
            if (tid < 256) hist[tid] = 0u;
            __syncthreads();
            for (int k = 0; k < 32; ++k) route_token(in, ws, hist, eloc, sloc, tok0 + wave * 32 + k, wave * 32 + k, lane);
            __syncthreads();
            if (tid < 256) { const unsigned h = hist[tid]; gbase[tid] = h ? __hip_atomic_fetch_add(ctl + CW_CNT + chunk_of_tok(tok0) * 256 + tid, h, RLX_AGENT) : 0u; }
            __syncthreads();
            for (int i = tid; i < 2048; i += NTHREADS) ((int*)(ws + WS_ASGS))[tok0 * 8 + i] = (int)(sloc[i] + gbase[eloc[i]]);
            __syncthreads();
        }
        SchedDense S = make_dense((const char*)ws, WS_HSH, 512, (const char*)(ws + WS_SHD), MTOK, 1024, 256);
        EpiShDown E{(unsigned char*)(ws + WS_SHOUT)}; pg8::gemm_phase<EpiShDown, SchedDense>(lds, S, E);
    }
    SEAM(10);
    if (IN(11) || IN(12)) {
        for (int i = tid; i < NCHUNK * 256; i += NTHREADS) { const unsigned c = __hip_atomic_load(ctl + CW_CNT + i, RLX_AGENT); tstart[(i >> 8) * 260 + (i & 255) + 1] = (int)((c + 255u) >> 8); }
        if (tid < NCHUNK) tstart[tid * 260] = 0;
        __syncthreads();
        if (tid < NCHUNK) { int sacc = 0; for (int e = 1; e <= 256; ++e) { sacc += tstart[tid * 260 + e]; tstart[tid * 260 + e] = sacc; } }
        __syncthreads();
    }
    if (IN(11)) {
        PHASE_ARGS();
        for (int a = gw * 64 + lane; a < MTOK * TOPK; a += NGW * 64) { const int e = ((const int*)(ws + WS_ASGE))[a], ch = chunk_of_tok(a >> 3); const int pos = ch * CHUNK_ROWS + 256 * tstart[ch * 260 + e] + ((const int*)(ws + WS_ASGS))[a];
            ((int*)(ws + WS_ROWASG))[pos] = a; ((float*)(ws + WS_ROWW))[pos] = ((const float*)(ws + WS_ASGW))[a]; }
    }
    SEAM(11);
    if (IN(12)) {
        PHASE_ARGS();
        for (int ch = 0; ch < NCHUNK; ++ch) {
            { SchedMoeGU S; S.abase = (const char*)ws; S.a_kstep = 128; S.K = 1024; S.tstart = tstart + ch * 260; S.rowasg = (const int*)(ws + WS_ROWASG) + ch * CHUNK_ROWS; S.W = (const char*)(ws + WS_WGU); S.G = G; S.c = (int)blockIdx.x;
              EpiSwiglu E{(bf16_t*)(ws + WS_HID)}; pg8::gemm_phase<EpiSwiglu, SchedMoeGU>(lds, S, E); }
            if (ch > 0) final_chunk(in, ws, out, ctl + CW_FCTR + 64 * (ch - 1), ch - 1, MISC + 16, tid, wave, lane);
            xcd_barrier(bar);
            { SchedMoeD S; S.abase = (const char*)ws; S.a_kstep = 128; S.K = 256; S.tstart = tstart + ch * 260; S.W = (const char*)(ws + WS_WD); S.G = G; S.c = (int)blockIdx.x;
              EpiMoeDown E{(unsigned char*)(ws + WS_OUTS), (const int*)(ws + WS_ROWASG) + ch * CHUNK_ROWS, (const float*)(ws + WS_ROWW) + ch * CHUNK_ROWS, ch * CHUNK_ASG}; pg8::gemm_phase<EpiMoeDown, SchedMoeD>(lds, S, E); }
            xcd_barrier(bar);
        }
        final_chunk(in, ws, out, ctl + CW_FCTR + 64 * (NCHUNK - 1), NCHUNK - 1, MISC + 16, tid, wave, lane);
    }
#undef IN
#undef SEAM
}

extern "C" void kernel_launch(void* const* d_in, const int* in_sizes, int n_in, void* d_out, int out_size, void* d_ws, size_t ws_size, hipStream_t stream) {
    static int grid = 0;
    if (grid == 0) {
        if (n_in != 31 || out_size != MTOK * DM || ws_size < WS_END) { fprintf(stderr, "kernel_launch: unexpected shapes: n_in %d out %d ws %zu (need %zu)\n", n_in, out_size, ws_size, (size_t)WS_END); grid = -1; return; }
        int dev = 0, cus = 0, per_cu = 0;
        if (hipGetDevice(&dev) != hipSuccess || hipDeviceGetAttribute(&cus, hipDeviceAttributeMultiprocessorCount, dev) != hipSuccess) { grid = -1; return; }
        if (hipFuncSetAttribute((const void*)fwd_kernel, hipFuncAttributeMaxDynamicSharedMemorySize, LDS_BYTES) != hipSuccess) { fprintf(stderr, "kernel_launch: hipFuncSetAttribute failed\n"); grid = -1; return; }
        if (hipOccupancyMaxActiveBlocksPerMultiprocessor(&per_cu, (const void*)fwd_kernel, NTHREADS, LDS_BYTES) != hipSuccess || per_cu < 1) { fprintf(stderr, "kernel_launch: occupancy query says %d\n", per_cu); }
        (void)hipGetLastError();
        grid = cus;
    }
    if (grid < 0) return;
    if (hipMemsetAsync((char*)d_ws + WS_CTL, 0, CTL_ZERO_BYTES, stream) != hipSuccess) return;
    Args a{};
    const float** ip = (const float**)&a.in;
    for (int i = 0; i < 31; ++i) ip[i] = (const float*)d_in[i];
    a.out = (float*)d_out; a.ws = (unsigned char*)d_ws; a.ph_lo = 0; a.ph_hi = 13;
    hipLaunchKernelGGL(fwd_kernel, dim3(grid), dim3(NTHREADS), LDS_BYTES, stream, a);
}
```

```cpp
#include <hip/hip_runtime.h>
#include <cstdio>
#include <cstdint>

#define LAS __attribute__((address_space(3)))
#define GAS __attribute__((address_space(1)))
typedef unsigned short bf16_t;
typedef short bf16x8 __attribute__((ext_vector_type(8)));
typedef short bf16x4 __attribute__((ext_vector_type(4)));
typedef float f32x4 __attribute__((ext_vector_type(4)));
typedef float f32x2 __attribute__((ext_vector_type(2)));
typedef unsigned u32x4 __attribute__((ext_vector_type(4)));
typedef unsigned u32x2 __attribute__((ext_vector_type(2)));

constexpr int DM = 1024, NB = 8, SEQ = 8192, MTOK = NB * SEQ;
constexpr int SSM_W = 512, SSM_G = 32, SSM_P = 64;
constexpr int NH = 16, HD = 64, NKV = 4, KVW = 256;
constexpr int NCMP = 511, NCMP_PAD = 512;
constexpr int NEXP = 256, TOPK = 8, DEXP = 256;
constexpr int NPROJ = 5376;
constexpr float DN_ALPHA = 1.189207115002721f;
constexpr float LN_EPS = 1e-5f;
constexpr int NWAVES = 8, NTHREADS = 512;

constexpr size_t MiB = 1u << 20;
constexpr size_t WS_CTL = 0, CTL_ZERO_BYTES = 1 * MiB;
constexpr size_t WS_MOD = 1 * MiB;
constexpr size_t WS_TAB = 1 * MiB + 512 * 1024;
constexpr size_t WS_WIN = 2 * MiB;
constexpr size_t WS_GLU = 13 * MiB;
constexpr size_t WS_WOUT = 15 * MiB;
constexpr size_t WS_ROUT = 17 * MiB;
constexpr size_t WS_SHGU = 17 * MiB + 512 * 1024;
constexpr size_t WS_SHD = 18 * MiB + 512 * 1024;
constexpr size_t WS_CW1 = 19 * MiB;
constexpr size_t WS_CW2 = 21 * MiB;
constexpr size_t WS_S5T = 21 * MiB + 512 * 1024;
constexpr size_t WS_BASE = 24 * MiB;
constexpr size_t WS_H1 = WS_BASE;
constexpr size_t WS_YNSA = WS_H1;
constexpr size_t WS_U = WS_H1 + 128 * MiB;
constexpr size_t WS_Q = WS_U + 64 * MiB;
constexpr size_t WS_MERGED = WS_Q;
constexpr size_t WS_KCR = WS_Q + 128 * MiB;
constexpr size_t WS_VCR = WS_KCR + 32 * MiB;
constexpr size_t WS_KS = WS_VCR + 32 * MiB;
constexpr size_t WS_VST = WS_KS + 32 * MiB;
constexpr size_t WS_KW = WS_VST + 32 * MiB;
constexpr size_t WS_VWT = WS_KW + 32 * MiB;
constexpr size_t WS_MG = WS_VWT + 32 * MiB;
constexpr size_t WS_GATES = WS_MG + 256 * MiB;
constexpr size_t WS_Z = WS_GATES + 12 * MiB;
constexpr size_t WS_CMPH = WS_Z + 64 * MiB;
constexpr size_t WS_KC = WS_CMPH + 16 * MiB;
constexpr size_t WS_VCT = WS_KC + 2 * MiB;
constexpr size_t WS_S5ST = WS_VCT + 2 * MiB;
constexpr size_t WS_MIX_END = WS_S5ST + 1 * MiB;
constexpr int NCHUNK = 2, CHUNK_TOK = 32768, CHUNK_ASG = CHUNK_TOK * 8, CHUNK_ROWS = 327680, CHUNK_TILES = CHUNK_ROWS / 256;
constexpr float OUTS_SCALE = 64.0f;
__host__ __device__ __forceinline__ int chunk_of_tok(int tok) { return tok >> 15; }
__host__ __device__ __forceinline__ int chunk_ntok(int ch) { return CHUNK_TOK; }
constexpr size_t WS_H2 = WS_BASE;
constexpr size_t WS_WGU = WS_H2 + 129 * MiB;
constexpr size_t WS_WD = WS_WGU + 256 * MiB;
constexpr size_t WS_OUTS = WS_WD + 128 * MiB;
constexpr size_t WS_LOGIT = WS_OUTS;
constexpr size_t WS_HID = WS_OUTS + 256 * MiB;
constexpr size_t WS_HSH = WS_HID;
constexpr size_t WS_ASGE = WS_HID + 160 * MiB;
constexpr size_t WS_ASGS = WS_ASGE + 2 * MiB;
constexpr size_t WS_ASGW = WS_ASGS + 2 * MiB;
constexpr size_t WS_ROWASG = WS_ASGW + 2 * MiB;
constexpr size_t WS_ROWW = WS_ROWASG + 3 * MiB;
constexpr size_t WS_LNST = WS_ROWW + 3 * MiB;
constexpr size_t WS_SHOUT = WS_LNST + 1 * MiB;
constexpr size_t WS_END = WS_SHOUT + 64 * MiB;
static_assert(WS_MIX_END <= WS_END, "map");
constexpr int CW_BAR = 4096;
constexpr int CW_CNT = 8192;
constexpr int CW_FCTR = 9216;
constexpr size_t TAB_CMPB = 0;
constexpr size_t TAB_LUT = 4096;
constexpr size_t S5_AFR = 0;
constexpr size_t S5_CFR = 256 * 1024;
constexpr size_t S5_A = 384 * 1024;
constexpr size_t S5_A16 = S5_A + 16384;
constexpr size_t S5_AC = S5_A16 + 16384;

constexpr int RING_BYTES = 131072;
constexpr int MISC_OFF = 133120;
constexpr int LUT_OFF = MISC_OFF + 1024;
constexpr int TILES_OFF = LUT_OFF + 8448;
constexpr int NB_OFF = TILES_OFF + 4160;
constexpr int LDS_BYTES = 163840;
static_assert(NB_OFF % 16 == 0 && NB_OFF + 16 * 264 * 4 <= LDS_BYTES, "near-bias table");
static_assert(RING_BYTES <= MISC_OFF, "GEMM stage ring below the control words");
static_assert(TILES_OFF + 4 * 260 * 4 <= LDS_BYTES, "lds map");

#define RLX_AGENT __ATOMIC_RELAXED, __HIP_MEMORY_SCOPE_AGENT
#define LDS_WAIT() asm volatile("s_waitcnt lgkmcnt(0)" ::: "memory")
#define VM_WAIT() asm volatile("s_waitcnt vmcnt(0)" ::: "memory")
__device__ __forceinline__ unsigned f2bf(float f) { unsigned u = __builtin_bit_cast(unsigned, f); return (u + 0x7fffu + ((u >> 16) & 1u)) >> 16; }
typedef __bf16 nbf16x2 __attribute__((ext_vector_type(2)));
__device__ __forceinline__ unsigned pk2(float lo, float hi) { const f32x2 v = {lo, hi}; return __builtin_bit_cast(unsigned, __builtin_convertvector(v, nbf16x2)); }
__device__ __forceinline__ float bf2f(unsigned short b) { return __builtin_bit_cast(float, ((unsigned)b) << 16); }
__device__ __forceinline__ float bflo(unsigned w) { return __builtin_bit_cast(float, w << 16); }
__device__ __forceinline__ float bfhi(unsigned w) { return __builtin_bit_cast(float, w & 0xffff0000u); }
__device__ __forceinline__ float sigmoidf_(float x) { return 1.0f / (1.0f + __expf(-x)); }
__device__ __forceinline__ float siluf_(float x) { return x / (1.0f + __expf(-x)); }
__device__ __forceinline__ float gelu_tanh(float x) { const float u = 0.7978845608028654f * (x + 0.044715f * x * x * x); const float e = __expf(2.0f * u); return x * (1.0f - 1.0f / (e + 1.0f)); }
__device__ __forceinline__ float wave_sum(float v) {
#pragma unroll
    for (int o = 1; o < 64; o <<= 1) v += __shfl_xor(v, o);
    return v;
}

#define XB_TMO      128
#define XB_XCNT(j)  (256  + 64 * (j))
#define XB_XSUB(j)  (1280 + 64 * (j))
#define XB_XGEN(j)  (2304 + 64 * (j))
#define XB_TOP      3328
#define XB_TOPGEN   3392
#define XCD_BAR_WORDS 3456
#define XB_SPIN_CAP (1u << 18)
__device__ __forceinline__ unsigned xb_ld(unsigned* p)              { return __hip_atomic_load(p, __ATOMIC_RELAXED, __HIP_MEMORY_SCOPE_AGENT); }
__device__ __forceinline__ unsigned xb_add(unsigned* p, unsigned v) { return __hip_atomic_fetch_add(p, v, __ATOMIC_RELAXED, __HIP_MEMORY_SCOPE_AGENT); }
__device__ __forceinline__ unsigned xb_xcc_id() { return (unsigned)__builtin_amdgcn_s_getreg((3 << 11) | 20) & 0xFu; }
#define XB_SPIN(cond, bar) do { unsigned _sp = 0; while (cond) { __builtin_amdgcn_s_sleep(1); \
    if ((++_sp & 255u) == 0u) { if (xb_ld(&(bar)[XB_TMO])) break; if (_sp > XB_SPIN_CAP) { atomicAdd(&(bar)[XB_TMO], 1u); break; } } } } while (0)
struct XcdBarrier { unsigned* bar; unsigned x; volatile LAS unsigned* st; };
__device__ __forceinline__ XcdBarrier xcd_barrier_post(unsigned* bar, volatile LAS unsigned* st) {
    XcdBarrier b; b.bar = bar; b.x = xb_xcc_id(); b.st = st;
    if (threadIdx.x == 0) (void)xb_add(&bar[XB_XCNT(b.x)], 1u);
    return b;
}
__device__ __forceinline__ void xcd_barrier_complete(unsigned* bar, unsigned x, unsigned& nloc, unsigned& nx) {
    const unsigned G = gridDim.x * gridDim.y * gridDim.z;
    unsigned sum, cnt, mine, sp = 0u;
    for (;;) {
        sum = 0u; cnt = 0u; mine = 0u;
#pragma unroll
        for (unsigned j = 0; j < 16; ++j) { const unsigned c = xb_ld(&bar[XB_XCNT(j)]); sum += c; cnt += (c > 0u) ? 1u : 0u; mine = (j == x) ? c : mine; }
        if (sum == G) break;
        __builtin_amdgcn_s_sleep(1);
        if ((++sp & 255u) == 0u) { if (xb_ld(&bar[XB_TMO])) break; if (sp > XB_SPIN_CAP) { atomicAdd(&bar[XB_TMO], 1u); break; } }
    }
    nloc = mine > 0u ? mine : 1u; nx = cnt > 0u ? cnt : 1u;
}
__device__ __forceinline__ void xcd_barrier(const XcdBarrier& b) {
    asm volatile("s_waitcnt vmcnt(0)" ::: "memory");
    __syncthreads();
    if (threadIdx.x == 0) {
        unsigned* bar = b.bar;
        __builtin_amdgcn_s_waitcnt(0);
        unsigned nloc = b.st[0], nx = b.st[1];
        if (nloc == 0u) { xcd_barrier_complete(bar, b.x, nloc, nx); b.st[0] = nloc; b.st[1] = nx; }
        const unsigned old = xb_add(&bar[XB_XSUB(b.x)], 1u);
        const unsigned gen = old / nloc;
        if (old + 1u == (gen + 1u) * nloc) {
            __builtin_amdgcn_fence(__ATOMIC_RELEASE, "agent");
            asm volatile("s_waitcnt vmcnt(0)" ::: "memory");
            const unsigned og = xb_add(&bar[XB_TOP], 1u);
            const unsigned tg = og / nx;
            if (og + 1u == (tg + 1u) * nx) xb_add(&bar[XB_TOPGEN], 1u);
            else XB_SPIN(xb_ld(&bar[XB_TOPGEN]) == tg, bar);
            __builtin_amdgcn_fence(__ATOMIC_ACQUIRE, "agent");
            xb_add(&bar[XB_XGEN(b.x)], 1u);
            asm volatile("s_waitcnt vmcnt(0)" ::: "memory");
        } else {
            XB_SPIN(xb_ld(&bar[XB_XGEN(b.x)]) == gen, bar);
            __builtin_amdgcn_fence(__ATOMIC_ACQUIRE, "agent");
            asm volatile("s_waitcnt vmcnt(0)" ::: "memory");
        }
    }
    __syncthreads();
}

namespace pg8 {
constexpr int BM = 256, BK = 64, HALF = 128, HTB = HALF * BK * 2, STAGE_BYTES = 8 * HTB, NXCD = 8, WGM = 8;
__host__ __device__ __forceinline__ int lds_byte(int r, int c) { const int st = (r >> 4) * 2 + (c >> 5), rr = r & 15, cc = c & 31, ob = rr * 64 + cc * 2; return st * 1024 + (ob ^ (((ob >> 9) & 1) << 5)); }
__host__ __device__ __forceinline__ void stage_rc(int b, int& R, int& C) { const int st = b / 1024, sb = b % 1024, swz = sb ^ (((sb >> 9) & 1) << 5); R = (st >> 1) * 16 + swz / 64; C = (st & 1) * 32 + (swz % 64) / 2; }
__host__ __device__ __forceinline__ int perm32(int rho) { const int n = rho >> 4, i = rho & 15; return 8 * (i >> 2) + 4 * n + (i & 3); }
struct Unit { int pm, pn; };
struct DenseOrder {
    int nM, nN, nwg, G, c;
    __device__ void init(int nM_, int nN_, int G_, int c_) { nM = nM_; nN = nN_; nwg = nM * nN; G = G_; c = c_; }
    __device__ bool next(int i, Unit& u) const {
        const long L = (long)i * G + c; if (L >= nwg) return false;
        int wgid = (int)L; { const int q = nwg / NXCD, r = nwg % NXCD, xcd = wgid % NXCD, off = wgid / NXCD; wgid = (xcd < r ? xcd * (q + 1) : r * (q + 1) + (xcd - r) * q) + off; }
        const int nig = WGM * nN, gid = wgid / nig, fm = gid * WGM, gsz = (nM - fm) < WGM ? (nM - fm) : WGM;
        u.pm = fm + ((wgid % nig) % gsz); u.pn = (wgid % nig) / gsz; return true;
    }
};
template <class Epi, class Sched>
__device__ __forceinline__ void gemm_phase(LAS unsigned char* lds, const Sched& S, const Epi& E) {
    int tid_ = threadIdx.x; asm volatile("" : "+v"(tid_));
    const int tid = tid_, wid = __builtin_amdgcn_readfirstlane(tid >> 6), lane = tid & 63, wr = wid >> 2, wc = wid & 3, fr = lane & 15, fq = lane >> 4;
    const int K = S.K, nt = K / BK;
    int RA[2], CA[2]; unsigned voffB[2];
#pragma unroll
    for (int i = 0; i < 2; ++i) { int R, C; stage_rc(tid * 16 + i * 8192, R, C); const int Rb = Epi::PERM ? ((R & ~31) + perm32(R & 31)) : R;
        RA[i] = R; CA[i] = C * 2; voffB[i] = (unsigned)(Rb * K + C) * 2u; }
    const size_t kstep = (size_t)(BK * 2);
    const size_t hstep = (size_t)HALF * K * 2;
    const size_t ka = (size_t)S.a_kstep;
    const unsigned ldsw = (unsigned)wid * 1024u;
    const int aoff = lds_byte(wr * 64 + fr, fq * 8), boff = lds_byte(wc * 32 + fr, fq * 8);
#define PG8_SA(b, h) (((b) * 2 + (h)) * HTB)
#define PG8_SB(b, h) ((4 + (b) * 2 + (h)) * HTB)
#define PG8_STAGE(bufoff, gbase, v0, v1) do { \
        __builtin_amdgcn_global_load_lds((const unsigned*)((const char*)(gbase) + (v0)), (LAS unsigned*)(lds + (bufoff) + ldsw), 16, 0, 0); \
        __builtin_amdgcn_global_load_lds((const unsigned*)((const char*)(gbase) + (v1)), (LAS unsigned*)(lds + (bufoff) + ldsw + 8192), 16, 0, 0); } while (0)
#define PG8_LDA(dst, b, h) do { _Pragma("unroll") for (int m = 0; m < 4; ++m) _Pragma("unroll") for (int k = 0; k < 2; ++k) dst[m][k] = *(const LAS bf16x8*)(lds + PG8_SA(b, h) + aoff + m * 2048 + k * 1024); } while (0)
#define PG8_LDB(dst, b, h) do { _Pragma("unroll") for (int n = 0; n < 2; ++n) _Pragma("unroll") for (int k = 0; k < 2; ++k) dst[n][k] = *(const LAS bf16x8*)(lds + PG8_SB(b, h) + boff + n * 2048 + k * 1024); } while (0)
#define PG8_MMA(ai, bj, At, Bt) do { __builtin_amdgcn_s_setprio(1); _Pragma("unroll") for (int m = 0; m < 4; ++m) _Pragma("unroll") for (int n = 0; n < 2; ++n) _Pragma("unroll") for (int k = 0; k < 2; ++k) \
        acc[ai][bj][m][n] = __builtin_amdgcn_mfma_f32_16x16x32_bf16(Bt[n][k], At[m][k], acc[ai][bj][m][n], 0, 0, 0); __builtin_amdgcn_s_setprio(0); } while (0)
#define PG8_WAIT_V(n) asm volatile("s_waitcnt vmcnt(" #n ")" ::: "memory")
#define PG8_WAIT_L(n) asm volatile("s_waitcnt lgkmcnt(" #n ")" ::: "memory")
#define PG8_BAR __builtin_amdgcn_s_barrier()
#define PG8_SCHED __builtin_amdgcn_sched_barrier(0)
    Unit cur, nxt; int ui = 0;
    if (!S.next(0, cur)) return;
    f32x4 acc[2][2][4][2];
#pragma unroll
    for (int a = 0; a < 2; ++a)
#pragma unroll
        for (int b = 0; b < 2; ++b)
#pragma unroll
            for (int m = 0; m < 4; ++m)
#pragma unroll
                for (int n = 0; n < 2; ++n) acc[a][b][m][n] = (f32x4){0.f, 0.f, 0.f, 0.f};
    bf16x8 At[4][2], B0[2][2], B1[2][2];
    const char* const abase = S.abase;
    unsigned va00 = S.a_off(cur, RA[0]) + CA[0], va01 = S.a_off(cur, RA[1]) + CA[1], va10 = S.a_off(cur, RA[0] + HALF) + CA[0], va11 = S.a_off(cur, RA[1] + HALF) + CA[1];
    const char* cB = S.b_ptr(cur);
    PG8_STAGE(PG8_SB(0, 0), cB, voffB[0], voffB[1]); PG8_STAGE(PG8_SB(0, 1), cB + hstep, voffB[0], voffB[1]); PG8_STAGE(PG8_SA(0, 0), abase, va00, va01); PG8_STAGE(PG8_SA(0, 1), abase, va10, va11);
    if (wr == 1) PG8_BAR;
    PG8_WAIT_V(2); PG8_BAR;
    PG8_STAGE(PG8_SB(1, 0), cB + kstep, voffB[0], voffB[1]); PG8_STAGE(PG8_SA(1, 0), abase + ka, va00, va01); PG8_STAGE(PG8_SB(1, 1), cB + hstep + kstep, voffB[0], voffB[1]);
    PG8_WAIT_V(6); PG8_BAR;
    for (;;) {
        const bool has_next = S.next(ui + 1, nxt);
        unsigned na00 = va00, na01 = va01, na10 = va10, na11 = va11; const char* nB = cB;
        if (has_next) { na00 = S.a_off(nxt, RA[0]) + CA[0]; na01 = S.a_off(nxt, RA[1]) + CA[1]; na10 = S.a_off(nxt, RA[0] + HALF) + CA[0]; na11 = S.a_off(nxt, RA[1] + HALF) + CA[1]; nB = S.b_ptr(nxt); }
        for (int t = 0; t < nt; t += 2) {
            const bool last = (t == nt - 2);
            const char* a1 = abase + (size_t)(t + 1) * ka;
            const char* a2 = last ? abase : abase + (size_t)(t + 2) * ka; const char* b2 = last ? nB : cB + (size_t)(t + 2) * kstep;
            const char* a3 = a2 + ka; const char* b3 = b2 + kstep;
            const unsigned x00 = last ? na00 : va00, x01 = last ? na01 : va01, x10 = last ? na10 : va10, x11 = last ? na11 : va11;
            PG8_LDB(B0, 0, 0); PG8_LDB(B1, 0, 1); PG8_SCHED; PG8_LDA(At, 0, 0); PG8_STAGE(PG8_SA(1, 1), a1, va10, va11);
            PG8_WAIT_V(8); PG8_WAIT_L(0); PG8_BAR; PG8_MMA(0, 0, At, B0); PG8_MMA(0, 1, At, B1); PG8_BAR; PG8_SCHED;
            PG8_LDA(At, 0, 1); PG8_STAGE(PG8_SB(0, 0), b2, voffB[0], voffB[1]); PG8_STAGE(PG8_SB(0, 1), b2 + hstep, voffB[0], voffB[1]); PG8_STAGE(PG8_SA(0, 0), a2, x00, x01);
            PG8_WAIT_V(8); PG8_WAIT_L(0); PG8_BAR; PG8_MMA(1, 0, At, B0); PG8_MMA(1, 1, At, B1); PG8_BAR; PG8_SCHED;
            PG8_LDB(B0, 1, 0); PG8_LDB(B1, 1, 1); PG8_SCHED; PG8_LDA(At, 1, 0); PG8_STAGE(PG8_SA(0, 1), a2, x10, x11);
            PG8_WAIT_V(8); PG8_WAIT_L(0); PG8_BAR; PG8_MMA(0, 0, At, B0); PG8_MMA(0, 1, At, B1); PG8_BAR; PG8_SCHED;
            PG8_LDA(At, 1, 1); PG8_STAGE(PG8_SB(1, 0), b3, voffB[0], voffB[1]); PG8_STAGE(PG8_SB(1, 1), b3 + hstep, voffB[0], voffB[1]); PG8_STAGE(PG8_SA(1, 0), a3, x00, x01);
            PG8_WAIT_V(8); PG8_WAIT_L(0); PG8_BAR; PG8_MMA(1, 0, At, B0); PG8_MMA(1, 1, At, B1); PG8_BAR; PG8_SCHED;
        }
        if (wr == 0) PG8_BAR;
        E(acc, cur, wr, wc, fr, fq);
        if (!has_next) break;
#pragma unroll
        for (int a = 0; a < 2; ++a)
#pragma unroll
            for (int b = 0; b < 2; ++b)
#pragma unroll
                for (int m = 0; m < 4; ++m)
#pragma unroll
                    for (int n = 0; n < 2; ++n) acc[a][b][m][n] = (f32x4){0.f, 0.f, 0.f, 0.f};
        cur = nxt; cB = nB; va00 = na00; va01 = na01; va10 = na10; va11 = na11; ++ui;
        if (wr == 1) PG8_BAR;
    }
    PG8_WAIT_V(0);
    PG8_BAR;
#undef PG8_SA
#undef PG8_SB
#undef PG8_STAGE
#undef PG8_LDA
#undef PG8_LDB
#undef PG8_MMA
#undef PG8_WAIT_V
#undef PG8_WAIT_L
#undef PG8_BAR
#undef PG8_SCHED
}
}

__host__ __device__ __forceinline__ int vperm(int key) { const int x = key & 31; return (key & ~31) | (8 * ((x >> 2) & 3) + 4 * ((x >> 4) & 1) + (x & 3)); }
using pg8::Unit;
struct SchedDense {
    const char* abase; unsigned a_kstep; int K;
    unsigned a_base; unsigned lda; const char* Bt; pg8::DenseOrder ord;
    __device__ __forceinline__ bool next(int i, Unit& u) const { return ord.next(i, u); }
    __device__ __forceinline__ unsigned a_off(const Unit& u, int R) const { return a_base + (unsigned)(u.pm * 256 + R) * lda; }
    __device__ __forceinline__ const char* b_ptr(const Unit& u) const { return Bt + (size_t)u.pn * 256 * K * 2; }
};
__device__ __forceinline__ SchedDense make_dense(const char* ws, size_t a_off, int lda_bytes, const char* Bt, int M, int N, int K) {
    SchedDense S; S.abase = ws; S.a_kstep = 128; S.K = K; S.a_base = (unsigned)a_off; S.lda = (unsigned)lda_bytes; S.Bt = Bt; S.ord.init(M / 256, N / 256, (int)gridDim.x, (int)blockIdx.x); return S;
}
struct SchedCmp1 {
    const char* abase; unsigned a_kstep; int K; const char* Bt; pg8::DenseOrder ord;
    __device__ __forceinline__ bool next(int i, Unit& u) const { return ord.next(i, u); }
    __device__ __forceinline__ unsigned a_off(const Unit& u, int R) const {
        const int row = u.pm * 256 + R, g = row & 3, bn = row >> 2, b = bn >> 9; int n = bn & 511; n = n > 510 ? 510 : n;
        return (unsigned)(u.pn ? WS_VCR : WS_KCR) + (unsigned)(((b * SEQ + 16 * n) * KVW + g * HD) * 2);
    }
    __device__ __forceinline__ const char* b_ptr(const Unit& u) const { return Bt + (size_t)u.pn * 256 * 2048 * 2; }
};
struct SchedCmp2 {
    const char* abase; unsigned a_kstep; int K; const char* Bt; pg8::DenseOrder ord;
    __device__ __forceinline__ bool next(int i, Unit& u) const { return ord.next(i, u); }
    __device__ __forceinline__ unsigned a_off(const Unit& u, int R) const { return (unsigned)WS_CMPH + (unsigned)(((u.pn * 16384) + u.pm * 256 + R) * 512); }
    __device__ __forceinline__ const char* b_ptr(const Unit& u) const { return Bt + (size_t)u.pn * 256 * 256 * 2; }
};

struct EpiProj {
    static constexpr bool PERM = true;
    unsigned char* ws;
    __device__ __forceinline__ void operator()(const f32x4 (&acc)[2][2][4][2], const Unit& u, int wr, int wc, int fr, int fq) const {
        const int pn = u.pn;
#pragma unroll
        for (int ai = 0; ai < 2; ++ai)
#pragma unroll
            for (int m = 0; m < 4; ++m) {
                const int row = u.pm * 256 + 128 * ai + 64 * wr + 16 * m + fr;
#pragma unroll
                for (int bj = 0; bj < 2; ++bj) {
                    const int c8 = 128 * bj + 32 * wc + 8 * fq;
                    float v[8];
#pragma unroll
                    for (int j = 0; j < 4; ++j) { v[j] = acc[ai][bj][m][0][j]; v[4 + j] = acc[ai][bj][m][1][j]; }
                    if (pn < 12 && pn != 9 && pn != 11) {
                        bf16_t* dst; float sc = 1.0f;
                        if (pn < 2) dst = (bf16_t*)(ws + WS_U) + (size_t)row * 512 + pn * 256 + c8;
                        else if (pn < 6) { dst = (bf16_t*)(ws + WS_Q) + (size_t)row * 1024 + (pn - 2) * 256 + c8; sc = 0.125f * 1.4426950408889634f; }
                        else { const size_t off = pn == 6 ? WS_KCR : pn == 7 ? WS_VCR : pn == 8 ? WS_KS : WS_KW; dst = (bf16_t*)(ws + off) + (size_t)row * 256 + c8; }
                        u32x4 w; w.x = pk2(v[0] * sc, v[1] * sc); w.y = pk2(v[2] * sc, v[3] * sc); w.z = pk2(v[4] * sc, v[5] * sc); w.w = pk2(v[6] * sc, v[7] * sc);
                        *(u32x4*)dst = w;
                    } else if (pn == 9 || pn == 11) {
                        bf16_t* base = (bf16_t*)(ws + (pn == 9 ? WS_VST : WS_VWT));
                        const int b = row >> 13, t = row & (SEQ - 1);
#pragma unroll
                        for (int e = 0; e < 8; ++e) { const int c = c8 + e, g = c >> 6, d = c & 63; base[((size_t)((b * 4 + g) * 64 + d)) * SEQ + vperm(t)] = (bf16_t)f2bf(v[e]); }
                    } else if (pn < 20) {
                        unsigned char* dst = ws + WS_MG + (size_t)row * 2048 + (pn - 12) * 256 + c8;
                        int w0 = __builtin_amdgcn_cvt_pk_fp8_f32(sigmoidf_(v[0]) * 64.f, sigmoidf_(v[1]) * 64.f, 0, false); w0 = __builtin_amdgcn_cvt_pk_fp8_f32(sigmoidf_(v[2]) * 64.f, sigmoidf_(v[3]) * 64.f, w0, true);
                        int w1 = __builtin_amdgcn_cvt_pk_fp8_f32(sigmoidf_(v[4]) * 64.f, sigmoidf_(v[5]) * 64.f, 0, false); w1 = __builtin_amdgcn_cvt_pk_fp8_f32(sigmoidf_(v[6]) * 64.f, sigmoidf_(v[7]) * 64.f, w1, true);
                        u32x2 w; w.x = (unsigned)w0; w.y = (unsigned)w1; *(u32x2*)dst = w;
                    } else {
                        if (c8 < 48) { float* dst = (float*)(ws + WS_GATES) + (size_t)row * 48 + c8;
                            *(f32x4*)dst = (f32x4){sigmoidf_(v[0]), sigmoidf_(v[1]), sigmoidf_(v[2]), sigmoidf_(v[3])}; *(f32x4*)(dst + 4) = (f32x4){sigmoidf_(v[4]), sigmoidf_(v[5]), sigmoidf_(v[6]), sigmoidf_(v[7])}; }
                    }
                }
            }
    }
};
struct EpiCmp1 {
    static constexpr bool PERM = true;
    unsigned char* ws;
    __device__ __forceinline__ void operator()(const f32x4 (&acc)[2][2][4][2], const Unit& u, int wr, int wc, int fr, int fq) const {
        const float* bias = (const float*)(ws + WS_CTL + 65536) + u.pn * 256;
#pragma unroll
        for (int bj = 0; bj < 2; ++bj) {
            const int c8 = 128 * bj + 32 * wc + 8 * fq;
            const f32x4 b0 = *(const f32x4*)(bias + c8), b1 = *(const f32x4*)(bias + c8 + 4);
#pragma unroll
            for (int ai = 0; ai < 2; ++ai)
#pragma unroll
                for (int m = 0; m < 4; ++m) {
                    const int row = u.pm * 256 + 128 * ai + 64 * wr + 16 * m + fr;
                    const f32x4 x0 = acc[ai][bj][m][0] + b0, x1 = acc[ai][bj][m][1] + b1;
                    u32x4 w; w.x = pk2(gelu_tanh(x0[0]), gelu_tanh(x0[1])); w.y = pk2(gelu_tanh(x0[2]), gelu_tanh(x0[3])); w.z = pk2(gelu_tanh(x1[0]), gelu_tanh(x1[1])); w.w = pk2(gelu_tanh(x1[2]), gelu_tanh(x1[3]));
                    *(u32x4*)((bf16_t*)(ws + WS_CMPH) + ((size_t)u.pn * 16384 + row) * 256 + c8) = w;
                }
        }
    }
};
struct EpiCmp2 {
    static constexpr bool PERM = false;
    unsigned char* ws;
    __device__ __forceinline__ void operator()(const f32x4 (&acc)[2][2][4][2], const Unit& u, int wr, int wc, int fr, int fq) const {
        if (wc >= 2) return;
#pragma unroll
        for (int ai = 0; ai < 2; ++ai)
#pragma unroll
            for (int m = 0; m < 4; ++m) {
                const int row = u.pm * 256 + 128 * ai + 64 * wr + 16 * m + fr;
#pragma unroll
                for (int n = 0; n < 2; ++n) {
                    const int c = 32 * wc + 16 * n + 4 * fq; const f32x4 x = acc[ai][0][m][n];
                    if (u.pn == 0) { u32x2 w; w.x = pk2(x[0], x[1]); w.y = pk2(x[2], x[3]); *(u32x2*)((bf16_t*)(ws + WS_KC) + (size_t)row * 64 + c) = w; }
                    else { const int g = row & 3, bn = row >> 2, b = bn >> 9, nn = bn & 511; bf16_t* base = (bf16_t*)(ws + WS_VCT) + ((size_t)((b * 4 + g) * 64 + c)) * NCMP_PAD + vperm(nn);
#pragma unroll
                        for (int j = 0; j < 4; ++j) base[(size_t)j * NCMP_PAD] = (bf16_t)f2bf(x[j]); }
                }
            }
    }
};
struct EpiGlu {
    static constexpr bool PERM = true;
    unsigned char* ws;
    __device__ __forceinline__ void operator()(const f32x4 (&acc)[2][2][4][2], const Unit& u, int wr, int wc, int fr, int fq) const {
        const int col = u.pn * 128 + 32 * wc + 8 * fq;
#pragma unroll
        for (int ai = 0; ai < 2; ++ai) {
            u32x2 g0[4], g1[4]; u32x4 yn[4];
#pragma unroll
            for (int m = 0; m < 4; ++m) { const int row = u.pm * 256 + 128 * ai + 64 * wr + 16 * m + fr;
                g0[m] = *(const u32x2*)(ws + WS_MG + (size_t)row * 2048 + col);
                g1[m] = *(const u32x2*)(ws + WS_MG + (size_t)row * 2048 + 1024 + col);
                yn[m] = *(const u32x4*)((const bf16_t*)(ws + WS_YNSA) + (size_t)row * 1024 + col); }
#pragma unroll
            for (int m = 0; m < 4; ++m) { const int row = u.pm * 256 + 128 * ai + 64 * wr + 16 * m + fr;
                float o[8];
#pragma unroll
                for (int e = 0; e < 8; ++e) { const float val = acc[ai][0][m][e >> 2][e & 3], gate = acc[ai][1][m][e >> 2][e & 3]; const float ys = val * sigmoidf_(gate);
                    const unsigned wy = yn[m][e >> 1];
                    const f32x2 p0 = ((e >> 1) & 1) ? __builtin_amdgcn_cvt_pk_f32_fp8((int)g0[m][e >> 2], true) : __builtin_amdgcn_cvt_pk_f32_fp8((int)g0[m][e >> 2], false);
                    const f32x2 p1 = ((e >> 1) & 1) ? __builtin_amdgcn_cvt_pk_f32_fp8((int)g1[m][e >> 2], true) : __builtin_amdgcn_cvt_pk_f32_fp8((int)g1[m][e >> 2], false);
                    const float a0 = (e & 1) ? p0.y : p0.x, a1 = (e & 1) ? p1.y : p1.x, yy = (e & 1) ? bfhi(wy) : bflo(wy);
                    o[e] = (a0 * ys + a1 * yy) * (1.0f / 64.0f); }
                u32x4 w; w.x = pk2(o[0], o[1]); w.y = pk2(o[2], o[3]); w.z = pk2(o[4], o[5]); w.w = pk2(o[6], o[7]);
                *(u32x4*)((bf16_t*)(ws + WS_MERGED) + (size_t)row * 1024 + col) = w; }
        }
    }
};
struct EpiWout {
    static constexpr bool PERM = false;
    const float* x; float* out; const float* gmod;
    __device__ __forceinline__ void operator()(const f32x4 (&acc)[2][2][4][2], const Unit& u, int wr, int wc, int fr, int fq) const {
        const int b = u.pm >> 5;
#pragma unroll
        for (int bj = 0; bj < 2; ++bj)
#pragma unroll
            for (int n = 0; n < 2; ++n) {
                const int col = u.pn * 256 + 128 * bj + 32 * wc + 16 * n + 4 * fq; const f32x4 gv = *(const f32x4*)(gmod + (size_t)b * 6144 + col);
                f32x4 xv[2][4];
#pragma unroll
                for (int ai = 0; ai < 2; ++ai)
#pragma unroll
                    for (int m = 0; m < 4; ++m) xv[ai][m] = *(const f32x4*)(x + (size_t)(u.pm * 256 + 128 * ai + 64 * wr + 16 * m + fr) * 1024 + col);
#pragma unroll
                for (int ai = 0; ai < 2; ++ai)
#pragma unroll
                    for (int m = 0; m < 4; ++m) { const f32x4 rv = xv[ai][m] * DN_ALPHA + gv * acc[ai][bj][m][n]; u32x2 w; w.x = pk2(rv[0], rv[1]); w.y = pk2(rv[2], rv[3]);
                        *(u32x2*)((bf16_t*)(out + (size_t)(u.pm * 256 + 128 * ai + 64 * wr + 16 * m + fr) * 1024) + col) = w; }
            }
    }
};
struct EpiF32 {
    static constexpr bool PERM = false;
    float* C; int ldc;
    __device__ __forceinline__ void operator()(const f32x4 (&acc)[2][2][4][2], const Unit& u, int wr, int wc, int fr, int fq) const {
#pragma unroll
        for (int ai = 0; ai < 2; ++ai)
#pragma unroll
            for (int m = 0; m < 4; ++m) { float* rowp = C + (size_t)(u.pm * 256 + 128 * ai + 64 * wr + 16 * m + fr) * ldc + u.pn * 256 + 32 * wc + 4 * fq;
#pragma unroll
                for (int bj = 0; bj < 2; ++bj)
#pragma unroll
                    for (int n = 0; n < 2; ++n) *(f32x4*)(rowp + bj * 128 + n * 16) = acc[ai][bj][m][n]; }
    }
};
struct EpiSwiglu {
    static constexpr bool PERM = true;
    bf16_t* H;
    __device__ __forceinline__ void operator()(const f32x4 (&acc)[2][2][4][2], const Unit& u, int wr, int wc, int fr, int fq) const {
#pragma unroll
        for (int ai = 0; ai < 2; ++ai)
#pragma unroll
            for (int m = 0; m < 4; ++m) {
                const size_t row = (size_t)u.pm * 256 + 128 * ai + 64 * wr + 16 * m + fr; const int col = u.pn * 128 + 32 * wc + 8 * fq;
                float o[8];
#pragma unroll
                for (int e = 0; e < 8; ++e) o[e] = siluf_(acc[ai][0][m][e >> 2][e & 3]) * acc[ai][1][m][e >> 2][e & 3];
                u32x4 w; w.x = pk2(o[0], o[1]); w.y = pk2(o[2], o[3]); w.z = pk2(o[4], o[5]); w.w = pk2(o[6], o[7]);
                *(u32x4*)(H + row * 256 + col) = w;
            }
    }
};

__device__ __forceinline__ int find_expert(const LAS int* tstart, int tau) {
    int lo = 0, hi = 256;
    while (hi - lo > 1) { const int mid = (lo + hi) >> 1; if (tstart[mid] <= tau) lo = mid; else hi = mid; }
    return lo;
}
struct SchedMoeGU {
    const char* abase; unsigned a_kstep; int K; const LAS int* tstart; const int* rowasg; const char* W; int G, c;
    __device__ __forceinline__ bool next(int i, Unit& u) const { const int x = c & 7, slot = c >> 3, per = (G >> 3) >> 1; const int tau = (i * 8 + x) * per + (slot >> 1); if ((G & 15) != 0 || tau >= tstart[256]) { if ((G & 15) != 0) { const int L = i * G + c; if (L >= 2 * tstart[256]) return false; u.pm = L >> 1; u.pn = L & 1; return true; } return false; } u.pm = tau; u.pn = slot & 1; return true; }
    __device__ __forceinline__ unsigned a_off(const Unit& u, int R) const { const int a = rowasg[u.pm * 256 + R]; const unsigned tok = a < 0 ? (unsigned)MTOK : (unsigned)a >> 3; return (unsigned)WS_H2 + tok * 2048u; }
    __device__ __forceinline__ const char* b_ptr(const Unit& u) const { const int e = find_expert(tstart, u.pm); return W + ((size_t)e * 512 + u.pn * 256) * 1024 * 2; }
};
struct SchedMoeD {
    const char* abase; unsigned a_kstep; int K; const LAS int* tstart; const char* W; int G, c;
    __device__ __forceinline__ bool next(int i, Unit& u) const { const int x = c & 7, slot = c >> 3, per = (G >> 3) >> 2; const int tau = (i * 8 + x) * per + (slot >> 2); if ((G & 31) != 0 || tau >= tstart[256]) { if ((G & 31) != 0) { const int L = i * G + c; if (L >= 4 * tstart[256]) return false; u.pm = L >> 2; u.pn = L & 3; return true; } return false; } u.pm = tau; u.pn = slot & 3; return true; }
    __device__ __forceinline__ unsigned a_off(const Unit& u, int R) const { return (unsigned)WS_HID + (unsigned)(u.pm * 256 + R) * 512u; }
    __device__ __forceinline__ const char* b_ptr(const Unit& u) const { const int e = find_expert(tstart, u.pm); return W + ((size_t)e * 1024 + u.pn * 256) * 256 * 2; }
};
struct EpiMoeDown {
    static constexpr bool PERM = true;
    unsigned char* O; const int* rowasg; const float* roww; int asg0;
    __device__ __forceinline__ void operator()(const f32x4 (&acc)[2][2][4][2], const Unit& u, int wr, int wc, int fr, int fq) const {
        int av[2][4]; float wv[2][4];
#pragma unroll
        for (int ai = 0; ai < 2; ++ai)
#pragma unroll
            for (int m = 0; m < 4; ++m) { const int row = u.pm * 256 + 128 * ai + 64 * wr + 16 * m + fr; av[ai][m] = rowasg[row]; wv[ai][m] = roww[row] * OUTS_SCALE; }
#pragma unroll
        for (int ai = 0; ai < 2; ++ai)
#pragma unroll
            for (int m = 0; m < 4; ++m) {
                const int a = av[ai][m]; const float w = wv[ai][m];
                if (a >= 0) { unsigned char* rowp = O + (size_t)(a - asg0) * 1024 + u.pn * 256 + 32 * wc + 8 * fq;
#pragma unroll
                    for (int bj = 0; bj < 2; ++bj) { f32x4 x0 = acc[ai][bj][m][0] * w, x1 = acc[ai][bj][m][1] * w;
#pragma unroll
                        for (int e = 0; e < 4; ++e) { x0[e] = fminf(fmaxf(x0[e], -440.f), 440.f); x1[e] = fminf(fmaxf(x1[e], -440.f), 440.f); }
                        int w0 = __builtin_amdgcn_cvt_pk_fp8_f32(x0[0], x0[1], 0, false); w0 = __builtin_amdgcn_cvt_pk_fp8_f32(x0[2], x0[3], w0, true);
                        int w1 = __builtin_amdgcn_cvt_pk_fp8_f32(x1[0], x1[1], 0, false); w1 = __builtin_amdgcn_cvt_pk_fp8_f32(x1[2], x1[3], w1, true);
                        u32x2 o; o.x = (unsigned)w0; o.y = (unsigned)w1; *(u32x2*)(rowp + bj * 128) = o; } }
            }
    }
};
struct EpiShDown {
    static constexpr bool PERM = true;
    unsigned char* O;
    __device__ __forceinline__ void operator()(const f32x4 (&acc)[2][2][4][2], const Unit& u, int wr, int wc, int fr, int fq) const {
#pragma unroll
        for (int ai = 0; ai < 2; ++ai)
#pragma unroll
            for (int m = 0; m < 4; ++m) { unsigned char* rowp = O + (size_t)(u.pm * 256 + 128 * ai + 64 * wr + 16 * m + fr) * 1024 + u.pn * 256 + 32 * wc + 8 * fq;
#pragma unroll
                for (int bj = 0; bj < 2; ++bj) { f32x4 x0 = acc[ai][bj][m][0] * OUTS_SCALE, x1 = acc[ai][bj][m][1] * OUTS_SCALE;
#pragma unroll
                    for (int e = 0; e < 4; ++e) { x0[e] = fminf(fmaxf(x0[e], -440.f), 440.f); x1[e] = fminf(fmaxf(x1[e], -440.f), 440.f); }
                    int w0 = __builtin_amdgcn_cvt_pk_fp8_f32(x0[0], x0[1], 0, false); w0 = __builtin_amdgcn_cvt_pk_fp8_f32(x0[2], x0[3], w0, true);
                    int w1 = __builtin_amdgcn_cvt_pk_fp8_f32(x1[0], x1[1], 0, false); w1 = __builtin_amdgcn_cvt_pk_fp8_f32(x1[2], x1[3], w1, true);
                    u32x2 o; o.x = (unsigned)w0; o.y = (unsigned)w1; *(u32x2*)(rowp + bj * 128) = o; } }
    }
};

__device__ __forceinline__ void transpose_item(const float* src, size_t ld, int nvalid, bf16_t* dst, size_t dld, LAS float* scr, int lane) {
    { const int j4 = lane & 7, k8 = lane >> 3;
        f32x4 v[8];
#pragma unroll
        for (int i = 0; i < 8; ++i) v[i] = 4 * j4 < nvalid ? *(const f32x4*)(src + (size_t)(8 * i + k8) * ld + 4 * j4) : (f32x4){0.f, 0.f, 0.f, 0.f};
#pragma unroll
        for (int i = 0; i < 8; ++i) { LAS float* d = scr + (8 * i + k8) * 33 + 4 * j4; d[0] = v[i][0]; d[1] = v[i][1]; d[2] = v[i][2]; d[3] = v[i][3]; } }
    LDS_WAIT(); asm volatile("" ::: "memory");
    const int c = lane & 7;
#pragma unroll
    for (int j = 0; j < 4; ++j) { const int n = (lane >> 3) + 8 * j; const LAS float* s = scr + (8 * c) * 33 + n;
        u32x4 o; o.x = pk2(s[0 * 33], s[1 * 33]); o.y = pk2(s[2 * 33], s[3 * 33]); o.z = pk2(s[4 * 33], s[5 * 33]); o.w = pk2(s[6 * 33], s[7 * 33]);
        *(u32x4*)(dst + (size_t)n * dld + 8 * c) = o; }
    LDS_WAIT(); asm volatile("" ::: "memory");
}
__device__ __forceinline__ void transpose_item2(const float* srcA, size_t ldA, bf16_t* dstA, size_t dldA, const float* srcB, size_t ldB, bf16_t* dstB, size_t dldB, LAS float* scr, int lane) {
    const int j4 = lane & 7, k8 = lane >> 3, c = lane & 7;
    f32x4 va[8], vb[8];
#pragma unroll
    for (int i = 0; i < 8; ++i) va[i] = *(const f32x4*)(srcA + (size_t)(8 * i + k8) * ldA + 4 * j4);
#pragma unroll
    for (int i = 0; i < 8; ++i) vb[i] = *(const f32x4*)(srcB + (size_t)(8 * i + k8) * ldB + 4 * j4);
#pragma unroll
    for (int i = 0; i < 8; ++i) { LAS float* d = scr + (8 * i + k8) * 33 + 4 * j4; d[0] = va[i][0]; d[1] = va[i][1]; d[2] = va[i][2]; d[3] = va[i][3]; }
    LDS_WAIT(); asm volatile("" ::: "memory");
#pragma unroll
    for (int j = 0; j < 4; ++j) { const int n = (lane >> 3) + 8 * j; const LAS float* sp = scr + (8 * c) * 33 + n;
        u32x4 o; o.x = pk2(sp[0 * 33], sp[1 * 33]); o.y = pk2(sp[2 * 33], sp[3 * 33]); o.z = pk2(sp[4 * 33], sp[5 * 33]); o.w = pk2(sp[6 * 33], sp[7 * 33]);
        *(u32x4*)(dstA + (size_t)n * dldA + 8 * c) = o; }
    LDS_WAIT(); asm volatile("" ::: "memory");
#pragma unroll
    for (int i = 0; i < 8; ++i) { LAS float* d = scr + (8 * i + k8) * 33 + 4 * j4; d[0] = vb[i][0]; d[1] = vb[i][1]; d[2] = vb[i][2]; d[3] = vb[i][3]; }
    LDS_WAIT(); asm volatile("" ::: "memory");
#pragma unroll
    for (int j = 0; j < 4; ++j) { const int n = (lane >> 3) + 8 * j; const LAS float* sp = scr + (8 * c) * 33 + n;
        u32x4 o; o.x = pk2(sp[0 * 33], sp[1 * 33]); o.y = pk2(sp[2 * 33], sp[3 * 33]); o.z = pk2(sp[4 * 33], sp[5 * 33]); o.w = pk2(sp[6 * 33], sp[7 * 33]);
        *(u32x4*)(dstB + (size_t)n * dldB + 8 * c) = o; }
    LDS_WAIT(); asm volatile("" ::: "memory");
}
struct In {
    const float *x, *c, *ada_w, *ada_b, *w_in, *lam_re, *lam_im, *log_step, *b_re, *b_im, *c_re, *c_im, *ssm_d, *glu_w, *cmp_pos, *cmp_w1, *cmp_w2, *rel_bias, *w_out,
        *ln1_g, *ln1_b, *router_w, *router_bias, *w_gate, *w_up, *w_down, *sh_gate, *sh_up, *sh_down, *ln2_g, *ln2_b;
};
static_assert(sizeof(In) == 31 * sizeof(void*), "In");

__device__ __forceinline__ void p0_small_weights(const In& in, unsigned char* ws, LAS float* scr, int gw, int NGW, int lane) {
    constexpr int I_WIN = 168 * 16, I_GLU = 64 * 8, I_WOUT = 32 * 16, I_ROUT = 8 * 16, I_SHGU = 16 * 16, I_SHD = 32 * 4, I_CW1 = 2 * 8 * 32, I_CW2 = 2 * 2 * 4;
    constexpr int NITEMS = I_WIN + I_GLU + I_WOUT + I_ROUT + I_SHGU + I_SHD + I_CW1 + I_CW2;
    for (int it = gw; it < NITEMS; it += NGW) {
        int r = it;
        if (r < I_WIN) { const int db = r / 16, kb = r % 16, n0 = 32 * db; int src, nv = 32;
            if (n0 < 3072) src = n0; else if (n0 < 5120) src = n0 + 48; else if (n0 < 5152) src = n0 - 2048; else if (n0 == 5152) { src = 3104; nv = 16; } else { src = 0; nv = 0; }
            transpose_item(in.w_in + (size_t)(64 * kb) * 5168 + src, 5168, nv, (bf16_t*)(ws + WS_WIN) + (size_t)n0 * 1024 + 64 * kb, 1024, scr, lane); continue; } r -= I_WIN;
        if (r < I_GLU) { const int db = r / 8, kb = r % 8, n0 = 32 * db, pn = n0 >> 8, half = (n0 >> 7) & 1, j = n0 & 127;
            transpose_item(in.glu_w + (size_t)(64 * kb) * 2048 + half * 1024 + pn * 128 + j, 2048, 32, (bf16_t*)(ws + WS_GLU) + (size_t)n0 * 512 + 64 * kb, 512, scr, lane); continue; } r -= I_GLU;
        if (r < I_WOUT) { const int db = r / 16, kb = r % 16;
            transpose_item(in.w_out + (size_t)(64 * kb) * 1024 + 32 * db, 1024, 32, (bf16_t*)(ws + WS_WOUT) + (size_t)(32 * db) * 1024 + 64 * kb, 1024, scr, lane); continue; } r -= I_WOUT;
        if (r < I_ROUT) { const int db = r / 16, kb = r % 16;
            transpose_item(in.router_w + (size_t)(64 * kb) * 256 + 32 * db, 256, 32, (bf16_t*)(ws + WS_ROUT) + (size_t)(32 * db) * 1024 + 64 * kb, 1024, scr, lane); continue; } r -= I_ROUT;
        if (r < I_SHGU) { const int db = r / 16, kb = r % 16, n0 = 32 * db, pn = n0 >> 8, half = (n0 >> 7) & 1, j = n0 & 127;
            transpose_item((half ? in.sh_up : in.sh_gate) + (size_t)(64 * kb) * 256 + pn * 128 + j, 256, 32, (bf16_t*)(ws + WS_SHGU) + (size_t)n0 * 1024 + 64 * kb, 1024, scr, lane); continue; } r -= I_SHGU;
        if (r < I_SHD) { const int db = r / 4, kb = r % 4;
            transpose_item(in.sh_down + (size_t)(64 * kb) * 1024 + 32 * db, 1024, 32, (bf16_t*)(ws + WS_SHD) + (size_t)(32 * db) * 256 + 64 * kb, 256, scr, lane); continue; } r -= I_SHD;
        if (r < I_CW1) { const int ts = r / 256, rr = r % 256, db = rr / 32, kb = rr % 32;
            transpose_item(in.cmp_w1 + (size_t)ts * 2048 * 256 + (size_t)(64 * kb) * 256 + 32 * db, 256, 32, (bf16_t*)(ws + WS_CW1) + (size_t)ts * 256 * 2048 + (size_t)(32 * db) * 2048 + 64 * kb, 2048, scr, lane); continue; } r -= I_CW1;
        { const int ts = r / 8, rr = r % 8, db = rr / 4, kb = rr % 4;
            transpose_item(in.cmp_w2 + (size_t)ts * 256 * 64 + (size_t)(64 * kb) * 64 + 32 * db, 64, 32, (bf16_t*)(ws + WS_CW2) + (size_t)ts * 256 * 256 + (size_t)(32 * db) * 256 + 64 * kb, 256, scr, lane); }
    }
    for (int i = gw * 64 + lane; i < 2 * 192 * 32; i += NGW * 64) { const int ts = i / (192 * 32), rr = i % (192 * 32); *(u32x4*)(ws + WS_CW2 + (size_t)ts * 256 * 512 + (size_t)64 * 512 + (size_t)rr * 16) = (u32x4){0u, 0u, 0u, 0u}; }
}
struct ConvItem { const float* src; size_t ld; bf16_t* dst; size_t dld; };
__device__ __forceinline__ void convert_expert_weights(const In& in, unsigned char* ws, LAS float* scr, int gw, int NGW, int lane, int part) {
    constexpr int I_GU = 256, I_D = 128;
    bool have = false; ConvItem pa{nullptr, 0, nullptr, 0};
    for (int it = gw; it < NEXP * (I_GU + I_D); it += NGW) {
        const int e = it / (I_GU + I_D), r = it % (I_GU + I_D);
        { const bool mid = e >= 63 && e <= 190; const bool early = r >= I_GU || !mid; if (early != (part == 0)) continue; }
        ConvItem d;
        if (r < I_GU) { const int db = r / 16, kb = r % 16, n0 = 32 * db, pn = n0 >> 8, half = (n0 >> 7) & 1, j = n0 & 127;
            d.src = (half ? in.w_up : in.w_gate) + (size_t)e * 1024 * 256 + (size_t)(64 * kb) * 256 + pn * 128 + j; d.ld = 256; d.dst = (bf16_t*)(ws + WS_WGU) + ((size_t)e * 512 + n0) * 1024 + 64 * kb; d.dld = 1024; }
        else { const int rr = r - I_GU, db = rr / 4, kb = rr % 4;
            d.src = in.w_down + (size_t)e * 256 * 1024 + (size_t)(64 * kb) * 1024 + 32 * db; d.ld = 1024; d.dst = (bf16_t*)(ws + WS_WD) + ((size_t)e * 1024 + 32 * db) * 256 + 64 * kb; d.dld = 256; }
        if (!have) { pa = d; have = true; }
        else { transpose_item2(pa.src, pa.ld, pa.dst, pa.dld, d.src, d.ld, d.dst, d.dld, scr, lane); have = false; }
    }
    if (have) transpose_item(pa.src, pa.ld, 32, pa.dst, pa.dld, scr, lane);
}

__device__ __forceinline__ void p0_mod(const In& in, unsigned char* ws, LAS unsigned char* lds, int tid) {
    LAS float* cond = (LAS float*)lds;
    LAS float* part = (LAS float*)(lds + 32768);
    for (int i = tid; i < 8192; i += NTHREADS) cond[i] = siluf_(in.c[i]);
    __syncthreads();
    const int col = tid % 24, ks = tid / 24, e = (int)blockIdx.x * 24 + col;
    if (tid < 504) {
        float a[8];
#pragma unroll
        for (int b = 0; b < 8; ++b) a[b] = 0.f;
        for (int k = ks; k < 1024; k += 21) { const float w = in.ada_w[(size_t)k * 6144 + e];
#pragma unroll
            for (int b = 0; b < 8; ++b) a[b] += cond[b * 1024 + k] * w; }
#pragma unroll
        for (int b = 0; b < 8; ++b) part[(ks * 24 + col) * 8 + b] = a[b];
    }
    __syncthreads();
    if (tid < 192) { const int c2 = tid % 24, b = tid / 24; float s = 0.f; for (int k = 0; k < 21; ++k) s += part[(k * 24 + c2) * 8 + b];
        const int e2 = (int)blockIdx.x * 24 + c2; ((float*)(ws + WS_MOD))[b * 6144 + e2] = s + in.ada_b[e2]; }
    __syncthreads();
}
__device__ __forceinline__ void p0_tables(const In& in, unsigned char* ws, LAS unsigned char* lds, int tid) {
    const int w = (int)blockIdx.x;
    if (w < 16) {
        const int ts = w >> 3, kq = w & 7, c = tid & 255, kh = tid >> 8; float s = 0.f;
        const float* pos = in.cmp_pos + ts * 2048; const float* w1 = in.cmp_w1 + (size_t)ts * 2048 * 256;
        for (int k = kq * 256 + kh * 128; k < kq * 256 + kh * 128 + 128; ++k) s += pos[k] * w1[(size_t)k * 256 + c];
        ((float*)(ws + WS_CTL + 131072))[((ts * 8 + kq) * 2 + kh) * 256 + c] = s;
    } else if (w == 16) {
        for (int i = tid; i < 16 * 132; i += NTHREADS) { const int h = i / 132, dd = i % 132; int bk;
            if (dd < 16) bk = dd; else { const int v = 16 + (int)(__logf((float)dd * (1.0f / 16.0f)) / 2.0794415416798357f * 16.0f); bk = v < 31 ? v : 31; }
            if (dd >= 128) bk = 31;
            ((float*)(ws + WS_TAB + TAB_LUT))[i] = in.rel_bias[bk * 16 + h] * 1.4426950408889634f; }
    } else if (w >= 32 && w < 64) {
        const int g = w - 32;
        LAS float* bbr = (LAS float*)lds; LAS float* bbi = bbr + 1024;
        if (tid < 64) { const int p = tid; const float lr = in.lam_re[g * 64 + p], li = in.lam_im[g * 64 + p], dt = expf(in.log_step[g]);
            const float mag = expf(lr * dt), ar = mag * cosf(li * dt), ai = mag * sinf(li * dt), den = lr * lr + li * li;
            const float kr = ((ar - 1.0f) * lr + ai * li) / den, ki = (ai * lr - (ar - 1.0f) * li) / den;
            for (int c = 0; c < 16; ++c) { const float br = in.b_re[(g * 64 + p) * 16 + c], bi = in.b_im[(g * 64 + p) * 16 + c]; bbr[p * 16 + c] = kr * br - ki * bi; bbi[p * 16 + c] = kr * bi + ki * br; }
            float* A = (float*)(ws + WS_S5T + S5_A) + (g * 64 + p) * 2; A[0] = ar; A[1] = ai;
            float xr = ar, xi = ai; for (int s = 0; s < 10; ++s) { const float nr = xr * xr - xi * xi, ni = 2.0f * xr * xi; xr = nr; xi = ni; }
            float* AC = (float*)(ws + WS_S5T + S5_AC) + (g * 64 + p) * 2; AC[0] = xr; AC[1] = xi; }
        __syncthreads();
        { const int f = tid >> 6, lane = tid & 63, pt = f >> 1, ri = f & 1, p = 16 * pt + (lane & 15), q = lane >> 4;
            bf16_t* dst = (bf16_t*)(ws + WS_S5T + S5_AFR) + ((size_t)(g * 8 + f) * 64 + lane) * 8;
            for (int j = 0; j < 8; ++j) { const float v = q < 2 ? (ri ? bbi : bbr)[p * 16 + 8 * q + j] : 0.f; dst[j] = (bf16_t)f2bf(v); } }
        if (tid < 256) { const int s = tid >> 6, lane = tid & 63, c = lane & 15, q = lane >> 4;
            bf16_t* dst = (bf16_t*)(ws + WS_S5T + S5_CFR) + ((size_t)(g * 4 + s) * 64 + lane) * 8;
            for (int j = 0; j < 8; ++j) { const int k = 32 * s + 8 * q + j, p = k >> 1; const float v = (k & 1) ? -in.c_im[(g * 16 + c) * 64 + p] : in.c_re[(g * 16 + c) * 64 + p]; dst[j] = (bf16_t)f2bf(v); } }
        __syncthreads();
    }
}

struct RowV { f32x4 v[4]; };
__device__ __forceinline__ RowV row_load(const float* p, int lane) { RowV r; const f32x4* q = (const f32x4*)p + lane;
#pragma unroll
    for (int j = 0; j < 4; ++j) r.v[j] = q[64 * j]; return r; }
__device__ __forceinline__ RowV row_load_bf16(const bf16_t* p, int lane) { RowV r; const u32x2* q = (const u32x2*)p + lane;
#pragma unroll
    for (int j = 0; j < 4; ++j) { const u32x2 w = q[64 * j]; r.v[j] = (f32x4){bflo(w.x), bfhi(w.x), bflo(w.y), bfhi(w.y)}; } return r; }
__device__ __forceinline__ void row_norm(RowV& r) {
    float s = 0.f;
#pragma unroll
    for (int j = 0; j < 4; ++j) s += (r.v[j].x + r.v[j].y) + (r.v[j].z + r.v[j].w);
    const float mean = wave_sum(s) * (1.f / DM); float s2 = 0.f;
#pragma unroll
    for (int j = 0; j < 4; ++j) { r.v[j] = r.v[j] - mean; s2 += (r.v[j].x * r.v[j].x + r.v[j].y * r.v[j].y) + (r.v[j].z * r.v[j].z + r.v[j].w * r.v[j].w); }
    const float rstd = 1.f / sqrtf(wave_sum(s2) * (1.f / DM) + LN_EPS);
#pragma unroll
    for (int j = 0; j < 4; ++j) r.v[j] = r.v[j] * rstd;
}
__device__ __forceinline__ void row_norm_stats(RowV& r, float& mean_o, float& rstd_o) {
    float s = 0.f;
#pragma unroll
    for (int j = 0; j < 4; ++j) s += (r.v[j].x + r.v[j].y) + (r.v[j].z + r.v[j].w);
    const float mean = wave_sum(s) * (1.f / DM); float s2 = 0.f;
#pragma unroll
    for (int j = 0; j < 4; ++j) { r.v[j] = r.v[j] - mean; s2 += (r.v[j].x * r.v[j].x + r.v[j].y * r.v[j].y) + (r.v[j].z * r.v[j].z + r.v[j].w * r.v[j].w); }
    const float rstd = 1.f / sqrtf(wave_sum(s2) * (1.f / DM) + LN_EPS);
#pragma unroll
    for (int j = 0; j < 4; ++j) r.v[j] = r.v[j] * rstd;
    mean_o = mean; rstd_o = rstd;
}
__device__ __forceinline__ void row_store_bf16(bf16_t* p, const RowV& r, int lane) { u32x2* o = (u32x2*)p + lane;
#pragma unroll
    for (int j = 0; j < 4; ++j) { u32x2 w; w.x = pk2(r.v[j].x, r.v[j].y); w.y = pk2(r.v[j].z, r.v[j].w); o[64 * j] = w; } }
__device__ __forceinline__ void ph_h1(const In& in, unsigned char* ws, int gw, int NGW, int lane) {
    const float* mod = (const float*)(ws + WS_MOD);
    for (int row = gw; row < MTOK; row += NGW) { const int b = row >> 13;
        RowV r = row_load(in.x + (size_t)row * DM, lane); row_norm(r);
        const RowV sh = row_load(mod + b * 6144, lane), sc = row_load(mod + b * 6144 + 1024, lane);
#pragma unroll
        for (int j = 0; j < 4; ++j) r.v[j] = r.v[j] * (sc.v[j] + 1.0f) + sh.v[j];
        row_store_bf16((bf16_t*)(ws + WS_H1) + (size_t)row * DM, r, lane); }
}
__device__ __forceinline__ void ph_ln1(const In& in, unsigned char* ws, float* r1, int gw, int NGW, int lane) {
    const float* mod = (const float*)(ws + WS_MOD);
    const RowV g = row_load(in.ln1_g, lane), bb = row_load(in.ln1_b, lane);
    for (int row = gw; row < MTOK; row += NGW) { const int b = row >> 13;
        RowV r = row_load_bf16((const bf16_t*)(r1 + (size_t)row * DM), lane); float mean, rstd; row_norm_stats(r, mean, rstd);
        if (lane == 0) *(f32x2*)((float*)(ws + WS_LNST) + (size_t)row * 2) = (f32x2){mean, rstd};
#pragma unroll
        for (int j = 0; j < 4; ++j) r.v[j] = r.v[j] * g.v[j] + bb.v[j];
        row_norm(r);
        const RowV sh = row_load(mod + b * 6144 + 3072, lane), sc = row_load(mod + b * 6144 + 4096, lane);
#pragma unroll
        for (int j = 0; j < 4; ++j) r.v[j] = r.v[j] * (sc.v[j] + 1.0f) + sh.v[j];
        row_store_bf16((bf16_t*)(ws + WS_H2) + (size_t)row * DM, r, lane); }
}
__device__ __forceinline__ void final_row(const In& in, unsigned char* ws, float* out, int tok, int chunk, const RowV& g, const RowV& bb, const RowV& g1, const RowV& b1, int lane) {
    const float* mod = (const float*)(ws + WS_MOD); const int b = tok >> 13;
    RowV v = row_load_bf16((const bf16_t*)(out + (size_t)tok * DM), lane); const RowV g2 = row_load(mod + b * 6144 + 5120, lane);
    const f32x2 stt = *(const f32x2*)((const float*)(ws + WS_LNST) + (size_t)tok * 2);
    const unsigned* sp = (const unsigned*)(ws + WS_OUTS + (size_t)(tok - chunk * CHUNK_TOK) * 8 * DM) + lane;
    const unsigned* shp = (const unsigned*)(ws + WS_SHOUT + (size_t)tok * DM) + lane;
    f32x4 acc[4];
#pragma unroll
    for (int j = 0; j < 4; ++j) { const int w = (int)shp[64 * j]; const f32x2 lo = __builtin_amdgcn_cvt_pk_f32_fp8(w, false), hi = __builtin_amdgcn_cvt_pk_f32_fp8(w, true); acc[j] = (f32x4){lo.x, lo.y, hi.x, hi.y}; }
#pragma unroll
    for (int k = 0; k < 8; ++k)
#pragma unroll
        for (int j = 0; j < 4; ++j) { const int w = (int)sp[k * 256 + 64 * j]; const f32x2 lo = __builtin_amdgcn_cvt_pk_f32_fp8(w, false), hi = __builtin_amdgcn_cvt_pk_f32_fp8(w, true);
            acc[j] = acc[j] + (f32x4){lo.x, lo.y, hi.x, hi.y}; }
#pragma unroll
    for (int j = 0; j < 4; ++j) { const f32x4 x1 = (v.v[j] - stt.x) * stt.y * g1.v[j] + b1.v[j]; v.v[j] = x1 * DN_ALPHA + g2.v[j] * (acc[j] * (1.0f / OUTS_SCALE)); }
    row_norm(v);
    f32x4* o = (f32x4*)(out + (size_t)tok * DM) + lane;
#pragma unroll
    for (int j = 0; j < 4; ++j) o[64 * j] = v.v[j] * g.v[j] + bb.v[j];
}
__device__ __forceinline__ void final_chunk(const In& in, unsigned char* ws, float* out, unsigned* ticket, int chunk, volatile LAS unsigned* bcast, int tid, int wave, int lane) {
    int ll = lane; asm volatile("" : "+v"(ll));
    const RowV g = row_load(in.ln2_g, ll), bb = row_load(in.ln2_b, ll), g1 = row_load(in.ln1_g, ll), b1 = row_load(in.ln1_b, ll);
    for (;;) {
        __syncthreads();
        if (tid == 0) bcast[0] = __hip_atomic_fetch_add(ticket, 64u, RLX_AGENT);
        __syncthreads();
        const unsigned base = bcast[0];
        if (base >= (unsigned)chunk_ntok(chunk)) break;
        for (int i = 0; i < 8; ++i) final_row(in, ws, out, chunk * CHUNK_TOK + (int)base + wave * 8 + i, chunk, g, bb, g1, b1, lane);
    }
}
constexpr int S5_LDS_PER_WAVE = 4352;
template <bool FULL>
__device__ __forceinline__ void s5_task(const In& in, unsigned char* ws, LAS unsigned char* wlds, int b, int g, int ch, int lane) {
    const int col = lane & 15, q = lane >> 4;
    LAS unsigned* BU = (LAS unsigned*)wlds;
    LAS unsigned char* XB = wlds;
    bf16x8 afr[8], cfr[4];
#pragma unroll
    for (int f = 0; f < 8; ++f) afr[f] = *(const bf16x8*)((const bf16_t*)(ws + WS_S5T + S5_AFR) + ((size_t)(g * 8 + f) * 64 + lane) * 8);
    if (FULL) {
#pragma unroll
        for (int s = 0; s < 4; ++s) cfr[s] = *(const bf16x8*)((const bf16_t*)(ws + WS_S5T + S5_CFR) + ((size_t)(g * 4 + s) * 64 + lane) * 8);
    }
    const float ar = ((const float*)(ws + WS_S5T + S5_A))[(g * 64 + lane) * 2], ai = ((const float*)(ws + WS_S5T + S5_A))[(g * 64 + lane) * 2 + 1];
    float xr = 0.f, xi = 0.f;
    float* st = (float*)(ws + WS_S5ST);
    if (FULL) {
        const float cr_ = ((const float*)(ws + WS_S5T + S5_AC))[(g * 64 + lane) * 2], ci_ = ((const float*)(ws + WS_S5T + S5_AC))[(g * 64 + lane) * 2 + 1];
        for (int c2 = 0; c2 < ch; ++c2) { const float sr = st[((size_t)((b * 32 + g) * 8 + c2) * 64 + lane) * 2], si = st[((size_t)((b * 32 + g) * 8 + c2) * 64 + lane) * 2 + 1];
            const float nr = cr_ * xr - ci_ * xi + sr, ni = cr_ * xi + ci_ * xr + si; xr = nr; xi = ni; }
    }
    const bf16_t* U = (const bf16_t*)(ws + WS_U);
    f32x4 dsk = (f32x4){0.f, 0.f, 0.f, 0.f};
    if (FULL) dsk = *(const f32x4*)(in.ssm_d + g * 16 + 4 * q);
    const size_t row00 = (size_t)b * SEQ + (size_t)ch * 1024;
    for (int sb = 0; sb < 64; ++sb) {
        const size_t row0 = row00 + 16 * sb;
        bf16x8 ufr = (bf16x8){0, 0, 0, 0, 0, 0, 0, 0};
        if (q < 2) ufr = *(const bf16x8*)(U + (row0 + col) * 512 + g * 16 + 8 * q);
#pragma unroll
        for (int pt = 0; pt < 4; ++pt) {
            const f32x4 dr = __builtin_amdgcn_mfma_f32_16x16x32_bf16(afr[2 * pt], ufr, (f32x4){0.f, 0.f, 0.f, 0.f}, 0, 0, 0);
            const f32x4 di = __builtin_amdgcn_mfma_f32_16x16x32_bf16(afr[2 * pt + 1], ufr, (f32x4){0.f, 0.f, 0.f, 0.f}, 0, 0, 0);
            u32x4 w; w.x = pk2(dr[0], di[0]); w.y = pk2(dr[1], di[1]); w.z = pk2(dr[2], di[2]); w.w = pk2(dr[3], di[3]);
            *(LAS u32x4*)(BU + col * 68 + 16 * pt + 4 * q) = w; }
        asm volatile("s_waitcnt lgkmcnt(0)" ::: "memory");
#pragma unroll
        for (int t = 0; t < 16; ++t) { const unsigned bw = BU[t * 68 + lane]; const float br = bflo(bw), bi = bfhi(bw);
            const float nr = ar * xr - ai * xi + br, ni = ar * xi + ai * xr + bi; xr = nr; xi = ni;
            if (FULL) *(LAS unsigned*)(XB + t * 272 + 4 * lane) = pk2(xr, xi); }
        asm volatile("s_waitcnt lgkmcnt(0)" ::: "memory");
        if (FULL) {
            f32x4 y = (f32x4){0.f, 0.f, 0.f, 0.f};
#pragma unroll
            for (int s = 0; s < 4; ++s) { const bf16x8 xf = *(const LAS bf16x8*)(XB + col * 272 + (32 * s + 8 * q) * 2); y = __builtin_amdgcn_mfma_f32_16x16x32_bf16(cfr[s], xf, y, 0, 0, 0); }
            const u32x2 uw = *(const u32x2*)(U + (row0 + col) * 512 + g * 16 + 4 * q);
            const f32x4 uv = (f32x4){bflo(uw.x), bfhi(uw.x), bflo(uw.y), bfhi(uw.y)};
            y = y + dsk * uv;
            u32x2 o; o.x = pk2(gelu_tanh(y[0]), gelu_tanh(y[1])); o.y = pk2(gelu_tanh(y[2]), gelu_tanh(y[3]));
            *(u32x2*)((bf16_t*)(ws + WS_Z) + (row0 + col) * 512 + g * 16 + 4 * q) = o;
            asm volatile("s_waitcnt lgkmcnt(0)" ::: "memory");
        }
    }
    if (!FULL) { st[((size_t)((b * 32 + g) * 8 + ch) * 64 + lane) * 2] = xr; st[((size_t)((b * 32 + g) * 8 + ch) * 64 + lane) * 2 + 1] = xi; }
}

constexpr int NSA_KB = 0, NSA_VB = 32768, NSA_IMP = 65536, NSA_RES = 65536;
static_assert(NSA_IMP + 67584 <= MISC_OFF && NSA_RES + 65536 <= MISC_OFF, "attention LDS map");
__device__ __forceinline__ bf16x8 pack8(const f32x4& a, const f32x4& b) {
    u32x4 w; w.x = pk2(a[0], a[1]); w.y = pk2(a[2], a[3]); w.z = pk2(b[0], b[1]); w.w = pk2(b[2], b[3]); return __builtin_bit_cast(bf16x8, w);
}
struct Softmax { float m; f32x4 l; };
typedef unsigned u32x2s __attribute__((ext_vector_type(2)));
__device__ __forceinline__ float fmax_x16(float x) { return fmaxf(x, __shfl_xor(x, 16)); }
__device__ __forceinline__ float fmax_x32(float x) { return fmaxf(x, __shfl_xor(x, 32)); }
__device__ __forceinline__ float fadd_x16(float x) { return x + __shfl_xor(x, 16); }
__device__ __forceinline__ float fadd_x32(float x) { return x + __shfl_xor(x, 32); }
__device__ __forceinline__ unsigned or_x16(unsigned u) { return u | __shfl_xor(u, 16); }
__device__ __forceinline__ unsigned or_x32(unsigned u) { return u | __shfl_xor(u, 32); }
__device__ __forceinline__ float dpp_x1(float x) { return __builtin_bit_cast(float, __builtin_amdgcn_update_dpp(0, __builtin_bit_cast(int, x), 0xB1, 0xF, 0xF, true)); }
__device__ __forceinline__ float dpp_x2(float x) { return __builtin_bit_cast(float, __builtin_amdgcn_update_dpp(0, __builtin_bit_cast(int, x), 0x4E, 0xF, 0xF, true)); }
__device__ __forceinline__ int dpp_x1i(int x) { return __builtin_amdgcn_update_dpp(0, x, 0xB1, 0xF, 0xF, true); }
__device__ __forceinline__ int dpp_x2i(int x) { return __builtin_amdgcn_update_dpp(0, x, 0x4E, 0xF, 0xF, true); }
__device__ __forceinline__ float ex2(float x) { return __builtin_amdgcn_exp2f(x); }
__device__ __forceinline__ float max16(const f32x4 (&S)[4]) {
    float a = fmaxf(fmaxf(S[0][0], S[0][1]), S[0][2]); a = fmaxf(fmaxf(a, S[0][3]), S[1][0]); a = fmaxf(fmaxf(a, S[1][1]), S[1][2]);
    float b = fmaxf(fmaxf(S[2][0], S[2][1]), S[2][2]); b = fmaxf(fmaxf(b, S[2][3]), S[3][0]); b = fmaxf(fmaxf(b, S[3][1]), S[3][2]);
    return fmaxf(fmaxf(a, S[1][3]), fmaxf(b, S[3][3]));
}
#define ONES8 ((bf16x8){(bf16_t)0x3F80, (bf16_t)0x3F80, (bf16_t)0x3F80, (bf16_t)0x3F80, (bf16_t)0x3F80, (bf16_t)0x3F80, (bf16_t)0x3F80, (bf16_t)0x3F80})
__device__ __forceinline__ void best_pair(float& bv, int& bj, float ov, int oj) { const bool take = (ov > bv) | ((ov == bv) & (oj < bj)); bv = take ? ov : bv; bj = take ? oj : bj; }
__device__ __forceinline__ void best_x16(float& bv, int& bj) { const float ov = __shfl_xor(bv, 16); const int oj = __shfl_xor(bj, 16); best_pair(bv, bj, ov, oj); }
__device__ __forceinline__ void best_x32(float& bv, int& bj) { const float ov = __shfl_xor(bv, 32); const int oj = __shfl_xor(bj, 32); best_pair(bv, bj, ov, oj); }
struct Stage { u32x4 k, v; };
__device__ __forceinline__ void stage_load(Stage& s, const unsigned char* kg, size_t kstride, const unsigned char* vg, size_t vstride, int tid, bool hasv) {
    const int row = tid >> 3, ch = tid & 7;
    s.k = *(const u32x4*)(kg + (size_t)row * kstride + ch * 16);
    if (hasv) s.v = *(const u32x4*)(vg + (size_t)row * vstride + ch * 16);
}
__device__ __forceinline__ void stage_store(const Stage& s, LAS unsigned char* lds, int buf, int tid, bool hasv) {
    const int row = tid >> 3, ch = tid & 7, off = row * 128 + ((ch ^ (row & 7)) << 4);
    *(LAS u32x4*)(lds + NSA_KB + buf * 8192 + off) = s.k;
    if (hasv) *(LAS u32x4*)(lds + NSA_VB + buf * 8192 + off) = s.v;
}
__device__ __forceinline__ bf16x8 lds_frag(const LAS unsigned char* base, int row, int ch) { return *(const LAS bf16x8*)(base + row * 128 + ((ch ^ (row & 7)) << 4)); }

__device__ __forceinline__ void select_blocks(const LAS float* impw, int tl, int r, int q, int cur, unsigned (&w)[4]) {
    w[0] = w[1] = w[2] = w[3] = 0u;
    if (cur < 16) { w[0] = (2u << cur) - 1u; return; }
    const int s16 = r * 4 + q;
    float cand[8];
#pragma unroll
    for (int k = 0; k < 8; ++k) { const int j = s16 + 16 * k; cand[k] = (j >= 1 && j <= cur - 2) ? impw[tl * 264 + j] + impw[tl * 264 + 132 + j] : -1.0f; }
    unsigned chosen = 0u;
    for (int it = 0; it < 13; ++it) {
        float bv = -2.0f; int bj = 1 << 20;
#pragma unroll
        for (int k = 0; k < 8; ++k) { const bool ok = !((chosen >> k) & 1u) && cand[k] > bv; bv = ok ? cand[k] : bv; bj = ok ? s16 + 16 * k : bj; }
        best_pair(bv, bj, dpp_x1(bv), dpp_x1i(bj)); best_pair(bv, bj, dpp_x2(bv), dpp_x2i(bj)); best_x16(bv, bj); best_x32(bv, bj);
        if ((bj & 15) == s16) chosen |= 1u << (bj >> 4);
    }
#pragma unroll
    for (int k = 0; k < 8; ++k) { const unsigned bit = ((chosen >> k) & 1u) << (s16 + 16 * (k & 1)); w[k >> 1] |= bit; }
#pragma unroll
    for (int x = 0; x < 4; ++x) { unsigned v = w[x]; v |= (unsigned)dpp_x1i((int)v); v |= (unsigned)dpp_x2i((int)v); v = or_x16(v); v = or_x32(v); w[x] = v; }
    w[0] |= 1u;
#pragma unroll
    for (int x = 0; x < 4; ++x) { if (((cur - 1) >> 5) == x) w[x] |= 1u << ((cur - 1) & 31); if ((cur >> 5) == x) w[x] |= 1u << (cur & 31); }
}

__device__ __forceinline__ float dpp_r4(float x) { return __builtin_bit_cast(float, __builtin_amdgcn_update_dpp(0, __builtin_bit_cast(int, x), 0x124, 0xF, 0xF, true)); }
__device__ __forceinline__ float dpp_r8(float x) { return __builtin_bit_cast(float, __builtin_amdgcn_update_dpp(0, __builtin_bit_cast(int, x), 0x128, 0xF, 0xF, true)); }
__device__ __forceinline__ int dpp_r4i(int x) { return __builtin_amdgcn_update_dpp(0, x, 0x124, 0xF, 0xF, true); }
__device__ __forceinline__ int dpp_r8i(int x) { return __builtin_amdgcn_update_dpp(0, x, 0x128, 0xF, 0xF, true); }
__device__ __forceinline__ void select_blocks8(const LAS float* impw, LAS unsigned* mk, int lane, int cur, unsigned (&u)[2][4]) {
    const int i = lane & 15, k = lane >> 4;
    unsigned m4[2][4];
    if (cur < 16) {
#pragma unroll
        for (int c = 0; c < 2; ++c) { m4[c][0] = (2u << cur) - 1u; m4[c][1] = 0u; m4[c][2] = 0u; m4[c][3] = 0u; }
    } else {
        float cand[2][8]; unsigned chosen[2] = {0u, 0u};
#pragma unroll
        for (int c = 0; c < 2; ++c)
#pragma unroll
            for (int m = 0; m < 8; ++m) { const int j = i + 16 * m; const LAS float* p = impw + (4 * c + k) * 264; const float va = p[j], vb2 = p[132 + j];
                cand[c][m] = ((j >= 1) & (j <= cur - 2)) ? va + vb2 : -1.0f; }
        for (int it = 0; it < 13; ++it) {
#pragma unroll
            for (int c = 0; c < 2; ++c) {
                float bv = -2.0f; int bj = 1 << 20;
#pragma unroll
                for (int m = 0; m < 8; ++m) { const bool ok = !((chosen[c] >> m) & 1u) && cand[c][m] > bv; bv = ok ? cand[c][m] : bv; bj = ok ? i + 16 * m : bj; }
                best_pair(bv, bj, dpp_r8(bv), dpp_r8i(bj)); best_pair(bv, bj, dpp_r4(bv), dpp_r4i(bj)); best_pair(bv, bj, dpp_x2(bv), dpp_x2i(bj)); best_pair(bv, bj, dpp_x1(bv), dpp_x1i(bj));
                if ((bj & 15) == i) chosen[c] |= 1u << (bj >> 4);
            }
        }
        const int c1 = cur - 1;
        const unsigned long long flo = 1ull | (c1 < 64 ? 1ull << c1 : 0ull) | (cur < 64 ? 1ull << cur : 0ull), fhi = (c1 >= 64 ? 1ull << (c1 - 64) : 0ull) | (cur >= 64 ? 1ull << (cur - 64) : 0ull);
#pragma unroll
        for (int c = 0; c < 2; ++c) {
#pragma unroll
            for (int x = 0; x < 4; ++x) m4[c][x] = 0u;
#pragma unroll
            for (int m = 0; m < 8; ++m) m4[c][m >> 1] |= ((chosen[c] >> m) & 1u) << (i + 16 * (m & 1));
#pragma unroll
            for (int x = 0; x < 4; ++x) { unsigned v = m4[c][x]; v |= (unsigned)dpp_r8i((int)v); v |= (unsigned)dpp_r4i((int)v); v |= (unsigned)dpp_x2i((int)v); v |= (unsigned)dpp_x1i((int)v); m4[c][x] = v; }
            m4[c][0] |= (unsigned)flo; m4[c][1] |= (unsigned)(flo >> 32); m4[c][2] |= (unsigned)fhi; m4[c][3] |= (unsigned)(fhi >> 32);
        }
    }
#pragma unroll
    for (int c = 0; c < 2; ++c) {
        if (i == 0) *(LAS u32x4*)(mk + (4 * c + k) * 4) = (u32x4){m4[c][0], m4[c][1], m4[c][2], m4[c][3]};
#pragma unroll
        for (int x = 0; x < 4; ++x) { unsigned v = m4[c][x]; v = or_x16(v); v = or_x32(v); u[c][x] = __builtin_amdgcn_readfirstlane(v); }
    }
}

template <int MODE, bool SELMASK>
__device__ __forceinline__ void attn_block(const LAS unsigned char* kb, const LAS unsigned char* vb, const bf16x8 (&qf)[2][2], int col, int q, const int (&tq)[2], int key0, const LAS float* nbq, float bias_far,
                                           bool sel0, bool sel1, Softmax (&st)[2], f32x4 (&O)[2][4]) {
    const f32x4 z4 = (f32x4){0.f, 0.f, 0.f, 0.f};
    const float NEG = -__builtin_inff();
    f32x4 S[2][4];
#pragma unroll
    for (int kt = 0; kt < 4; ++kt) { const bf16x8 k0 = lds_frag(kb, 16 * kt + col, q), k1 = lds_frag(kb, 16 * kt + col, 4 + q);
#pragma unroll
        for (int c = 0; c < 2; ++c) { S[c][kt] = __builtin_amdgcn_mfma_f32_16x16x32_bf16(k0, qf[c][0], z4, 0, 0, 0); S[c][kt] = __builtin_amdgcn_mfma_f32_16x16x32_bf16(k1, qf[c][1], S[c][kt], 0, 0, 0); } }
    float rowb[2] = {bias_far, bias_far}, cm[2];
#pragma unroll
    for (int c = 0; c < 2; ++c) {
        const bool sel = c == 0 ? sel0 : sel1;
        if (MODE == 0) { if (SELMASK) rowb[c] = sel ? bias_far : NEG; }
        else if (MODE == 1) { rowb[c] = (SELMASK && !sel) ? NEG : 0.f;
            const LAS float* bp = nbq - (tq[c] - key0);
#pragma unroll
            for (int kt = 0; kt < 4; ++kt) S[c][kt] = S[c][kt] + *(const LAS f32x4*)(bp + 16 * kt); }
        else {
#pragma unroll
            for (int kt = 0; kt < 4; ++kt)
#pragma unroll
                for (int e = 0; e < 4; ++e) { const int d = tq[c] - (key0 + 16 * kt + 4 * q + e); S[c][kt][e] = d < 512 ? S[c][kt][e] : NEG; } }
        cm[c] = max16(S[c]) + rowb[c];
    }
    if (__any(cm[0] > st[0].m || cm[1] > st[1].m)) {
#pragma unroll
        for (int c = 0; c < 2; ++c) { float x = fmax_x16(cm[c]); x = fmax_x32(x);
            const float mn = fmaxf(st[c].m, x), alpha = ex2(st[c].m - mn);
            st[c].m = mn; st[c].l = st[c].l * alpha;
#pragma unroll
            for (int dt = 0; dt < 4; ++dt) O[c][dt] = O[c][dt] * alpha; }
    }
    bf16x8 pf[2][2];
#pragma unroll
    for (int c = 0; c < 2; ++c) {
        const float off = rowb[c] - st[c].m;
#pragma unroll
        for (int kt = 0; kt < 4; ++kt) { f32x4 p = S[c][kt] + off;
#pragma unroll
            for (int e = 0; e < 4; ++e) p[e] = ex2(p[e]);
            S[c][kt] = p; }
        pf[c][0] = pack8(S[c][0], S[c][1]); pf[c][1] = pack8(S[c][2], S[c][3]);
        st[c].l = __builtin_amdgcn_mfma_f32_16x16x32_bf16(ONES8, pf[c][0], st[c].l, 0, 0, 0); st[c].l = __builtin_amdgcn_mfma_f32_16x16x32_bf16(ONES8, pf[c][1], st[c].l, 0, 0, 0);
    }
#pragma unroll
    for (int c32 = 0; c32 < 2; ++c32)
#pragma unroll
        for (int dt = 0; dt < 4; ++dt) { const bf16x8 vf = lds_frag(vb, 16 * dt + col, 4 * c32 + q);
            O[0][dt] = __builtin_amdgcn_mfma_f32_16x16x32_bf16(vf, pf[0][c32], O[0][dt], 0, 0, 0);
            O[1][dt] = __builtin_amdgcn_mfma_f32_16x16x32_bf16(vf, pf[1][c32], O[1][dt], 0, 0, 0); }
}

template <int C>
__device__ __forceinline__ void attn_block_far1(const LAS unsigned char* kb, const LAS unsigned char* vb, const bf16x8 (&qf)[2][2], int col, int q, float bias_far, bool sel, Softmax (&st)[2], f32x4 (&O)[2][4]) {
    const f32x4 z4 = (f32x4){0.f, 0.f, 0.f, 0.f};
    const float NEG = -__builtin_inff();
    f32x4 S[4];
#pragma unroll
    for (int kt = 0; kt < 4; ++kt) { const bf16x8 k0 = lds_frag(kb, 16 * kt + col, q), k1 = lds_frag(kb, 16 * kt + col, 4 + q);
        S[kt] = __builtin_amdgcn_mfma_f32_16x16x32_bf16(k0, qf[C][0], z4, 0, 0, 0); S[kt] = __builtin_amdgcn_mfma_f32_16x16x32_bf16(k1, qf[C][1], S[kt], 0, 0, 0); }
    const float rowb = sel ? bias_far : NEG;
    float cm = max16(S) + rowb;
    if (__any(cm > st[C].m)) { float x = fmax_x16(cm); x = fmax_x32(x);
        const float mn = fmaxf(st[C].m, x), alpha = ex2(st[C].m - mn);
        st[C].m = mn; st[C].l = st[C].l * alpha;
#pragma unroll
        for (int dt = 0; dt < 4; ++dt) O[C][dt] = O[C][dt] * alpha; }
    const float off = rowb - st[C].m;
#pragma unroll
    for (int kt = 0; kt < 4; ++kt) { f32x4 p = S[kt] + off;
#pragma unroll
        for (int e = 0; e < 4; ++e) p[e] = ex2(p[e]);
        S[kt] = p; }
    const bf16x8 pf0 = pack8(S[0], S[1]), pf1 = pack8(S[2], S[3]);
    st[C].l = __builtin_amdgcn_mfma_f32_16x16x32_bf16(ONES8, pf0, st[C].l, 0, 0, 0); st[C].l = __builtin_amdgcn_mfma_f32_16x16x32_bf16(ONES8, pf1, st[C].l, 0, 0, 0);
#pragma unroll
    for (int dt = 0; dt < 4; ++dt) { const bf16x8 vf0 = lds_frag(vb, 16 * dt + col, q), vf1 = lds_frag(vb, 16 * dt + col, 4 + q);
        O[C][dt] = __builtin_amdgcn_mfma_f32_16x16x32_bf16(vf0, pf0, O[C][dt], 0, 0, 0); O[C][dt] = __builtin_amdgcn_mfma_f32_16x16x32_bf16(vf1, pf1, O[C][dt], 0, 0, 0); }
}

template <bool SELMASK>
__device__ __forceinline__ void attn_far_fast(const LAS unsigned char* kb, const LAS unsigned char* vb, const bf16x8 (&qf)[2][2], int col, int q, float bias_far, bool sel0, bool sel1, Softmax (&st)[2], f32x4 (&O)[2][4]) {
    const f32x4 z4 = (f32x4){0.f, 0.f, 0.f, 0.f};
    const float NEG = -__builtin_inff();
    f32x4 S[2][4];
#pragma unroll
    for (int kt = 0; kt < 4; ++kt) { const bf16x8 k0 = lds_frag(kb, 16 * kt + col, q), k1 = lds_frag(kb, 16 * kt + col, 4 + q);
#pragma unroll
        for (int c = 0; c < 2; ++c) { S[c][kt] = __builtin_amdgcn_mfma_f32_16x16x32_bf16(k0, qf[c][0], z4, 0, 0, 0); S[c][kt] = __builtin_amdgcn_mfma_f32_16x16x32_bf16(k1, qf[c][1], S[c][kt], 0, 0, 0); } }
    bf16x8 pf[2][2];
#pragma unroll
    for (int c = 0; c < 2; ++c) {
        const bool sel = c == 0 ? sel0 : sel1;
        const float off = ((SELMASK && !sel) ? NEG : bias_far) - st[c].m;
#pragma unroll
        for (int kt = 0; kt < 4; ++kt) { f32x4 p = S[c][kt] + off;
#pragma unroll
            for (int e = 0; e < 4; ++e) p[e] = ex2(p[e]);
            S[c][kt] = p; }
        pf[c][0] = pack8(S[c][0], S[c][1]); pf[c][1] = pack8(S[c][2], S[c][3]);
        st[c].l = __builtin_amdgcn_mfma_f32_16x16x32_bf16(ONES8, pf[c][0], st[c].l, 0, 0, 0); st[c].l = __builtin_amdgcn_mfma_f32_16x16x32_bf16(ONES8, pf[c][1], st[c].l, 0, 0, 0);
    }
#pragma unroll
    for (int c32 = 0; c32 < 2; ++c32)
#pragma unroll
        for (int dt = 0; dt < 4; ++dt) { const bf16x8 vf = lds_frag(vb, 16 * dt + col, 4 * c32 + q);
            O[0][dt] = __builtin_amdgcn_mfma_f32_16x16x32_bf16(vf, pf[0][c32], O[0][dt], 0, 0, 0);
            O[1][dt] = __builtin_amdgcn_mfma_f32_16x16x32_bf16(vf, pf[1][c32], O[1][dt], 0, 0, 0); }
}
template <int C>
__device__ __forceinline__ void attn_far1_fast(const LAS unsigned char* kb, const LAS unsigned char* vb, const bf16x8 (&qf)[2][2], int col, int q, float bias_far, bool sel, Softmax (&st)[2], f32x4 (&O)[2][4]) {
    const f32x4 z4 = (f32x4){0.f, 0.f, 0.f, 0.f};
    const float NEG = -__builtin_inff();
    f32x4 S[4];
#pragma unroll
    for (int kt = 0; kt < 4; ++kt) { const bf16x8 k0 = lds_frag(kb, 16 * kt + col, q), k1 = lds_frag(kb, 16 * kt + col, 4 + q);
        S[kt] = __builtin_amdgcn_mfma_f32_16x16x32_bf16(k0, qf[C][0], z4, 0, 0, 0); S[kt] = __builtin_amdgcn_mfma_f32_16x16x32_bf16(k1, qf[C][1], S[kt], 0, 0, 0); }
    const float off = (sel ? bias_far : NEG) - st[C].m;
#pragma unroll
    for (int kt = 0; kt < 4; ++kt) { f32x4 p = S[kt] + off;
#pragma unroll
        for (int e = 0; e < 4; ++e) p[e] = ex2(p[e]);
        S[kt] = p; }
    const bf16x8 pf0 = pack8(S[0], S[1]), pf1 = pack8(S[2], S[3]);
    st[C].l = __builtin_amdgcn_mfma_f32_16x16x32_bf16(ONES8, pf0, st[C].l, 0, 0, 0); st[C].l = __builtin_amdgcn_mfma_f32_16x16x32_bf16(ONES8, pf1, st[C].l, 0, 0, 0);
#pragma unroll
    for (int dt = 0; dt < 4; ++dt) { const bf16x8 vf0 = lds_frag(vb, 16 * dt + col, q), vf1 = lds_frag(vb, 16 * dt + col, 4 + q);
        O[C][dt] = __builtin_amdgcn_mfma_f32_16x16x32_bf16(vf0, pf0, O[C][dt], 0, 0, 0); O[C][dt] = __builtin_amdgcn_mfma_f32_16x16x32_bf16(vf1, pf1, O[C][dt], 0, 0, 0); }
}
__device__ __forceinline__ bool attn_overflowed(const Softmax (&st)[2], const f32x4 (&O)[2][4]) {
    float a = 0.f;
#pragma unroll
    for (int c = 0; c < 2; ++c) { a += fabsf(st[c].l[0]);
#pragma unroll
        for (int dt = 0; dt < 4; ++dt) a += (fabsf(O[c][dt][0]) + fabsf(O[c][dt][1])) + (fabsf(O[c][dt][2]) + fabsf(O[c][dt][3])); }
    return !(a < 1e37f);
}

__device__ __forceinline__ void nsa_unit(unsigned char* ws, LAS unsigned char* lds, const LAS float* lut, int b, int g, int tau, int tid_in) {
    int tid = tid_in; asm volatile("" : "+v"(tid));
    const int lane = tid & 63, wave = __builtin_amdgcn_readfirstlane(tid >> 6);
    const int col = lane & 15, q = lane >> 4, tl = col >> 2, r = col & 3, h = g * 4 + r, t0 = 64 * tau, cur = tau;
    const f32x4 z4 = (f32x4){0.f, 0.f, 0.f, 0.f};
    const float NEG = -__builtin_inff();
    int tq[2]; bf16x8 qf[2][2];
#pragma unroll
    for (int c = 0; c < 2; ++c) { tq[c] = t0 + 8 * wave + 4 * c + tl; const size_t qrow = (size_t)b * SEQ + tq[c];
        const bf16_t* Qp = (const bf16_t*)(ws + WS_Q) + qrow * 1024 + h * 64 + 8 * q; qf[c][0] = *(const bf16x8*)Qp; qf[c][1] = *(const bf16x8*)(Qp + 32); }
#define NSA_GATE(c, k) (((const float*)(ws + WS_GATES))[((size_t)b * SEQ + tq[c]) * 48 + h * 3 + (k)])
    const LAS float* lrow = lut + h * 132;
    const float bias_far = lrow[128];
    const int dl = (4 - tl) & 3;
    const LAS float* nbq = (const LAS float*)(lds + NB_OFF) + (r * 4 + dl) * 264 + 196 - dl + 4 * q;
    LAS f32x4* resw = (LAS f32x4*)(lds + NSA_RES + wave * 8192) + lane;
    f32x4 Oc[2][4];
#pragma unroll
    for (int c = 0; c < 2; ++c)
#pragma unroll
        for (int dt = 0; dt < 4; ++dt) Oc[c][dt] = z4;
    LAS float* impw = (LAS float*)(lds + NSA_IMP) + wave * 2112;
    volatile LAS unsigned* ovf = (volatile LAS unsigned*)(lds + MISC_OFF) + 20;
    if (tid == 0) { ovf[0] = 0u; ovf[1] = 0u; }
    Stage stg;
    const int nvmax = (t0 + 63 >= 31) ? ((t0 + 63 - 31) >> 4) + 1 : 0;
    const int ncb = (nvmax + 63) >> 6;
    int nv[2];
#pragma unroll
    for (int c = 0; c < 2; ++c) nv[c] = tq[c] >= 31 ? ((tq[c] - 31) >> 4) + 1 : 0;
    const unsigned char* kcg = ws + WS_KC + ((size_t)(b * 512) * 4 + g) * 128;
    const unsigned char* vcg = ws + WS_VCT + ((size_t)((b * 4 + g) * 64)) * NCMP_PAD * 2;
    float M[2] = {-1e30f, -1e30f}, L[2] = {0.f, 0.f};
    if (ncb > 0) {
        const int nfar = (t0 - 159 >= 0) ? (((t0 - 159) >> 4) + 1) >> 6 : 0;
        stage_load(stg, kcg, 512, nullptr, 0, tid, false); stage_store(stg, lds, 0, tid, false); __syncthreads();
        for (int i = 0; i < ncb; ++i) {
            if (i + 1 < ncb) stage_load(stg, kcg + (size_t)(i + 1) * 64 * 512, 512, nullptr, 0, tid, false);
            else stage_load(stg, kcg, 512, vcg, NCMP_PAD * 2, tid, true);
            const LAS unsigned char* kb = lds + NSA_KB + (i & 1) * 8192;
            f32x4 S[2][4];
#pragma unroll
            for (int kt = 0; kt < 4; ++kt) { const bf16x8 kf0 = lds_frag(kb, 16 * kt + col, q), kf1 = lds_frag(kb, 16 * kt + col, 4 + q);
#pragma unroll
                for (int c = 0; c < 2; ++c) { S[c][kt] = __builtin_amdgcn_mfma_f32_16x16x32_bf16(kf0, qf[c][0], z4, 0, 0, 0); S[c][kt] = __builtin_amdgcn_mfma_f32_16x16x32_bf16(kf1, qf[c][1], S[c][kt], 0, 0, 0); } }
#pragma unroll
            for (int c = 0; c < 2; ++c) {
                float rowb = bias_far;
                if (i >= nfar) { rowb = 0.f;
                    const int tqlo = t0 + 8 * wave + 4 * c, tqhi = tqlo + 3;
#pragma unroll
                    for (int kt = 0; kt < 4; ++kt) { const int nlo = 64 * i + 16 * kt;
                        if (16 * (nlo + 15) + 31 + 128 <= tqlo) S[c][kt] = S[c][kt] + bias_far;
                        else if (16 * nlo + 31 > tqhi) S[c][kt] = (f32x4){NEG, NEG, NEG, NEG};
                        else {
#pragma unroll
                            for (int e = 0; e < 4; ++e) { const int n = nlo + 4 * q + e; int dist = tq[c] - (16 * n + 31); dist = dist < 0 ? 0 : (dist > 128 ? 128 : dist);
                                const float bv = lrow[dist]; const float sv = S[c][kt][e] + bv; S[c][kt][e] = n < nv[c] ? sv : NEG; } } } }
                const float tm = max16(S[c]) + rowb;
                const float mn = fmaxf(M[c], tm); L[c] *= ex2(M[c] - mn); M[c] = mn;
                const float off = rowb - mn; float sum = 0.f;
#pragma unroll
                for (int kt = 0; kt < 4; ++kt)
#pragma unroll
                    for (int e = 0; e < 4; ++e) sum += ex2(S[c][kt][e] + off);
                L[c] += sum;
            }
            if (i + 1 < ncb) stage_store(stg, lds, (i + 1) & 1, tid, false);
            __syncthreads();
        }
#pragma unroll
        for (int c = 0; c < 2; ++c) { float mo = fmax_x16(M[c]); mo = fmax_x32(mo); L[c] *= ex2(M[c] - mo); M[c] = mo; L[c] = fadd_x16(L[c]); L[c] = fadd_x32(L[c]); }
        float offN[2];
#pragma unroll
        for (int c = 0; c < 2; ++c) offN[c] = -M[c] - __builtin_amdgcn_logf(fmaxf(L[c], 1e-30f));
        f32x4 (&O)[2][4] = Oc;
        stage_store(stg, lds, 0, tid, true); __syncthreads();
        for (int i = 0; i < ncb; ++i) {
            if (i + 1 < ncb) stage_load(stg, kcg + (size_t)(i + 1) * 64 * 512, 512, vcg + (size_t)(i + 1) * 128, NCMP_PAD * 2, tid, true);
            const LAS unsigned char* kb = lds + NSA_KB + (i & 1) * 8192; const LAS unsigned char* vb = lds + NSA_VB + (i & 1) * 8192;
            f32x4 S[2][4];
#pragma unroll
            for (int kt = 0; kt < 4; ++kt) { const bf16x8 kf0 = lds_frag(kb, 16 * kt + col, q), kf1 = lds_frag(kb, 16 * kt + col, 4 + q);
#pragma unroll
                for (int c = 0; c < 2; ++c) { S[c][kt] = __builtin_amdgcn_mfma_f32_16x16x32_bf16(kf0, qf[c][0], z4, 0, 0, 0); S[c][kt] = __builtin_amdgcn_mfma_f32_16x16x32_bf16(kf1, qf[c][1], S[c][kt], 0, 0, 0); } }
#pragma unroll
            for (int c = 0; c < 2; ++c) {
                if (i >= nfar) {
                    const int tqlo = t0 + 8 * wave + 4 * c, tqhi = tqlo + 3; const float offF = bias_far + offN[c];
#pragma unroll
                    for (int kt = 0; kt < 4; ++kt) { const int nlo = 64 * i + 16 * kt;
                        if (16 * (nlo + 15) + 31 + 128 <= tqlo) {
#pragma unroll
                            for (int e = 0; e < 4; ++e) S[c][kt][e] = ex2(S[c][kt][e] + offF); }
                        else if (16 * nlo + 31 > tqhi) S[c][kt] = (f32x4){0.f, 0.f, 0.f, 0.f};
                        else {
#pragma unroll
                            for (int e = 0; e < 4; ++e) { const int n = nlo + 4 * q + e; int dist = tq[c] - (16 * n + 31); dist = dist < 0 ? 0 : (dist > 128 ? 128 : dist);
                                const float bv = lrow[dist]; const float pv = ex2(S[c][kt][e] + bv + offN[c]); S[c][kt][e] = n < nv[c] ? pv : 0.f; } } }
                } else { const float off = bias_far + offN[c];
#pragma unroll
                    for (int kt = 0; kt < 4; ++kt)
#pragma unroll
                        for (int e = 0; e < 4; ++e) S[c][kt][e] = ex2(S[c][kt][e] + off); }
#pragma unroll
                for (int kt = 0; kt < 4; ++kt) { float sA = (S[c][kt][0] + S[c][kt][1]) + (S[c][kt][2] + S[c][kt][3]), c3 = S[c][kt][3];
                    sA += dpp_x1(sA); sA += dpp_x2(sA); c3 += dpp_x1(c3); c3 += dpp_x2(c3);
                    if (r == 0) { const int jb = 4 * (4 * i + kt) + q; impw[(4 * c + tl) * 264 + jb] = sA; impw[(4 * c + tl) * 264 + 132 + jb + 1] = c3; } }
            }
            const bf16x8 pf00 = pack8(S[0][0], S[0][1]), pf01 = pack8(S[0][2], S[0][3]), pf10 = pack8(S[1][0], S[1][1]), pf11 = pack8(S[1][2], S[1][3]);
#pragma unroll
            for (int dt = 0; dt < 4; ++dt) { const bf16x8 vf0 = lds_frag(vb, 16 * dt + col, q), vf1 = lds_frag(vb, 16 * dt + col, 4 + q);
                O[0][dt] = __builtin_amdgcn_mfma_f32_16x16x32_bf16(vf0, pf00, O[0][dt], 0, 0, 0); O[1][dt] = __builtin_amdgcn_mfma_f32_16x16x32_bf16(vf0, pf10, O[1][dt], 0, 0, 0);
                O[0][dt] = __builtin_amdgcn_mfma_f32_16x16x32_bf16(vf1, pf01, O[0][dt], 0, 0, 0); O[1][dt] = __builtin_amdgcn_mfma_f32_16x16x32_bf16(vf1, pf11, O[1][dt], 0, 0, 0); }
            if (i + 1 < ncb) stage_store(stg, lds, (i + 1) & 1, tid, true);
            __syncthreads();
        }
    }
    unsigned u[2][4];
    Stage stg2;
    const unsigned char* kg_s = ws + WS_KS + ((size_t)b * SEQ * 256 + g * 64) * 2;
    const unsigned char* vg_s = ws + WS_VST + ((size_t)((b * 4 + g) * 64)) * SEQ * 2;
    stage_load(stg, kg_s, 512, vg_s, SEQ * 2, tid, true);
    if (1 <= cur) stage_load(stg2, kg_s + (size_t)64 * 512, 512, vg_s + 128, SEQ * 2, tid, true);
    asm volatile("s_waitcnt lgkmcnt(0)" ::: "memory");
    LAS unsigned* selw = (LAS unsigned*)(lds + TILES_OFF) + wave * 32;
    select_blocks8(impw, selw, lane, cur, u);
    __syncthreads();
#pragma unroll
    for (int c = 0; c < 2; ++c) { const float gc = NSA_GATE(c, 0);
#pragma unroll
        for (int dt = 0; dt < 4; ++dt) resw[(c * 4 + dt) * 64] = Oc[c][dt] * gc; }
    {
        f32x4 O[2][4]; Softmax st[2];
#pragma unroll
        for (int c = 0; c < 2; ++c) { st[c].m = -1e30f; st[c].l = z4;
#pragma unroll
            for (int dt = 0; dt < 4; ++dt) O[c][dt] = z4; }
        const unsigned char* kg = kg_s; const unsigned char* vg = vg_s;
        const unsigned char* kgw = ws + WS_KW + ((size_t)b * SEQ * 256 + g * 64) * 2;
        const unsigned char* vgw = ws + WS_VWT + ((size_t)((b * 4 + g) * 64)) * SEQ * 2;
        const int jlo_w = cur >= 8 ? cur - 8 : 0;
#define SLC_LOAD(ST, J) stage_load(ST, kg + (size_t)(J) * 64 * 512, 512, vg + (size_t)(J) * 128, SEQ * 2, tid, true)
#define SLC_STEP(SAFE, J, BUF) do { const int j_ = (J); \
            const unsigned uw0 = (j_ >> 5) == 0 ? u[0][0] : (j_ >> 5) == 1 ? u[0][1] : (j_ >> 5) == 2 ? u[0][2] : u[0][3]; \
            const unsigned uw1 = (j_ >> 5) == 0 ? u[1][0] : (j_ >> 5) == 1 ? u[1][1] : (j_ >> 5) == 2 ? u[1][2] : u[1][3]; \
            if (((uw0 | uw1) >> (j_ & 31)) & 1u) { \
                const bool sel0 = (cw0 >> (j_ & 31)) & 1u, sel1 = (cw1 >> (j_ & 31)) & 1u; \
                const LAS unsigned char* kb = lds + NSA_KB + (BUF) * 8192; const LAS unsigned char* vb = lds + NSA_VB + (BUF) * 8192; \
                if (j_ + 3 > cur) attn_block<1, true>(kb, vb, qf, col, q, tq, 64 * j_, nbq, bias_far, sel0, sel1, st, O); \
                else { const bool d0_ = (uw0 >> (j_ & 31)) & 1u, d1_ = (uw1 >> (j_ & 31)) & 1u; \
                    if (SAFE) { \
                        if (d0_ && d1_) attn_block<0, true>(kb, vb, qf, col, q, tq, 64 * j_, nbq, bias_far, sel0, sel1, st, O); \
                        else if (d0_) attn_block_far1<0>(kb, vb, qf, col, q, bias_far, sel0, st, O); \
                        else attn_block_far1<1>(kb, vb, qf, col, q, bias_far, sel1, st, O); \
                    } else if (j_ == 0) attn_block<0, true>(kb, vb, qf, col, q, tq, 0, nbq, bias_far, sel0, sel1, st, O); \
                    else if (d0_ && d1_) attn_far_fast<true>(kb, vb, qf, col, q, bias_far, sel0, sel1, st, O); \
                    else if (d0_) attn_far1_fast<0>(kb, vb, qf, col, q, bias_far, sel0, st, O); \
                    else attn_far1_fast<1>(kb, vb, qf, col, q, bias_far, sel1, st, O); } } } while (0)
#define SLC_LOOP(SAFE) do { \
        if (SAFE) { SLC_LOAD(stg, 0); if (1 <= cur) SLC_LOAD(stg2, 1); } \
        stage_store(stg, lds, 0, tid, true); if (1 <= cur) stage_store(stg2, lds, 1, tid, true); __syncthreads(); \
        unsigned cw0 = 0u, cw1 = 0u; \
        for (int j = 0; j <= cur; j += 2) { \
            if ((j & 31) == 0) { cw0 = selw[tl * 4 + (j >> 5)]; cw1 = selw[16 + tl * 4 + (j >> 5)]; } \
            if (j + 2 <= cur) SLC_LOAD(stg, j + 2); \
            else stage_load(stg, kgw + (size_t)jlo_w * 64 * 512, 512, vgw + (size_t)jlo_w * 128, SEQ * 2, tid, true);     \
            if (j + 3 <= cur) SLC_LOAD(stg2, j + 3); \
            SLC_STEP(SAFE, j, j & 3); \
            if (j + 1 <= cur) SLC_STEP(SAFE, j + 1, (j + 1) & 3); \
            if (j + 2 <= cur) stage_store(stg, lds, (j + 2) & 3, tid, true); \
            if (j + 3 <= cur) stage_store(stg2, lds, (j + 3) & 3, tid, true); \
            __syncthreads(); \
        } } while (0)
        SLC_LOOP(false);
        if (__any(attn_overflowed(st, O))) ovf[0] = 1u;
        __syncthreads();
        if (ovf[0] != 0u) {
#pragma unroll
            for (int c = 0; c < 2; ++c) { st[c].m = -1e30f; st[c].l = z4;
#pragma unroll
                for (int dt = 0; dt < 4; ++dt) O[c][dt] = z4; }
            SLC_LOOP(true);
        }
#undef SLC_LOOP
#undef SLC_LOAD
#undef SLC_STEP
#pragma unroll
        for (int c = 0; c < 2; ++c) { const float sc = NSA_GATE(c, 1) / fmaxf(st[c].l[0], 1e-30f);
#pragma unroll
            for (int dt = 0; dt < 4; ++dt) resw[(c * 4 + dt) * 64] = resw[(c * 4 + dt) * 64] + O[c][dt] * sc; }
    }
    {
        f32x4 O[2][4]; Softmax st[2];
#pragma unroll
        for (int c = 0; c < 2; ++c) { st[c].m = -1e30f; st[c].l = z4;
#pragma unroll
            for (int dt = 0; dt < 4; ++dt) O[c][dt] = z4; }
        const unsigned char* kg = ws + WS_KW + ((size_t)b * SEQ * 256 + g * 64) * 2;
        const unsigned char* vg = ws + WS_VWT + ((size_t)((b * 4 + g) * 64)) * SEQ * 2;
        const int jlo = cur >= 8 ? cur - 8 : 0;
#define WIN_LOOP(SAFE) do { \
        if (SAFE) stage_load(stg, kg + (size_t)jlo * 64 * 512, 512, vg + (size_t)jlo * 128, SEQ * 2, tid, true); \
        stage_store(stg, lds, 0, tid, true); __syncthreads(); \
        for (int j = jlo; j <= cur; ++j) { \
            const int bi = (j - jlo) & 1; \
            if (j + 1 <= cur) stage_load(stg, kg + (size_t)(j + 1) * 64 * 512, 512, vg + (size_t)(j + 1) * 128, SEQ * 2, tid, true); \
            const LAS unsigned char* kb = lds + NSA_KB + bi * 8192; const LAS unsigned char* vb = lds + NSA_VB + bi * 8192; \
            if (j + 3 > cur) attn_block<1, false>(kb, vb, qf, col, q, tq, 64 * j, nbq, bias_far, true, true, st, O); \
            else if (j + 8 == cur) attn_block<2, false>(kb, vb, qf, col, q, tq, 64 * j, nbq, bias_far, true, true, st, O); \
            else if ((SAFE) || j < jlo + 2) attn_block<0, false>(kb, vb, qf, col, q, tq, 64 * j, nbq, bias_far, true, true, st, O); \
            else attn_far_fast<false>(kb, vb, qf, col, q, bias_far, true, true, st, O); \
            if (j + 1 <= cur) stage_store(stg, lds, bi ^ 1, tid, true); \
            __syncthreads(); \
        } } while (0)
        WIN_LOOP(false);
        if (__any(attn_overflowed(st, O))) ovf[1] = 1u;
        __syncthreads();
        if (ovf[1] != 0u) {
#pragma unroll
            for (int c = 0; c < 2; ++c) { st[c].m = -1e30f; st[c].l = z4;
#pragma unroll
                for (int dt = 0; dt < 4; ++dt) O[c][dt] = z4; }
            WIN_LOOP(true);
        }
#undef WIN_LOOP
#pragma unroll
        for (int c = 0; c < 2; ++c) { const float sc = NSA_GATE(c, 2) / fmaxf(st[c].l[0], 1e-30f);
            bf16_t* yo = (bf16_t*)(ws + WS_YNSA) + ((size_t)b * SEQ + tq[c]) * 1024 + h * 64 + 4 * q;
#pragma unroll
            for (int dt = 0; dt < 4; ++dt) { const f32x4 rv = resw[(c * 4 + dt) * 64] + O[c][dt] * sc; u32x2 o; o.x = pk2(rv[0], rv[1]); o.y = pk2(rv[2], rv[3]); *(u32x2*)(yo + 16 * dt) = o; } }
    }
}

__device__ __forceinline__ float dpp_ror4(float x) { return __builtin_bit_cast(float, __builtin_amdgcn_update_dpp(0, __builtin_bit_cast(int, x), 0x124, 0xF, 0xF, true)); }
__device__ __forceinline__ float dpp_ror8(float x) { return __builtin_bit_cast(float, __builtin_amdgcn_update_dpp(0, __builtin_bit_cast(int, x), 0x128, 0xF, 0xF, true)); }
__device__ __forceinline__ int dpp_ror4i(int x) { return __builtin_amdgcn_update_dpp(0, x, 0x124, 0xF, 0xF, true); }
__device__ __forceinline__ int dpp_ror8i(int x) { return __builtin_amdgcn_update_dpp(0, x, 0x128, 0xF, 0xF, true); }
__device__ __forceinline__ void route_token(const In& in, unsigned char* ws, LAS unsigned* hist, LAS unsigned* eloc, LAS unsigned* sloc, int tok, int tloc, int lane) {
    const f32x4 lg = *((const f32x4*)((const float*)(ws + WS_LOGIT) + (size_t)tok * 256) + lane);
    const f32x4 rb = *((const f32x4*)in.router_bias + lane);
    float s[4], v[4];
#pragma unroll
    for (int i = 0; i < 4; ++i) { s[i] = sigmoidf_(lg[i]); v[i] = s[i] + rb[i]; }
    unsigned taken = 0u; float my_s = 0.f; int my_e = 0;
    for (int k = 0; k < TOPK; ++k) {
        float bv = -__builtin_inff(); int bi = 1 << 20;
#pragma unroll
        for (int i = 0; i < 4; ++i) { const bool ok = !((taken >> i) & 1u) && v[i] > bv; bv = ok ? v[i] : bv; bi = ok ? 4 * lane + i : bi; }
        best_pair(bv, bi, dpp_ror8(bv), dpp_ror8i(bi)); best_pair(bv, bi, dpp_ror4(bv), dpp_ror4i(bi)); best_pair(bv, bi, dpp_x2(bv), dpp_x2i(bi)); best_pair(bv, bi, dpp_x1(bv), dpp_x1i(bi));
        { const float ov = __shfl_xor(bv, 16); const int oi = __shfl_xor(bi, 16); best_pair(bv, bi, ov, oi); }
        { const float ov = __shfl_xor(bv, 32); const int oi = __shfl_xor(bi, 32); best_pair(bv, bi, ov, oi); }
        const bool mine = (bi >> 2) == lane;
        if (mine) taken |= 1u << (bi & 3);
        const float sw = (bi & 3) == 0 ? s[0] : (bi & 3) == 1 ? s[1] : (bi & 3) == 2 ? s[2] : s[3];
        const float bs = __shfl(sw, bi >> 2);
        if (lane == k) { my_s = bs; my_e = bi; }
    }
    float sum = lane < TOPK ? my_s : 0.f;
    sum += dpp_x1(sum); sum += dpp_x2(sum); sum += dpp_ror4(sum); sum += dpp_ror8(sum);
    if (lane < TOPK) {
        const unsigned slot = __hip_atomic_fetch_add(hist + my_e, 1u, __ATOMIC_RELAXED, __HIP_MEMORY_SCOPE_WORKGROUP);
        eloc[tloc * 8 + lane] = (unsigned)my_e; sloc[tloc * 8 + lane] = slot;
        ((int*)(ws + WS_ASGE))[tok * 8 + lane] = my_e; ((float*)(ws + WS_ASGW))[tok * 8 + lane] = my_s / sum * 2.5f;
    }
}

#ifndef DBG_MODE
#define DBG_MODE 0
#endif
struct Args { In in; float* out; unsigned char* ws; int ph_lo, ph_hi; };
static_assert(sizeof(Args) == 31 * 8 + 8 + 8 + 8, "Args has no padding");

#define CAS __attribute__((address_space(4)))
struct PhaseArgs { In in; float* out; unsigned char* ws; };
__device__ __forceinline__ PhaseArgs load_args() {
    const CAS unsigned char* kp = (const CAS unsigned char*)__builtin_amdgcn_kernarg_segment_ptr(); asm volatile("" : "+s"(kp));
    const float* const CAS* pp = (const float* const CAS*)kp; PhaseArgs r; const float** rp = (const float**)&r.in;
#pragma unroll
    for (int i = 0; i < 31; ++i) rp[i] = pp[i];
    r.out = (float*)pp[31]; r.ws = (unsigned char*)pp[32]; return r;
}
#define PHASE_ARGS() const PhaseArgs pa_ = load_args(); const In& in = pa_.in; float* const out = pa_.out; unsigned char* const ws = pa_.ws; (void)in; (void)out; (void)ws
__global__ void __launch_bounds__(NTHREADS, 2) fwd_kernel(Args args) {
    extern __shared__ __attribute__((aligned(16))) unsigned char lds_raw[];
    LAS unsigned char* lds = (LAS unsigned char*)lds_raw;
    volatile LAS unsigned* MISC = (volatile LAS unsigned*)(lds + MISC_OFF);
    const int tid = threadIdx.x, lane = tid & 63, wave = __builtin_amdgcn_readfirstlane(tid >> 6);
    const int G = gridDim.x, gw = (int)blockIdx.x * NWAVES + wave, NGW = G * NWAVES;
    unsigned* ctl = (unsigned*)(args.ws + WS_CTL);
    for (int u = tid; u < 256; u += NTHREADS) ((LAS unsigned*)(lds + MISC_OFF))[u] = 0u;
    __syncthreads();
    XcdBarrier bar = xcd_barrier_post(ctl + CW_BAR, MISC + 8);
    const int lo = args.ph_lo, hi = args.ph_hi;
#define IN(k) (lo <= (k) && (k) < hi)
#define SEAM(k) do { if (IN(k) && IN((k) + 1)) xcd_barrier(bar); } while (0)
    LAS float* lut = (LAS float*)(lds + LUT_OFF);
    LAS int* tstart = (LAS int*)(lds + TILES_OFF);

    if (IN(0)) {
        PHASE_ARGS();
        p0_mod(in, ws, lds, tid);
        p0_tables(in, ws, lds, tid);
        if (blockIdx.x >= 64) p0_small_weights(in, ws, (LAS float*)(lds + wave * 8448), gw - 64 * NWAVES, NGW - 64 * NWAVES, lane);
    }
    SEAM(0);
    if (IN(1)) { PHASE_ARGS();
        if (blockIdx.x == 0) {
            const float* part = (const float*)(ws + WS_CTL + 131072);
            const int ts = tid >> 8, c = tid & 255; float sb = 0.f;
            for (int pz = 0; pz < 16; ++pz) sb += part[(ts * 16 + pz) * 256 + c];
            ((float*)(ws + WS_CTL + 65536))[ts * 256 + c] = sb; }
        ph_h1(in, ws, gw, NGW, lane); }
    SEAM(1);
    if (IN(2)) {
        PHASE_ARGS();
        SchedDense S = make_dense((const char*)ws, WS_H1, 2048, (const char*)(ws + WS_WIN), MTOK, NPROJ, 1024);
        EpiProj E{ws};
        pg8::gemm_phase<EpiProj, SchedDense>(lds, S, E);
    }
    SEAM(2);
    if (IN(3)) {
        PHASE_ARGS();
        { SchedCmp1 S; S.abase = (const char*)ws; S.a_kstep = 512; S.K = 2048; S.Bt = (const char*)(ws + WS_CW1); S.ord.init(64, 2, G, (int)blockIdx.x);
          EpiCmp1 E{ws}; pg8::gemm_phase<EpiCmp1, SchedCmp1>(lds, S, E); }
        __syncthreads();
        s5_task<false>(in, ws, lds + wave * S5_LDS_PER_WAVE, gw >> 8, (gw >> 3) & 31, gw & 7, lane);
    }
    SEAM(3);
    if (IN(4)) {
        PHASE_ARGS();
        { SchedCmp2 S; S.abase = (const char*)ws; S.a_kstep = 128; S.K = 256; S.Bt = (const char*)(ws + WS_CW2); S.ord.init(64, 2, G, (int)blockIdx.x);
          EpiCmp2 E{ws}; pg8::gemm_phase<EpiCmp2, SchedCmp2>(lds, S, E); }
        __syncthreads();
        s5_task<true>(in, ws, lds + wave * S5_LDS_PER_WAVE, gw >> 8, (gw >> 3) & 31, gw & 7, lane);
    }
    SEAM(4);
    if (IN(5)) {
        PHASE_ARGS();
        for (int i = tid; i < 16 * 132; i += NTHREADS) lut[i] = ((const float*)(ws + WS_TAB + TAB_LUT))[i];
        __syncthreads();
        if ((tid >> 6) >= 4) __builtin_amdgcn_s_setprio(2);
        for (int i = 0; i < 16; ++i) { const int bg = 8 * (i >> 2) + ((int)blockIdx.x & 7), wi = (int)blockIdx.x >> 3, k = i & 3;
            const int tau = k == 0 ? wi : k == 1 ? 63 - wi : k == 2 ? 64 + wi : 127 - wi;
            if (k == 0) {
                __syncthreads();
                LAS float* nbt = (LAS float*)(lds + NB_OFF);
                for (int x = tid; x < 16 * 264; x += NTHREADS) { const int rr = x / 1056, sh = (x / 264) & 3, z = x % 264, d = 196 - z - sh;
                    nbt[x] = d < 0 ? -__builtin_inff() : lut[((bg & 3) * 4 + rr) * 132 + (d > 128 ? 128 : d)]; }
                __syncthreads();
            }
            nsa_unit(ws, lds, lut, bg >> 2, bg & 3, tau, tid); }
        __builtin_amdgcn_s_setprio(0);
    }
    SEAM(5);
    if (IN(6)) {
        PHASE_ARGS();
        SchedDense S = make_dense((const char*)ws, WS_Z, 1024, (const char*)(ws + WS_GLU), MTOK, 2048, 512);
        EpiGlu E{ws}; pg8::gemm_phase<EpiGlu, SchedDense>(lds, S, E);
    }
    SEAM(6);
    if (IN(7)) {
        PHASE_ARGS();
        SchedDense S = make_dense((const char*)ws, WS_MERGED, 2048, (const char*)(ws + WS_WOUT), MTOK, 1024, 1024);
        EpiWout E{in.x, out, (const float*)(ws + WS_MOD) + 2048};
        static_assert(WS_WD >= WS_KS && WS_WD + 128 * MiB <= WS_MG + 256 * MiB && WS_WGU + 63 * MiB <= WS_Q && WS_WGU + 191 * MiB >= WS_Q + 128 * MiB, "early conversion targets must not overlap MERGED (live in this phase)");
        if (blockIdx.x & 1) { convert_expert_weights(in, ws, (LAS float*)(lds + wave * 8448), gw, NGW, lane, 0); __syncthreads(); }
        pg8::gemm_phase<EpiWout, SchedDense>(lds, S, E);
        if (!(blockIdx.x & 1)) { __syncthreads(); convert_expert_weights(in, ws, (LAS float*)(lds + wave * 8448), gw, NGW, lane, 0); }
    }
    SEAM(7);
    if (IN(8)) {
        PHASE_ARGS();
        ph_ln1(in, ws, out, gw, NGW, lane);
        for (int i = gw * 64 + lane; i < 128; i += NGW * 64) ((u32x4*)((bf16_t*)(ws + WS_H2) + (size_t)MTOK * DM))[i] = (u32x4){0u, 0u, 0u, 0u};
        for (int i = gw * 64 + lane; i < NCHUNK * CHUNK_ROWS; i += NGW * 64) { ((int*)(ws + WS_ROWASG))[i] = -1; ((float*)(ws + WS_ROWW))[i] = 0.f; }
        convert_expert_weights(in, ws, (LAS float*)(lds + wave * 8448), gw, NGW, lane, 1);
    }
    SEAM(8);
    if (IN(9)) {
        PHASE_ARGS();
        { SchedDense S = make_dense((const char*)ws, WS_H2, 2048, (const char*)(ws + WS_ROUT), MTOK, 256, 1024);
          EpiF32 E{(float*)(ws + WS_LOGIT), 256}; pg8::gemm_phase<EpiF32, SchedDense>(lds, S, E); }
        { SchedDense S = make_dense((const char*)ws, WS_H2, 2048, (const char*)(ws + WS_SHGU), MTOK, 512, 1024);
          EpiSwiglu E{(bf16_t*)(ws + WS_HSH)}; pg8::gemm_phase<EpiSwiglu, SchedDense>(lds, S, E); }
    }
    SEAM(9);
    if (IN(10)) {
        PHASE_ARGS();
        {
            LAS unsigned* hist = (LAS unsigned*)lds; LAS unsigned* gbase = hist + 256; LAS unsigned* eloc = hist + 512; LAS unsigned* sloc = hist + 2560;
            const int tok0 = (int)blockIdx.x * 256;
            if (tid < 256) hist[tid] = 0u;
            __syncthreads();
            for (int k = 0; k < 32; ++k) route_token(in, ws, hist, eloc, sloc, tok0 + wave * 32 + k, wave * 32 + k, lane);
            __syncthreads();
            if (tid < 256) { const unsigned h = hist[tid]; gbase[tid] = h ? __hip_atomic_fetch_add(ctl + CW_CNT + chunk_of_tok(tok0) * 256 + tid, h, RLX_AGENT) : 0u; }
            __syncthreads();
            for (int i = tid; i < 2048; i += NTHREADS) ((int*)(ws + WS_ASGS))[tok0 * 8 + i] = (int)(sloc[i] + gbase[eloc[i]]);
            __syncthreads();
        }
        SchedDense S = make_dense((const char*)ws, WS_HSH, 512, (const char*)(ws + WS_SHD), MTOK, 1024, 256);
        EpiShDown E{(unsigned char*)(ws + WS_SHOUT)}; pg8::gemm_phase<EpiShDown, SchedDense>(lds, S, E);
    }
    SEAM(10);
    if (IN(11) || IN(12)) {
        for (int i = tid; i < NCHUNK * 256; i += NTHREADS) { const unsigned c = __hip_atomic_load(ctl + CW_CNT + i, RLX_AGENT); tstart[(i >> 8) * 260 + (i & 255) + 1] = (int)((c + 255u) >> 8); }
        if (tid < NCHUNK) tstart[tid * 260] = 0;
        __syncthreads();
        if (tid < NCHUNK) { int sacc = 0; for (int e = 1; e <= 256; ++e) { sacc += tstart[tid * 260 + e]; tstart[tid * 260 + e] = sacc; } }
        __syncthreads();
    }
    if (IN(11)) {
        PHASE_ARGS();
        for (int a = gw * 64 + lane; a < MTOK * TOPK; a += NGW * 64) { const int e = ((const int*)(ws + WS_ASGE))[a], ch = chunk_of_tok(a >> 3); const int pos = ch * CHUNK_ROWS + 256 * tstart[ch * 260 + e] + ((const int*)(ws + WS_ASGS))[a];
            ((int*)(ws + WS_ROWASG))[pos] = a; ((float*)(ws + WS_ROWW))[pos] = ((const float*)(ws + WS_ASGW))[a]; }
    }
    SEAM(11);
    if (IN(12)) {
        PHASE_ARGS();
        for (int ch = 0; ch < NCHUNK; ++ch) {
            { SchedMoeGU S; S.abase = (const char*)ws; S.a_kstep = 128; S.K = 1024; S.tstart = tstart + ch * 260; S.rowasg = (const int*)(ws + WS_ROWASG) + ch * CHUNK_ROWS; S.W = (const char*)(ws + WS_WGU); S.G = G; S.c = (int)blockIdx.x;
              EpiSwiglu E{(bf16_t*)(ws + WS_HID)}; pg8::gemm_phase<EpiSwiglu, SchedMoeGU>(lds, S, E); }
            if (ch > 0) final_chunk(in, ws, out, ctl + CW_FCTR + 64 * (ch - 1), ch - 1, MISC + 16, tid, wave, lane);
            xcd_barrier(bar);
            { SchedMoeD S; S.abase = (const char*)ws; S.a_kstep = 128; S.K = 256; S.tstart = tstart + ch * 260; S.W = (const char*)(ws + WS_WD); S.G = G; S.c = (int)blockIdx.x;
              EpiMoeDown E{(unsigned char*)(ws + WS_OUTS), (const int*)(ws + WS_ROWASG) + ch * CHUNK_ROWS, (const float*)(ws + WS_ROWW) + ch * CHUNK_ROWS, ch * CHUNK_ASG}; pg8::gemm_phase<EpiMoeDown, SchedMoeD>(lds, S, E); }
            xcd_barrier(bar);
        }
        final_chunk(in, ws, out, ctl + CW_FCTR + 64 * (NCHUNK - 1), NCHUNK - 1, MISC + 16, tid, wave, lane);
    }
#undef IN
#undef SEAM
}

extern "C" void kernel_launch(void* const* d_in, const int* in_sizes, int n_in, void* d_out, int out_size, void* d_ws, size_t ws_size, hipStream_t stream) {
    static int grid = 0;
    if (grid == 0) {
        if (n_in != 31 || out_size != MTOK * DM || ws_size < WS_END) { fprintf(stderr, "kernel_launch: unexpected shapes: n_in %d out %d ws %zu (need %zu)\n", n_in, out_size, ws_size, (size_t)WS_END); grid = -1; return; }
        int dev = 0, cus = 0, per_cu = 0;
        if (hipGetDevice(&dev) != hipSuccess || hipDeviceGetAttribute(&cus, hipDeviceAttributeMultiprocessorCount, dev) != hipSuccess) { grid = -1; return; }
        if (hipFuncSetAttribute((const void*)fwd_kernel, hipFuncAttributeMaxDynamicSharedMemorySize, LDS_BYTES) != hipSuccess) { fprintf(stderr, "kernel_launch: hipFuncSetAttribute failed\n"); grid = -1; return; }
        if (hipOccupancyMaxActiveBlocksPerMultiprocessor(&per_cu, (const void*)fwd_kernel, NTHREADS, LDS_BYTES) != hipSuccess || per_cu < 1) { fprintf(stderr, "kernel_launch: occupancy query says %d\n", per_cu); }
        (void)hipGetLastError();
        grid = cus;
    }
    if (grid < 0) return;
    if (hipMemsetAsync((char*)d_ws + WS_CTL, 0, CTL_ZERO_BYTES, stream) != hipSuccess) return;
    Args a{};
    const float** ip = (const float**)&a.in;
    for (int i = 0; i < 31; ++i) ip[i] = (const float*)d_in[i];
    a.out = (float*)d_out; a.ws = (unsigned char*)d_ws; a.ph_lo = 0; a.ph_hi = 13;
    hipLaunchKernelGGL(fwd_kernel, dim3(grid), dim3(NTHREADS), LDS_BYTES, stream, a);
}
```
